# Optimizing an MI355X kernel written in HIP

```python
import math
import jax
import jax.numpy as jnp
from jax import lax
import numpy as np

D_MODEL = 1024
BATCH = 8
SEQ = 4096
DEPTH = 1

N_HEADS = 8
N_KV_HEADS = 2
HEAD_DIM = 64
WINDOW = 128
BLOCK = 128
ATTN_Q = N_HEADS * HEAD_DIM
ATTN_KV = N_KV_HEADS * HEAD_DIM
N_BUCKETS = 32
MAX_EXACT = N_BUCKETS // 2
MAX_DISTANCE = 128
GM_WIDTH = 512
GM_GROUPS = 4
GM_GROUP_DIM = GM_WIDTH // GM_GROUPS
GM_CHUNK = 128
IN_WIDTH = ATTN_Q + 2 * ATTN_KV + 2 * GM_WIDTH + 2 * D_MODEL
N_GROUPS = 4
EXPERTS_PER_GROUP = 8
N_EXPERTS = N_GROUPS * EXPERTS_PER_GROUP
TOP_K = 2
D_EXPERT = 512
MOE_BLOCK = 128

EPS = 1e-6
NEG = -1e30

kernel_name = 'hybrid_swa_gmlp_hmoe_adaln'


def rms_norm(x, g):
    xf = x.astype(jnp.float32)
    y = xf * lax.rsqrt(jnp.mean(xf * xf, axis=-1, keepdims=True) + EPS)
    return (y * g.astype(jnp.float32)).astype(x.dtype)


def layer_norm(x, g, b):
    xf = x.astype(jnp.float32)
    mu = jnp.mean(xf, axis=-1, keepdims=True)
    var = jnp.mean(jnp.square(xf - mu), axis=-1, keepdims=True)
    y = (xf - mu) * lax.rsqrt(var + EPS)
    return (y * g.astype(jnp.float32) + b.astype(jnp.float32)).astype(x.dtype)


def t5_bucket(dist):
    n = jnp.maximum(dist, 0)
    nf = jnp.maximum(n, 1).astype(jnp.float32)
    large = MAX_EXACT + (jnp.log(nf / MAX_EXACT) / math.log(MAX_DISTANCE / MAX_EXACT)
                         * (N_BUCKETS - MAX_EXACT)).astype(jnp.int32)
    large = jnp.minimum(large, N_BUCKETS - 1)
    return jnp.where(n < MAX_EXACT, n, large)


def band(t):
    prev = jnp.concatenate([jnp.zeros_like(t[:, :1]), t[:, :-1]], axis=1)
    return jnp.concatenate([prev, t], axis=2)


def sliding_window_attention(q, k, v, positions, sinks, rel_bias):
    B, S, _ = q.shape
    nb = S // BLOCK
    grp = N_HEADS // N_KV_HEADS
    q = q.reshape(B, nb, BLOCK, N_KV_HEADS, grp, HEAD_DIM)
    kb = band(k.reshape(B, nb, BLOCK, N_KV_HEADS, HEAD_DIM))
    vb = band(v.reshape(B, nb, BLOCK, N_KV_HEADS, HEAD_DIM))
    pq = positions.reshape(B, nb, BLOCK)
    pk = band(pq)
    bucket = t5_bucket(pq[..., :, None] - pk[..., None, :])
    bias = rel_bias[bucket].reshape(B, nb, BLOCK, 2 * BLOCK, N_KV_HEADS, grp)
    bias = bias.transpose(0, 1, 4, 5, 2, 3).astype(jnp.float32)
    qi = jnp.arange(BLOCK)[:, None] + BLOCK
    kj = jnp.arange(2 * BLOCK)[None, :]
    local = (kj <= qi) & (qi - kj < WINDOW)
    first = (jnp.arange(nb)[:, None, None] > 0) | (kj[None] >= BLOCK)
    mask = (local[None] & first)[None, :, None, None]
    scale = HEAD_DIM ** -0.5
    s = jnp.einsum('bnqhgd,bnshd->bnhgqs', q, kb).astype(jnp.float32)
    s = jnp.where(mask, s * scale + bias, NEG)
    sink = sinks.astype(jnp.float32).reshape(N_KV_HEADS, grp)[None, None, :, :, None, None]
    m = jnp.maximum(jnp.max(s, axis=-1, keepdims=True), sink)
    p = jnp.exp(s - m)
    p = p / (jnp.sum(p, axis=-1, keepdims=True) + jnp.exp(sink - m))
    o = jnp.einsum('bnhgqs,bnshd->bnqhgd', p.astype(v.dtype), vb)
    return o.reshape(B, S, ATTN_Q)


def spatial_gating(u, v, ln_g, ln_b, w_s, b_s):
    B, S, _ = v.shape
    nc = S // GM_CHUNK
    vn = layer_norm(v, ln_g, ln_b).reshape(B, nc, GM_CHUNK, GM_GROUPS, GM_GROUP_DIM)
    w = w_s * jnp.tril(jnp.ones((GM_CHUNK, GM_CHUNK), w_s.dtype))
    sv = jnp.einsum('gts,bnsgc->bntgc', w, vn) + b_s.T[:, :, None]
    return u * sv.reshape(B, S, GM_WIDTH)


def hierarchical_moe(h, w_rg, b_rg, w_re, b_re, w_gate, w_up, w_down):
    B, S, D = h.shape
    T = B * S
    hf = h.reshape(T, D)
    lg = (hf @ w_rg).astype(jnp.float32) + b_rg.astype(jnp.float32)
    g_idx = jnp.argmax(lg, axis=-1)
    p_g = jnp.take_along_axis(jax.nn.softmax(lg, axis=-1), g_idx[:, None], axis=-1)[:, 0]
    le = ((hf @ w_re).astype(jnp.float32) + b_re.astype(jnp.float32)).reshape(T, N_GROUPS, EXPERTS_PER_GROUP)
    le = jnp.take_along_axis(le, g_idx[:, None, None], axis=1)[:, 0]
    top_p, top_i = lax.top_k(jax.nn.softmax(le, axis=-1), TOP_K)
    top_p = top_p / jnp.sum(top_p, axis=-1, keepdims=True)
    weights = p_g[:, None] * top_p
    expert_id = g_idx[:, None] * EXPERTS_PER_GROUP + top_i
    A = T * TOP_K
    e_flat = expert_id.reshape(A)
    tok_flat = jnp.repeat(jnp.arange(T, dtype=jnp.int32), TOP_K)
    w_flat = weights.reshape(A)
    order = jnp.argsort(e_flat)
    e_sorted, tok_sorted, w_sorted = e_flat[order], tok_flat[order], w_flat[order]
    counts = jnp.bincount(e_flat, length=N_EXPERTS)
    starts = jnp.cumsum(counts) - counts
    padded = (counts + MOE_BLOCK - 1) // MOE_BLOCK * MOE_BLOCK
    pends = jnp.cumsum(padded)
    pstarts = pends - padded
    dest = pstarts[e_sorted] + (jnp.arange(A) - starts[e_sorted])
    R = (A + MOE_BLOCK - 1) // MOE_BLOCK * MOE_BLOCK + N_EXPERTS * MOE_BLOCK
    NB = R // MOE_BLOCK
    row_tok = jnp.zeros((R,), jnp.int32).at[dest].set(tok_sorted)
    row_w = jnp.zeros((R,), jnp.float32).at[dest].set(w_sorted)
    block_e = jnp.minimum(jnp.searchsorted(pends, jnp.arange(NB) * MOE_BLOCK, side='right'), N_EXPERTS - 1)
    xr = hf[row_tok].reshape(NB, MOE_BLOCK, D)

    def expert_block(args):
        xb, e = args
        return (jax.nn.silu(xb @ w_gate[e]) * (xb @ w_up[e])) @ w_down[e]

    yr = lax.map(expert_block, (xr, block_e)).reshape(R, D)
    out = jax.ops.segment_sum(yr.astype(jnp.float32) * row_w[:, None], row_tok, num_segments=T)
    return out.astype(h.dtype).reshape(B, S, D)


def setup_inputs(seed: int = 0) -> dict:
    key = jax.random.key(seed)
    ks = jax.random.split(key, 26)

    def nrm(k, shape, scale):
        return jax.random.normal(k, shape, jnp.float32) * scale

    L = DEPTH
    return {
        'x': nrm(ks[0], (BATCH, SEQ, D_MODEL), 1.0),
        'c': nrm(ks[1], (BATCH, D_MODEL), 1.0),
        'positions': jnp.broadcast_to(jnp.arange(SEQ, dtype=jnp.int32), (BATCH, SEQ)),
        'rel_bias': nrm(ks[2], (N_BUCKETS, N_HEADS), 0.5),
        'w_ada': nrm(ks[3], (L, D_MODEL, 6 * D_MODEL), D_MODEL ** -0.5),
        'b_ada': nrm(ks[4], (L, 6 * D_MODEL), 0.02),
        'norm1_g': 1.0 + nrm(ks[5], (L, D_MODEL), 0.02),
        'w_in': nrm(ks[6], (L, D_MODEL, IN_WIDTH), D_MODEL ** -0.5),
        'sinks': nrm(ks[7], (L, N_HEADS), 0.5),
        'gm_ln_g': 1.0 + nrm(ks[8], (L, GM_WIDTH), 0.02),
        'gm_ln_b': nrm(ks[9], (L, GM_WIDTH), 0.02),
        'gm_w_s': nrm(ks[10], (L, GM_GROUPS, GM_CHUNK, GM_CHUNK), GM_CHUNK ** -0.5),
        'gm_b_s': 1.0 + nrm(ks[11], (L, GM_GROUPS, GM_CHUNK), 0.02),
        'p_a': nrm(ks[12], (L, ATTN_Q, D_MODEL), ATTN_Q ** -0.5),
        'p_b': nrm(ks[13], (L, GM_WIDTH, D_MODEL), GM_WIDTH ** -0.5),
        'w_o': nrm(ks[14], (L, D_MODEL, D_MODEL), D_MODEL ** -0.5),
        'norm2_g': 1.0 + nrm(ks[15], (L, D_MODEL), 0.02),
        'w_router_g': nrm(ks[16], (L, D_MODEL, N_GROUPS), D_MODEL ** -0.5),
        'b_router_g': nrm(ks[17], (L, N_GROUPS), 0.01),
        'w_router_e': nrm(ks[18], (L, D_MODEL, N_EXPERTS), D_MODEL ** -0.5),
        'b_router_e': nrm(ks[19], (L, N_EXPERTS), 0.01),
        'w_gate': nrm(ks[20], (L, N_EXPERTS, D_MODEL, D_EXPERT), D_MODEL ** -0.5),
        'w_up': nrm(ks[21], (L, N_EXPERTS, D_MODEL, D_EXPERT), D_MODEL ** -0.5),
        'w_down': nrm(ks[22], (L, N_EXPERTS, D_EXPERT, D_MODEL), D_EXPERT ** -0.5),
        'final_g': 1.0 + nrm(ks[23], (D_MODEL,), 0.02),
    }


def reference(x, c, positions, rel_bias, w_ada, b_ada, norm1_g, w_in, sinks, gm_ln_g, gm_ln_b,
              gm_w_s, gm_b_s, p_a, p_b, w_o, norm2_g, w_router_g, b_router_g, w_router_e,
              b_router_e, w_gate, w_up, w_down, final_g):
    splits = np.cumsum([ATTN_Q, ATTN_KV, ATTN_KV, GM_WIDTH, GM_WIDTH, D_MODEL]).tolist()
    cs = jax.nn.silu(c)
    for l in range(DEPTH):
        mod = cs @ w_ada[l] + b_ada[l]
        sh1, sc1, g1, sh2, sc2, g2 = [m[:, None, :] for m in jnp.split(mod, 6, axis=-1)]
        h = rms_norm(x, norm1_g[l]) * (1.0 + sc1) + sh1
        q, k, v, gu, gv, ga, gb = jnp.split(h @ w_in[l], splits, axis=-1)
        y_a = sliding_window_attention(q, k, v, positions, sinks[l], rel_bias)
        y_b = spatial_gating(jax.nn.gelu(gu), jax.nn.gelu(gv), gm_ln_g[l], gm_ln_b[l], gm_w_s[l], gm_b_s[l])
        merged = jax.nn.sigmoid(ga) * (y_a @ p_a[l]) + jax.nn.sigmoid(gb) * (y_b @ p_b[l])
        x = x + g1 * (merged @ w_o[l])
        h = rms_norm(x, norm2_g[l]) * (1.0 + sc2) + sh2
        x = x + g2 * hierarchical_moe(h, w_router_g[l], b_router_g[l], w_router_e[l], b_router_e[l],
                                      w_gate[l], w_up[l], w_down[l])
    return rms_norm(x, final_g)
```

```cpp
#include <hip/hip_runtime.h>
#include <cstdio>
#include <cstdint>
#include <cmath>
#include <type_traits>

#ifndef MK_N_LAUNCHES
#define MK_N_LAUNCHES 1
#endif

#ifndef DEBUG_CHECKS
#define DEBUG_CHECKS 0
#endif
#ifndef DBG_FIRST
#define DBG_FIRST 0
#endif
#ifndef RUN_PHASES
#define RUN_PHASES 10
#endif
#define GAS __attribute__((address_space(1)))
#define LAS __attribute__((address_space(3)))
typedef unsigned short bf16;
typedef short bf16x8 __attribute__((ext_vector_type(8)));
typedef short s16x4 __attribute__((ext_vector_type(4)));
typedef float f32x2 __attribute__((ext_vector_type(2)));
typedef float f32x4 __attribute__((ext_vector_type(4)));
typedef float f32x16 __attribute__((ext_vector_type(16)));
typedef unsigned u32x2 __attribute__((ext_vector_type(2)));
typedef unsigned u32x4 __attribute__((ext_vector_type(4)));
typedef __bf16 bf16x2_t __attribute__((ext_vector_type(2)));
typedef GAS unsigned gu32;

constexpr int BATCH = 8, SEQ = 4096, D = 1024, M = BATCH * SEQ;
constexpr int NQ = 512, NKV = 256  , GMW = 512, INW = 3840;
constexpr int NEXP = 32, DEXP = 512;
constexpr float EPS = 1e-6f;
constexpr float LOG2E = 1.4426950408889634f;
constexpr float QSCALE = 0.125f * LOG2E;
constexpr int LIST_CAP = 32768;
constexpr int HACT_ROWS = 73728;

constexpr size_t MiB = 1u << 20;
constexpr size_t WS_CTL = 0, CTL_ZERO_BYTES = 32 * 1024;
constexpr size_t WS_MOD = 1 * MiB;
constexpr size_t WS_MODP = 1 * MiB + 256 * 1024;
constexpr size_t WS_WST = 4 * MiB + 512 * 1024;
constexpr size_t WS_LROW = 5 * MiB;
constexpr size_t WS_LW = 9 * MiB;
constexpr size_t WS_GT = 13 * MiB;
constexpr size_t WS_GC = 13 * MiB + 800 * 1024;
constexpr size_t WS_WIN = 14 * MiB;
constexpr size_t WS_WIN8 = 18 * MiB;
constexpr size_t WS_H1F8 = 186 * MiB;
constexpr int NBF = 1792;
constexpr size_t WS_PA = 22 * MiB;
constexpr size_t WS_WO = 24 * MiB;
constexpr size_t WS_WGU = 26 * MiB;
constexpr size_t WS_WD = 90 * MiB;
constexpr size_t WS_A = 122 * MiB;
constexpr size_t WS_YAB = 186 * MiB;
constexpr size_t WS_YT = 122 * MiB;
constexpr size_t WS_Q = 250 * MiB;
constexpr size_t WS_KV = 282 * MiB;
constexpr size_t WS_GU = 298 * MiB, WS_GV = 330 * MiB;
constexpr size_t WS_T = 298 * MiB;
constexpr size_t WS_HACT = 250 * MiB;
constexpr size_t WS_GA = 362 * MiB;
constexpr size_t WS_XMID = 362 * MiB;
constexpr size_t WS_GB = 426 * MiB;
constexpr size_t WS_H2 = 426 * MiB;
constexpr size_t WS_END = 490 * MiB;
static_assert(WS_HACT + (size_t)HACT_ROWS * 1024 <= WS_GA, "HACT overlay");
constexpr int CW_TMO = 0, CW_CODE = 1;
constexpr int CW_CNT = 1024;
constexpr int CW_BAR = 4096;

constexpr int RING_OFF = 0, RING_BYTES = 131072;
constexpr int LDSCTL_OFF = RING_BYTES, MISC_OFF = LDSCTL_OFF + 320;
constexpr int TAB_OFF = RING_BYTES + 512;
constexpr int TAB_UNITS = TAB_OFF, TAB_CNT = TAB_OFF + 256, TAB_ROWS = TAB_OFF + 1024, MAX_WG_UNITS = 14;
constexpr int LDS_BYTES = 147456;
static_assert(TAB_ROWS + MAX_WG_UNITS * 1024 <= LDS_BYTES, "LDS map");
constexpr int NWAVES = 8;
constexpr int N_PHASES = 10;

#define LDS_WAIT() asm volatile("s_waitcnt lgkmcnt(0)" ::: "memory")
#define VM_WAIT() asm volatile("s_waitcnt vmcnt(0)" ::: "memory")
#define RLX_AGENT __ATOMIC_RELAXED, __HIP_MEMORY_SCOPE_AGENT
__device__ __forceinline__ unsigned cvtpk(float lo, float hi) { f32x2 v = {lo, hi}; bf16x2_t b = __builtin_convertvector(v, bf16x2_t); return __builtin_bit_cast(unsigned, b); }
__device__ __forceinline__ float bf_lo(unsigned w) { return __uint_as_float(w << 16); }
__device__ __forceinline__ float bf_hi(unsigned w) { return __uint_as_float(w & 0xffff0000u); }
__device__ __forceinline__ float wave_sum(float v) {
    int x = __float_as_int(v);
#define WS_DPP(ctrl, rmask) x = __float_as_int(__int_as_float(x) + __int_as_float(__builtin_amdgcn_update_dpp(0, x, (ctrl), (rmask), 0xf, false)))
    WS_DPP(0xB1, 0xf);
    WS_DPP(0x4E, 0xf);
    WS_DPP(0x141, 0xf);
    WS_DPP(0x140, 0xf);
    WS_DPP(0x142, 0xa);
    WS_DPP(0x143, 0xc);
#undef WS_DPP
    return __int_as_float(__builtin_amdgcn_readlane(x, 63));
}
__device__ __forceinline__ float clamp448(float v) { return __builtin_amdgcn_fmed3f(v, -448.0f, 448.0f); }
__device__ __forceinline__ unsigned pk4_fp8(float a, float b, float c, float d) {
    unsigned r = 0; r = __builtin_amdgcn_cvt_pk_fp8_f32(clamp448(a), clamp448(b), r, false); r = __builtin_amdgcn_cvt_pk_fp8_f32(clamp448(c), clamp448(d), r, true); return r; }
__device__ __forceinline__ u32x2 pack8_fp8(const f32x4 a, const f32x4 b) { u32x2 w; w.x = pk4_fp8(a[0], a[1], a[2], a[3]); w.y = pk4_fp8(b[0], b[1], b[2], b[3]); return w; }
constexpr float WGU_SCALE = 64.0f, WD_SCALE = 32.0f;
__device__ __forceinline__ unsigned pk4_u8(float a, float b, float c, float d) {
    return (unsigned)(a * 255.0f + 0.5f) | ((unsigned)(b * 255.0f + 0.5f) << 8) | ((unsigned)(c * 255.0f + 0.5f) << 16) | ((unsigned)(d * 255.0f + 0.5f) << 24); }
__device__ __forceinline__ void unpack8_u8(const u32x2 w, f32x4& a, f32x4& b) {
    a = (f32x4){(float)(w.x & 0xffu), (float)((w.x >> 8) & 0xffu), (float)((w.x >> 16) & 0xffu), (float)(w.x >> 24)};
    b = (f32x4){(float)(w.y & 0xffu), (float)((w.y >> 8) & 0xffu), (float)((w.y >> 16) & 0xffu), (float)(w.y >> 24)}; }
__device__ __forceinline__ float sigmoid_f(float x) { return __builtin_amdgcn_rcpf(1.0f + __builtin_amdgcn_exp2f(-x * LOG2E)); }
__device__ __forceinline__ float gelu_tanh_f(float x) {
    const float t = x * __builtin_fmaf(x * x, -2.3022081987f * 0.044715f, -2.3022081987f);
    return x * __builtin_amdgcn_rcpf(1.0f + __builtin_amdgcn_exp2f(t));
}
__device__ __forceinline__ float silu_f(float x) { return x * __builtin_amdgcn_rcpf(1.0f + __builtin_amdgcn_exp2f(-x * LOG2E)); }

namespace pg8 {
constexpr int BM = 256, BK = 64, HALF = 128, HTB = HALF * BK * 2, STAGE_BYTES = 8 * HTB, NXCD = 8, WGM = 8;
__host__ __device__ __forceinline__ int lds_byte(int r, int c) { const int st = (r >> 4) * 2 + (c >> 5), rr = r & 15, cc = c & 31, ob = rr * 64 + cc * 2; return st * 1024 + (ob ^ (((ob >> 9) & 1) << 5)); }
__host__ __device__ __forceinline__ void stage_rc(int b, int& R, int& C) { const int st = b / 1024, sb = b % 1024, swz = sb ^ (((sb >> 9) & 1) << 5); R = (st >> 1) * 16 + swz / 64; C = (st & 1) * 32 + (swz % 64) / 2; }
__host__ __device__ __forceinline__ int perm32(int rho) { const int n = rho >> 4, i = rho & 15; return 8 * (i >> 2) + 4 * n + (i & 3); }

struct Unit { int pm, pn, v, e, ui; };

struct DenseOrder {
    int nM, nN, nwg, G, c;
    __device__ void init(int M_, int N_, int G_, int c_) { nM = M_ / BM; nN = N_ / BM; nwg = nM * nN; G = G_; c = c_; }
    __device__ bool tile(int i, Unit& u) const { return tileL((long)i * G + c, u); }
    __device__ bool tileL(long L, Unit& u) const {
        if (L >= nwg) return false;
        int wgid = (int)L; { const int q = nwg / NXCD, r = nwg % NXCD, xcd = wgid % NXCD, off = wgid / NXCD; wgid = (xcd < r ? xcd * (q + 1) : r * (q + 1) + (xcd - r) * q) + off; }
        const int nig = WGM * nN, gid = wgid / nig, fm = gid * WGM, gsz = (nM - fm) < WGM ? (nM - fm) : WGM;
        u.pm = fm + ((wgid % nig) % gsz); u.pn = (wgid % nig) / gsz; u.v = 0; u.e = 0; u.ui = 0; return true;
    }
    __device__ bool next(int i, Unit& u) const { return tile(i, u); }
};
struct BackfillOrder : DenseOrder {
    __device__ bool next(int i, Unit& u) const {
        if (i < 3) return tileL((long)i * G + c, u);
        if (c >= G / 2) return tileL((long)3 * G + (long)(i - 3) * (G - G / 2) + (c - G / 2), u);
        return false; }
};

template <class Prob, class Epi, class Sched, bool ALIGN_EPI>
__device__ __forceinline__ void gemm_phase(LAS unsigned char* lds, const Prob& P, const Sched& S, const Epi& E) {
    const int tid = threadIdx.x, wid = __builtin_amdgcn_readfirstlane(tid >> 6), lane = tid & 63, wr = wid >> 2, wc = wid & 3, fr = lane & 15, fq = lane >> 4;
    const int nt = P.Kb / 128;
    int Rr[2], Cc[2]; unsigned voffB[2], aoc[2][2], aon[2][2];
#pragma unroll
    for (int i = 0; i < 2; ++i) { int R, C; stage_rc(tid * 16 + i * 8192, R, C); Rr[i] = R; Cc[i] = C; const int Rb = Epi::PERM ? ((R & ~31) + perm32(R & 31)) : R;
        voffB[i] = (unsigned)Rb * P.ldb + (unsigned)C * 2u; }
    const size_t kstep = (size_t)(BK * 2);
    const size_t hstepB = (size_t)HALF * P.ldb;
    const unsigned ldsw = (unsigned)wid * 1024u;
    const int aoff = lds_byte(wr * 64 + fr, fq * 8), boff = lds_byte(wc * 32 + fr, fq * 8);
#define PG8_SA(b, h) (((b) * 2 + (h)) * HTB)
#define PG8_SB(b, h) ((4 + (b) * 2 + (h)) * HTB)
#define PG8_STG(bufoff, p0, p1) do { \
        __builtin_amdgcn_global_load_lds((const unsigned*)(p0), (LAS unsigned*)(lds + (bufoff) + ldsw), 16, 0, 0); \
        __builtin_amdgcn_global_load_lds((const unsigned*)(p1), (LAS unsigned*)(lds + (bufoff) + ldsw + 8192), 16, 0, 0); } while (0)
#define PG8_STGB(bufoff, base) PG8_STG(bufoff, (base) + voffB[0], (base) + voffB[1])
#define PG8_STGA(bufoff, base, off, h) PG8_STG(bufoff, (base) + off[h][0], (base) + off[h][1])
#define PG8_LDF(dst, addr) do { if constexpr (Prob::F8) { const i32x4 lo_ = *(const LAS i32x4*)(addr), hi_ = *(const LAS i32x4*)((addr) + 1024); dst.v = __builtin_shufflevector(lo_, hi_, 0, 1, 2, 3, 4, 5, 6, 7); } \
        else { dst.k[0] = *(const LAS bf16x8*)(addr); dst.k[1] = *(const LAS bf16x8*)((addr) + 1024); } } while (0)
#define PG8_LDA(dst, b, h) do { _Pragma("unroll") for (int m = 0; m < 4; ++m) PG8_LDF(dst[m], lds + PG8_SA(b, h) + aoff + m * 2048); } while (0)
#define PG8_LDB(dst, b, h) do { _Pragma("unroll") for (int n = 0; n < 2; ++n) PG8_LDF(dst[n], lds + PG8_SB(b, h) + boff + n * 2048); } while (0)
#define PG8_MMA(ai, bj, At, Bt) do { __builtin_amdgcn_s_setprio(1); _Pragma("unroll") for (int m = 0; m < 4; ++m) _Pragma("unroll") for (int n = 0; n < 2; ++n) { \
        if constexpr (Prob::F8) asm volatile("v_mfma_scale_f32_16x16x128_f8f6f4 %0, %1, %2, %0, %3, %3 op_sel_hi:[0,0,0]" : "+v"(acc[ai][bj][m][n]) : "v"(Bt[n].v), "v"(At[m].v), "v"(f8scale));   \
        else { _Pragma("unroll") for (int k = 0; k < 2; ++k) acc[ai][bj][m][n] = __builtin_amdgcn_mfma_f32_16x16x32_bf16(Bt[n].k[k], At[m].k[k], acc[ai][bj][m][n], 0, 0, 0); } } \
        __builtin_amdgcn_s_setprio(0); } while (0)
#define PG8_WAIT_V(n) asm volatile("s_waitcnt vmcnt(" #n ")" ::: "memory")
#define PG8_WAIT_L(n) asm volatile("s_waitcnt lgkmcnt(" #n ")" ::: "memory")
#define PG8_BAR __builtin_amdgcn_s_barrier()
#define PG8_SCHED __builtin_amdgcn_sched_barrier(0)
#define PG8_AOFF(dst, ui_) do { _Pragma("unroll") for (int h = 0; h < 2; ++h) _Pragma("unroll") for (int i = 0; i < 2; ++i) { \
        if constexpr (Prob::GATHER) dst[h][i] = P.rowtab[(ui_) * 256 + h * HALF + Rr[i]] + (unsigned)Cc[i] * 2u; \
        else dst[h][i] = (unsigned)(h * HALF + Rr[i]) * P.lda + (unsigned)Cc[i] * 2u; } } while (0)
    Unit cur, nxt; int ui = 0;
    if (!S.next(0, cur)) return;
    f32x4 acc[2][2][4][2];
#pragma unroll
    for (int a = 0; a < 2; ++a)
#pragma unroll
        for (int b = 0; b < 2; ++b)
#pragma unroll
            for (int m = 0; m < 4; ++m)
#pragma unroll
                for (int n = 0; n < 2; ++n) acc[a][b][m][n] = (f32x4){0.f, 0.f, 0.f, 0.f};
    typedef int i32x8 __attribute__((ext_vector_type(8))); typedef int i32x4 __attribute__((ext_vector_type(4)));
    struct FragBf { bf16x8 k[2]; }; struct FragF8 { i32x8 v; };
    typedef typename std::conditional<Prob::F8, FragF8, FragBf>::type Frag;
    Frag At[4], B0[2], B1[2];
    int f8scale = 0x7f7f7f7f; asm volatile("" : "+v"(f8scale));
    const char* cA = P.a_ptr(cur); const char* cB = P.b_ptr(cur);
    PG8_AOFF(aoc, 0);
#pragma unroll
    for (int h = 0; h < 2; ++h)
#pragma unroll
        for (int i = 0; i < 2; ++i) aon[h][i] = aoc[h][i];
    PG8_STGB(PG8_SB(0, 0), cB); PG8_STGB(PG8_SB(0, 1), cB + hstepB); PG8_STGA(PG8_SA(0, 0), cA, aoc, 0); PG8_STGA(PG8_SA(0, 1), cA, aoc, 1);
    if (wr == 1) PG8_BAR;
    PG8_WAIT_V(2); PG8_BAR;
    PG8_STGB(PG8_SB(1, 0), cB + kstep); PG8_STGA(PG8_SA(1, 0), cA + kstep, aoc, 0); PG8_STGB(PG8_SB(1, 1), cB + hstepB + kstep);
    PG8_WAIT_V(6); PG8_BAR;
    for (;;) {
        const bool has_next = S.next(ui + 1, nxt);
        const char* nA = has_next ? P.a_ptr(nxt) : cA; const char* nB = has_next ? P.b_ptr(nxt) : cB;
        for (int t = 0; t < nt; t += 2) {
            const bool last = (t == nt - 2);
            const char* a1 = cA + (size_t)(t + 1) * kstep;
            const char* a2 = last ? nA : cA + (size_t)(t + 2) * kstep; const char* b2 = last ? nB : cB + (size_t)(t + 2) * kstep;
            const char* a3 = a2 + kstep; const char* b3 = b2 + kstep;
            unsigned ao2[2][2];
            if constexpr (Prob::GATHER) {
                if (last && has_next) PG8_AOFF(aon, ui + 1);
#pragma unroll
                for (int h = 0; h < 2; ++h)
#pragma unroll
                    for (int i = 0; i < 2; ++i) ao2[h][i] = (last && has_next) ? aon[h][i] : aoc[h][i];
            } else {
#pragma unroll
                for (int h = 0; h < 2; ++h)
#pragma unroll
                    for (int i = 0; i < 2; ++i) ao2[h][i] = aoc[h][i];
            }
            if constexpr (Epi::MIDK) { if (t == nt / 2) E.mid(acc, cur, wr, wc, fr, fq); }
            PG8_LDB(B0, 0, 0); PG8_LDB(B1, 0, 1); PG8_SCHED; PG8_LDA(At, 0, 0); PG8_STGA(PG8_SA(1, 1), a1, aoc, 1);
            PG8_WAIT_V(8); PG8_WAIT_L(0); PG8_BAR; PG8_MMA(0, 0, At, B0); PG8_MMA(0, 1, At, B1); PG8_BAR; PG8_SCHED;
            PG8_LDA(At, 0, 1); PG8_STGB(PG8_SB(0, 0), b2); PG8_STGB(PG8_SB(0, 1), b2 + hstepB); PG8_STGA(PG8_SA(0, 0), a2, ao2, 0);
            PG8_WAIT_V(8); PG8_WAIT_L(0); PG8_BAR; PG8_MMA(1, 0, At, B0); PG8_MMA(1, 1, At, B1); PG8_BAR; PG8_SCHED;
            PG8_LDB(B0, 1, 0); PG8_LDB(B1, 1, 1); PG8_SCHED; PG8_LDA(At, 1, 0); PG8_STGA(PG8_SA(0, 1), a2, ao2, 1);
            PG8_WAIT_V(8); PG8_WAIT_L(0); PG8_BAR; PG8_MMA(0, 0, At, B0); PG8_MMA(0, 1, At, B1); PG8_BAR; PG8_SCHED;
            PG8_LDA(At, 1, 1); PG8_STGB(PG8_SB(1, 0), b3); PG8_STGB(PG8_SB(1, 1), b3 + hstepB); PG8_STGA(PG8_SA(1, 0), a3, ao2, 0);
            PG8_WAIT_V(8); PG8_WAIT_L(0); PG8_BAR; PG8_MMA(1, 0, At, B0); PG8_MMA(1, 1, At, B1); PG8_BAR; PG8_SCHED;
        }
        if constexpr (ALIGN_EPI) { if (wr == 0) PG8_BAR; }
        if constexpr (Prob::F8) asm volatile("s_nop 15\n\ts_nop 15\n\ts_nop 15" ::: "memory");
        E(acc, cur, wr, wc, fr, fq);
        if (!has_next) break;
#pragma unroll
        for (int a = 0; a < 2; ++a)
#pragma unroll
            for (int b = 0; b < 2; ++b)
#pragma unroll
                for (int m = 0; m < 4; ++m)
#pragma unroll
                    for (int n = 0; n < 2; ++n) acc[a][b][m][n] = (f32x4){0.f, 0.f, 0.f, 0.f};
        cur = nxt; cA = nA; cB = nB; ++ui;
        if constexpr (Prob::GATHER) {
#pragma unroll
            for (int h = 0; h < 2; ++h)
#pragma unroll
                for (int i = 0; i < 2; ++i) aoc[h][i] = aon[h][i];
        }
        if constexpr (ALIGN_EPI) { if (wr == 1) PG8_BAR; }
    }
    PG8_WAIT_V(0);
    if constexpr (!ALIGN_EPI) { if (wr == 0) PG8_BAR; }
    PG8_BAR;
#undef PG8_SA
#undef PG8_SB
#undef PG8_STG
#undef PG8_STGA
#undef PG8_STGB
#undef PG8_LDA
#undef PG8_LDF
#undef PG8_LDB
#undef PG8_MMA
#undef PG8_WAIT_V
#undef PG8_WAIT_L
#undef PG8_BAR
#undef PG8_SCHED
#undef PG8_AOFF
}
}

#define XB_TMO      128
#define XB_XCNT(j)  (256  + 64 * (j))
#define XB_XSUB(j)  (1280 + 64 * (j))
#define XB_XGEN(j)  (2304 + 64 * (j))
#define XB_TOP      3328
#define XB_TOPGEN   3392
#define XCD_BAR_WORDS 3456
#define XB_SPIN_CAP (1u << 18)
__device__ __forceinline__ unsigned xb_ld(unsigned* p)              { return __hip_atomic_load(p, __ATOMIC_RELAXED, __HIP_MEMORY_SCOPE_AGENT); }
__device__ __forceinline__ unsigned xb_add(unsigned* p, unsigned v) { return __hip_atomic_fetch_add(p, v, __ATOMIC_RELAXED, __HIP_MEMORY_SCOPE_AGENT); }
__device__ __forceinline__ unsigned xb_xcc_id() { return (unsigned)__builtin_amdgcn_s_getreg((3 << 11) | 20) & 0xFu; }
#define XB_SPIN(cond, bar) do { unsigned _sp = 0; while (cond) { __builtin_amdgcn_s_sleep(1); \
    if ((++_sp & 255u) == 0u) { if (xb_ld(&(bar)[XB_TMO])) break; if (_sp > XB_SPIN_CAP) { atomicAdd(&(bar)[XB_TMO], 1u); break; } } } } while (0)
struct XcdBarrier { unsigned* bar; unsigned x; volatile LAS unsigned* st; };
__device__ __forceinline__ XcdBarrier xcd_barrier_post(unsigned* bar, volatile LAS unsigned* st) {
    XcdBarrier b; b.bar = bar; b.x = xb_xcc_id(); b.st = st;
    if (threadIdx.x == 0) (void)xb_add(&bar[XB_XCNT(b.x)], 1u);
    return b;
}
__device__ __forceinline__ void xcd_barrier_complete(unsigned* bar, unsigned x, unsigned& nloc, unsigned& nx) {
    const unsigned G = gridDim.x * gridDim.y * gridDim.z;
    unsigned sum, cnt, mine, sp = 0u;
    for (;;) {
        sum = 0u; cnt = 0u; mine = 0u;
#pragma unroll
        for (unsigned j = 0; j < 16; ++j) { const unsigned c = xb_ld(&bar[XB_XCNT(j)]); sum += c; cnt += (c > 0u) ? 1u : 0u; mine = (j == x) ? c : mine; }
        if (sum == G) break;
        __builtin_amdgcn_s_sleep(1);
        if ((++sp & 255u) == 0u) { if (xb_ld(&bar[XB_TMO])) break; if (sp > XB_SPIN_CAP) { atomicAdd(&bar[XB_TMO], 1u); break; } }
    }
    nloc = mine > 0u ? mine : 1u; nx = cnt > 0u ? cnt : 1u;
}
__device__ __forceinline__ void xcd_barrier(const XcdBarrier& b) {
    asm volatile("s_waitcnt vmcnt(0)" ::: "memory");
    __syncthreads();
    if (threadIdx.x == 0) {
        unsigned* bar = b.bar;
        __builtin_amdgcn_s_waitcnt(0);
        unsigned nloc = b.st[0], nx = b.st[1];
        if (nloc == 0u) { xcd_barrier_complete(bar, b.x, nloc, nx); b.st[0] = nloc; b.st[1] = nx; }
        const unsigned old = xb_add(&bar[XB_XSUB(b.x)], 1u);
        const unsigned gen = old / nloc;
        if (old + 1u == (gen + 1u) * nloc) {
            __builtin_amdgcn_fence(__ATOMIC_RELEASE, "agent");
            asm volatile("s_waitcnt vmcnt(0)" ::: "memory");
            const unsigned og = xb_add(&bar[XB_TOP], 1u);
            const unsigned tg = og / nx;
            if (og + 1u == (tg + 1u) * nx) xb_add(&bar[XB_TOPGEN], 1u);
            else XB_SPIN(xb_ld(&bar[XB_TOPGEN]) == tg, bar);
            __builtin_amdgcn_fence(__ATOMIC_ACQUIRE, "agent");
            xb_add(&bar[XB_XGEN(b.x)], 1u);
            asm volatile("s_waitcnt vmcnt(0)" ::: "memory");
        } else {
            XB_SPIN(xb_ld(&bar[XB_XGEN(b.x)]) == gen, bar);
            __builtin_amdgcn_fence(__ATOMIC_ACQUIRE, "agent");
            asm volatile("s_waitcnt vmcnt(0)" ::: "memory");
        }
    }
    __syncthreads();
}

struct Args {
    const float* in[25]; float* out; unsigned char* ws; int ph_lo, ph_hi, li, pad;
};
struct Frame {
    LAS unsigned char* lds;
    volatile LAS unsigned* MISC;
    gu32* ctl;
    unsigned char* ws;
    int tid, lane, wave, vcu, G;
};
enum { I_X = 0, I_C, I_POS, I_RELB, I_WADA, I_BADA, I_N1G, I_WIN, I_SINKS, I_LNG, I_LNB, I_GWS, I_GBS, I_PA, I_PB, I_WO, I_N2G, I_WRG, I_BRG, I_WRE, I_BRE, I_WG, I_WU, I_WDN, I_FG };

__device__ __forceinline__ void p0_transpose_tile(const float* W, int N, int k0, int n0, bf16* WT, int ldt, int drow0, LAS float* scr, int lane) {
    {
        f32x4 t[8];
#pragma unroll
        for (int i = 0; i < 8; ++i) t[i] = __builtin_nontemporal_load((const GAS f32x4*)(W + (size_t)(k0 + 8 * i + (lane >> 3)) * N + n0 + 4 * (lane & 7)));
#pragma unroll
        for (int i = 0; i < 8; ++i) { LAS float* d = scr + (8 * i + (lane >> 3)) * 33 + 4 * (lane & 7); d[0] = t[i][0]; d[1] = t[i][1]; d[2] = t[i][2]; d[3] = t[i][3]; }
    }
    LDS_WAIT(); asm volatile("" ::: "memory");
    const int c = lane & 7;
#pragma unroll
    for (int j = 0; j < 4; ++j) { const int n = (lane >> 3) + 8 * j; const LAS float* s = scr + (8 * c) * 33 + n;
        u32x4 o; o.x = cvtpk(s[0 * 33], s[1 * 33]); o.y = cvtpk(s[2 * 33], s[3 * 33]); o.z = cvtpk(s[4 * 33], s[5 * 33]); o.w = cvtpk(s[6 * 33], s[7 * 33]);
        *(GAS u32x4*)(WT + (size_t)(drow0 + n) * ldt + k0 + 8 * c) = o; }
    LDS_WAIT(); asm volatile("" ::: "memory");
}
__device__ __forceinline__ void p0_transpose_tile_f8(const float* W, int N, int k0, int n0, unsigned char* WT, int ldt, int drow0, float scale, LAS float* scr, int lane) {
    {
        f32x4 t[16];
#pragma unroll
        for (int i = 0; i < 16; ++i) t[i] = __builtin_nontemporal_load((const GAS f32x4*)(W + (size_t)(k0 + 8 * i + (lane >> 3)) * N + n0 + 4 * (lane & 7)));
#pragma unroll
        for (int i = 0; i < 16; ++i) { const int k = 8 * i + (lane >> 3); *(LAS f32x4*)(scr + k * 32 + ((4 * (lane & 7)) ^ (4 * (k >> 4)))) = t[i]; }
    }
    LDS_WAIT(); asm volatile("" ::: "memory");
    const int c = lane & 7;
#pragma unroll
    for (int j = 0; j < 4; ++j) { const int n = (lane >> 3) + 8 * j; const LAS float* sp = scr + (16 * c) * 32 + (n ^ (4 * c));
        u32x4 o;
        o.x = pk4_fp8(sp[0 * 32] * scale, sp[1 * 32] * scale, sp[2 * 32] * scale, sp[3 * 32] * scale); o.y = pk4_fp8(sp[4 * 32] * scale, sp[5 * 32] * scale, sp[6 * 32] * scale, sp[7 * 32] * scale);
        o.z = pk4_fp8(sp[8 * 32] * scale, sp[9 * 32] * scale, sp[10 * 32] * scale, sp[11 * 32] * scale); o.w = pk4_fp8(sp[12 * 32] * scale, sp[13 * 32] * scale, sp[14 * 32] * scale, sp[15 * 32] * scale);
        *(GAS u32x4*)(WT + (size_t)(drow0 + n) * ldt + k0 + 16 * c) = o; }
    LDS_WAIT(); asm volatile("" ::: "memory");
}
__device__ __forceinline__ void p0_prologue(Frame& F, const Args& A) {
    const int gw = F.vcu * NWAVES + F.wave, NGW = F.G * NWAVES, lane = F.lane;
    {
        const float* c = A.in[I_C]; const float* w = A.in[I_WADA]; float* modp = (float*)(F.ws + WS_MODP);
        for (int it = gw; it < 96 * 16; it += NGW) {
            const int cg = it % 96, ks = it / 96, k0 = ks * 64, col = cg * 64 + lane;
            float csv[8], acc[8];
#pragma unroll
            for (int b = 0; b < 8; ++b) { const float v = c[b * D + k0 + lane]; csv[b] = silu_f(v); acc[b] = 0.f; }
            float wv[64];
#pragma unroll
            for (int kk = 0; kk < 64; ++kk) wv[kk] = __builtin_nontemporal_load((const GAS float*)(w + (size_t)(k0 + kk) * (6 * D) + col));
#pragma unroll
            for (int kk = 0; kk < 64; ++kk) {
#pragma unroll
                for (int b = 0; b < 8; ++b) acc[b] += __int_as_float(__builtin_amdgcn_readlane(__float_as_int(csv[b]), kk)) * wv[kk];
            }
#pragma unroll
            for (int b = 0; b < 8; ++b) modp[((size_t)ks * 8 + b) * (6 * D) + col] = acc[b];
        }
    }
    {
        LAS float* scr = (LAS float*)(F.lds + RING_OFF + F.wave * 16384);
        constexpr int S0 = 16 * 56  , S0F = 8 * 64  , S1 = 8 * 32, S2 = 8 * 32, S3 = 16 * 32, S4 = 32 * 128, S5 = 32 * 128, S6 = 32 * 128;
        constexpr int NITEMS = S0 + S0F + S1 + S2 + S3 + S4 + S5 + S6;
        for (int it = gw; it < NITEMS; it += NGW) {
            int r = it;
            if (r < S0) { const int kb = r / 56, nb = r % 56; p0_transpose_tile(A.in[I_WIN], INW, 64 * kb, 32 * nb, (bf16*)(F.ws + WS_WIN), D, 32 * nb, scr, lane); continue; } r -= S0;
            if (r < S0F) { const int kb = r / 64, nb = r % 64; p0_transpose_tile_f8(A.in[I_WIN], INW, 128 * kb, NBF + 32 * nb, (unsigned char*)(F.ws + WS_WIN8), D, 32 * nb, WGU_SCALE, scr, lane); continue; } r -= S0F;
            if (r < S1) { const int kb = r / 32, nb = r % 32; p0_transpose_tile(A.in[I_PA], D, 64 * kb, 32 * nb, (bf16*)(F.ws + WS_PA), D, 32 * nb, scr, lane); continue; } r -= S1;
            if (r < S2) { const int kb = r / 32, nb = r % 32; p0_transpose_tile(A.in[I_PB], D, 64 * kb, 32 * nb, (bf16*)(F.ws + WS_PA) + NQ, D, 32 * nb, scr, lane); continue; } r -= S2;
            if (r < S3) { const int kb = r / 32, nb = r % 32; p0_transpose_tile(A.in[I_WO], D, 64 * kb, 32 * nb, (bf16*)(F.ws + WS_WO), D, 32 * nb, scr, lane); continue; } r -= S3;
            if (r < S4 + S5) { const int up = r >= S4 ? 1 : 0; if (up) r -= S4; const int e = r >> 7, q = r & 127, kb = q / 16, nb = q % 16, n0 = 32 * nb;
                p0_transpose_tile_f8(A.in[up ? I_WU : I_WG] + (size_t)e * D * DEXP, DEXP, 128 * kb, n0, (unsigned char*)(F.ws + WS_WGU) + (size_t)e * 1024 * 1024, D, (n0 >> 7) * 256 + up * 128 + (n0 & 127), WGU_SCALE, scr, lane); continue; }
            r -= S4 + S5;
            { const int e = r >> 7, q = r & 127, kb = q / 32, nb = q % 32; p0_transpose_tile_f8(A.in[I_WDN] + (size_t)e * DEXP * D, D, 128 * kb, 32 * nb, (unsigned char*)(F.ws + WS_WD) + (size_t)e * 1024 * DEXP, DEXP, 32 * nb, WD_SCALE, scr, lane); }
        }
        const float* gws = A.in[I_GWS]; bf16* wst = (bf16*)(F.ws + WS_WST);
        for (int i = F.vcu * 512 + F.tid; i < 4 * 128 * 128 / 2; i += F.G * 512) { const int e0 = 2 * i, t = (e0 >> 7) & 127, s = e0 & 127;
            const float a = s <= t ? gws[e0] : 0.f, b = (s + 1) <= t ? gws[e0 + 1] : 0.f; ((unsigned*)wst)[i] = cvtpk(a, b); }
    }
}

__device__ __forceinline__ float mod_sum(const float* modp, const float* bada, int b, int j) {
    float s = bada[j];
#pragma unroll
    for (int ks = 0; ks < 16; ++ks) s += modp[((size_t)ks * 8 + b) * (6 * D) + j];
    return s;
}
__device__ __forceinline__ void p1_h1(Frame& F, const Args& A) {
    const float* modp = (const float*)(F.ws + WS_MODP); const float* bada = A.in[I_BADA]; float* mod = (float*)(F.ws + WS_MOD);
    for (int idx = F.vcu * 512 + F.tid; idx < 8 * 6 * D; idx += F.G * 512) { const int b = idx / (6 * D), j = idx % (6 * D); mod[idx] = mod_sum(modp, bada, b, j); }
    LAS float* Av = (LAS float*)(F.lds + RING_OFF); LAS float* Bv = Av + D;
    const float* x = A.in[I_X]; const float* g = A.in[I_N1G]; bf16* h1 = (bf16*)(F.ws + WS_A);
    for (int rb = F.vcu; rb < M / 128; rb += F.G) {
        const int b = rb / (SEQ / 128);
        __syncthreads();
        for (int c = F.tid; c < D; c += 512) { const float sh = mod_sum(modp, bada, b, c), sc = mod_sum(modp, bada, b, D + c); Av[c] = g[c] * (1.0f + sc); Bv[c] = sh; }
        __syncthreads();
        for (int j = 0; j < 16; ++j) {
            const int row = rb * 128 + F.wave * 16 + j; const float* xr = x + (size_t)row * D;
            f32x4 v[2][2]; float ss = 0.f;
#pragma unroll
            for (int jj = 0; jj < 2; ++jj)
#pragma unroll
                for (int q = 0; q < 2; ++q) { v[jj][q] = __builtin_nontemporal_load((const GAS f32x4*)(xr + 512 * jj + 8 * F.lane + 4 * q)); ss += (v[jj][q].x * v[jj][q].x + v[jj][q].y * v[jj][q].y) + (v[jj][q].z * v[jj][q].z + v[jj][q].w * v[jj][q].w); }
            const float rinv = 1.0f / sqrtf(wave_sum(ss) * (1.0f / D) + EPS);
#pragma unroll
            for (int jj = 0; jj < 2; ++jj) { const int c0 = 512 * jj + 8 * F.lane;
                const f32x4 a0 = *(const LAS f32x4*)(Av + c0), a1 = *(const LAS f32x4*)(Av + c0 + 4), b0 = *(const LAS f32x4*)(Bv + c0), b1 = *(const LAS f32x4*)(Bv + c0 + 4);
                const f32x4 o0 = v[jj][0] * rinv * a0 + b0, o1 = v[jj][1] * rinv * a1 + b1;
                u32x4 w; w.x = cvtpk(o0.x, o0.y); w.y = cvtpk(o0.z, o0.w); w.z = cvtpk(o1.x, o1.y); w.w = cvtpk(o1.z, o1.w);
                *(GAS u32x4*)(h1 + (size_t)row * D + c0) = w;
                *(GAS u32x2*)((unsigned char*)(F.ws + WS_H1F8) + (size_t)row * D + c0) = pack8_fp8(o0, o1); }
        }
    }
}

struct ProbDense { int Kb; unsigned lda, ldb; const char* A; const char* B; static constexpr bool GATHER = false, F8 = false; const LAS unsigned* rowtab;
    __device__ __forceinline__ const char* a_ptr(const pg8::Unit& u) const { return A + (size_t)u.pm * 256 * lda; }
    __device__ __forceinline__ const char* b_ptr(const pg8::Unit& u) const { return B + (size_t)u.pn * 256 * ldb; } };
struct ProbDense8 { int Kb; unsigned lda, ldb; const char* A; const char* B; static constexpr bool GATHER = false, F8 = true; const LAS unsigned* rowtab;
    __device__ __forceinline__ const char* a_ptr(const pg8::Unit& u) const { return A + (size_t)u.pm * 256 * lda; }
    __device__ __forceinline__ const char* b_ptr(const pg8::Unit& u) const { return B + (size_t)u.pn * 256 * ldb; } };
struct ProbGateUp { int Kb; unsigned lda, ldb; const char* A; const char* B; static constexpr bool GATHER = true, F8 = true; const LAS unsigned* rowtab;
    __device__ __forceinline__ const char* a_ptr(const pg8::Unit&) const { return A; }
    __device__ __forceinline__ const char* b_ptr(const pg8::Unit& u) const { return B + ((size_t)(u.e & 63) * 1024 + (size_t)u.pn * 256) * ldb; } };
struct ProbDown { int Kb; unsigned lda, ldb; const char* A; const char* B; static constexpr bool GATHER = false, F8 = true; const LAS unsigned* rowtab;
    __device__ __forceinline__ const char* a_ptr(const pg8::Unit& u) const { return A + (size_t)u.pm * 256 * lda; }
    __device__ __forceinline__ const char* b_ptr(const pg8::Unit& u) const { return B + ((size_t)(u.e & 63) * 1024 + (size_t)u.pn * 256) * ldb; } };

__device__ __forceinline__ u32x4 pack8(const f32x4 a, const f32x4 b) { u32x4 w; w.x = cvtpk(a[0], a[1]); w.y = cvtpk(a[2], a[3]); w.z = cvtpk(b[0], b[1]); w.w = cvtpk(b[2], b[3]); return w; }
__device__ __forceinline__ void unpack8(const u32x4 w, f32x4& a, f32x4& b) { a = (f32x4){bf_lo(w.x), bf_hi(w.x), bf_lo(w.y), bf_hi(w.y)}; b = (f32x4){bf_lo(w.z), bf_hi(w.z), bf_lo(w.w), bf_hi(w.w)}; }

struct EpiInProj {
    static constexpr bool PERM = true, MIDK = false;
    unsigned char* ws; int pn0; float scl;
    __device__ __forceinline__ void operator()(const f32x4 (&acc)[2][2][4][2], const pg8::Unit& u, int wr, int wc, int fr, int fq) const {
        const int pn = u.pn + pn0; bf16* base; int ldc, colt, act;
        if (pn < 2) { base = (bf16*)(ws + WS_Q); ldc = NQ; colt = 256 * pn; act = 0; }
        else if (pn == 2) { base = (bf16*)(ws + WS_KV); ldc = NKV; colt = 0; act = 1; }
        else if (pn < 5) { base = (bf16*)(ws + WS_GU); ldc = GMW; colt = 256 * (pn - 3); act = 2; }
        else if (pn < 7) { base = (bf16*)(ws + WS_GV); ldc = GMW; colt = 256 * (pn - 5); act = 2; }
        else if (pn < 11) { base = (bf16*)(ws + WS_GA); ldc = D; colt = 256 * (pn - 7); act = 3; }
        else { base = (bf16*)(ws + WS_GB); ldc = D; colt = 256 * (pn - 11); act = 4; }
        const int row0 = u.pm * 256 + wr * 64 + fr, col0 = colt + wc * 32 + 8 * fq;
#pragma unroll
        for (int ai = 0; ai < 2; ++ai)
#pragma unroll
            for (int m = 0; m < 4; ++m) { bf16* rowp = base + (size_t)(row0 + ai * 128 + m * 16) * ldc + col0;
#pragma unroll
                for (int bj = 0; bj < 2; ++bj) { f32x4 v0 = acc[ai][bj][m][0], v1 = acc[ai][bj][m][1];
                    if (act == 0) { v0 = v0 * QSCALE; v1 = v1 * QSCALE; }
                    else if (act == 2) {
#pragma unroll
                        for (int q = 0; q < 4; ++q) { v0[q] = gelu_tanh_f(v0[q]); v1[q] = gelu_tanh_f(v1[q]); } }
                    else if (act >= 3) {
                        const float kx = -LOG2E * scl, lo = act == 4 ? 1.0f : 0.0f; unsigned wx = 0u, wy = 0u;
#pragma unroll
                        for (int q = 0; q < 4; ++q) {
                            const float c0 = fmaxf(__builtin_amdgcn_rcpf(__builtin_fmaf(__builtin_amdgcn_exp2f(acc[ai][bj][m][0][q] * kx), 1.0f / 255.0f, 1.0f / 255.0f)), lo);
                            const float c1 = fmaxf(__builtin_amdgcn_rcpf(__builtin_fmaf(__builtin_amdgcn_exp2f(acc[ai][bj][m][1][q] * kx), 1.0f / 255.0f, 1.0f / 255.0f)), lo);
                            wx = __builtin_amdgcn_cvt_pk_u8_f32(c0, q, wx); wy = __builtin_amdgcn_cvt_pk_u8_f32(c1, q, wy); }
                        u32x2 w; w.x = wx; w.y = wy;
                        *(GAS u32x2*)((unsigned char*)base + (size_t)(row0 + ai * 128 + m * 16) * ldc + col0 + bj * 128) = w; continue; }
                    *(GAS u32x4*)(rowp + bj * 128) = pack8(v0, v1); } }
    }
};
struct EpiMerge {
    static constexpr bool PERM = true, MIDK = true;
    const unsigned char* GA; const unsigned char* GB; bf16* MG;
    __device__ __forceinline__ void mid(f32x4 (&acc)[2][2][4][2], const pg8::Unit& u, int wr, int wc, int fr_, int fq) const {
        int fr = fr_; asm volatile("" : "+v"(fr));
        const int row0 = u.pm * 256 + wr * 64 + fr, col0 = u.pn * 256 + wc * 32 + 8 * fq;
#pragma unroll
        for (int ai = 0; ai < 2; ++ai) {
            u32x2 ga[4][2], gb[4][2];
#pragma unroll
            for (int m = 0; m < 4; ++m)
#pragma unroll
                for (int bj = 0; bj < 2; ++bj) { const size_t off = (size_t)(row0 + ai * 128 + m * 16) * D + col0 + bj * 128; ga[m][bj] = *(const GAS u32x2*)(GA + off); gb[m][bj] = *(const GAS u32x2*)(GB + off); }
#pragma unroll
            for (int m = 0; m < 4; ++m)
#pragma unroll
                for (int bj = 0; bj < 2; ++bj) { f32x4 a0, a1, b0, b1; unpack8_u8(ga[m][bj], a0, a1); unpack8_u8(gb[m][bj], b0, b1);
#pragma unroll
                    for (int q = 0; q < 4; ++q) { acc[ai][bj][m][0][q] *= a0[q] * __builtin_amdgcn_rcpf(b0[q]); acc[ai][bj][m][1][q] *= a1[q] * __builtin_amdgcn_rcpf(b1[q]); } }
            asm volatile("" ::: "memory");
        }
    }
    __device__ __forceinline__ void operator()(const f32x4 (&acc)[2][2][4][2], const pg8::Unit& u, int wr, int wc, int fr, int fq) const {
        const int row0 = u.pm * 256 + wr * 64 + fr, col0 = u.pn * 256 + wc * 32 + 8 * fq;
        u32x2 gb[2][4][2];
#pragma unroll
        for (int ai = 0; ai < 2; ++ai)
#pragma unroll
            for (int m = 0; m < 4; ++m)
#pragma unroll
                for (int bj = 0; bj < 2; ++bj) gb[ai][m][bj] = *(const GAS u32x2*)(GB + (size_t)(row0 + ai * 128 + m * 16) * D + col0 + bj * 128);
#pragma unroll
        for (int ai = 0; ai < 2; ++ai)
#pragma unroll
            for (int m = 0; m < 4; ++m) { const size_t off = (size_t)(row0 + ai * 128 + m * 16) * D + col0;
#pragma unroll
                for (int bj = 0; bj < 2; ++bj) { f32x4 b0, b1; unpack8_u8(gb[ai][m][bj], b0, b1);
                    *(GAS u32x4*)(MG + off + bj * 128) = pack8(acc[ai][bj][m][0] * b0 * (1.0f / 255.0f), acc[ai][bj][m][1] * b1 * (1.0f / 255.0f)); } }
    }
};
struct EpiWo {
    static constexpr bool PERM = true, MIDK = false;
    const float* x; const float* mod; bf16* XM;
    __device__ __forceinline__ void operator()(const f32x4 (&acc)[2][2][4][2], const pg8::Unit& u, int wr, int wc, int fr, int fq) const {
        const int row0 = u.pm * 256 + wr * 64 + fr, col0 = u.pn * 256 + wc * 32 + 8 * fq, b = u.pm >> 4;
        f32x4 g[2][2];
#pragma unroll
        for (int bj = 0; bj < 2; ++bj)
#pragma unroll
            for (int n = 0; n < 2; ++n) g[bj][n] = *(const GAS f32x4*)(mod + (size_t)b * 6 * D + 2 * D + col0 + bj * 128 + 4 * n);
#pragma unroll
        for (int ai = 0; ai < 2; ++ai) {
            f32x4 xv[4][2][2];
#pragma unroll
            for (int m = 0; m < 4; ++m)
#pragma unroll
                for (int bj = 0; bj < 2; ++bj)
#pragma unroll
                    for (int n = 0; n < 2; ++n) xv[m][bj][n] = __builtin_nontemporal_load((const GAS f32x4*)(x + (size_t)(row0 + ai * 128 + m * 16) * D + col0 + bj * 128 + 4 * n));
#pragma unroll
            for (int m = 0; m < 4; ++m) { const size_t off = (size_t)(row0 + ai * 128 + m * 16) * D + col0;
#pragma unroll
                for (int bj = 0; bj < 2; ++bj) *(GAS u32x4*)(XM + off + bj * 128) = pack8(xv[m][bj][0] + g[bj][0] * acc[ai][bj][m][0], xv[m][bj][1] + g[bj][1] * acc[ai][bj][m][1]); }
            asm volatile("" ::: "memory");
        }
    }
};
struct EpiGateUp {
    static constexpr bool PERM = true, MIDK = false;
    unsigned char* H;
    __device__ __forceinline__ void operator()(const f32x4 (&acc)[2][2][4][2], const pg8::Unit& u, int wr, int wc, int fr, int fq) const {
        const int row0 = u.pm * 256 + wr * 64 + fr, col0 = u.pn * 128 + wc * 32 + 8 * fq;
#pragma unroll
        for (int ai = 0; ai < 2; ++ai)
#pragma unroll
            for (int m = 0; m < 4; ++m) { f32x4 v0, v1;
#pragma unroll
                for (int q = 0; q < 4; ++q) { constexpr float is = 1.0f / WGU_SCALE, k1 = -LOG2E * is, is2 = is * is;
                    v0[q] = acc[ai][0][m][0][q] * acc[ai][1][m][0][q] * (is2 * __builtin_amdgcn_rcpf(1.0f + __builtin_amdgcn_exp2f(acc[ai][0][m][0][q] * k1)));
                    v1[q] = acc[ai][0][m][1][q] * acc[ai][1][m][1][q] * (is2 * __builtin_amdgcn_rcpf(1.0f + __builtin_amdgcn_exp2f(acc[ai][0][m][1][q] * k1))); }
                *(GAS u32x2*)(H + (size_t)(row0 + ai * 128 + m * 16) * DEXP + col0) = pack8_fp8(v0, v1); }
    }
};
struct EpiDown {
    static constexpr bool PERM = true, MIDK = false;
    const unsigned* lrow; const float* lw; bf16* YT; const LAS unsigned* tab;
    __device__ __forceinline__ void operator()(const f32x4 (&acc)[2][2][4][2], const pg8::Unit& u, int wr, int wc, int fr, int fq) const {
        const int col0 = u.pn * 256 + wc * 32 + 8 * fq, lt0 = u.pn  ; (void)lt0;
        const int e = u.e & 63, cnt = u.e >> 6;
        unsigned ent[2][4]; float w[2][4];
#pragma unroll
        for (int ai = 0; ai < 2; ++ai)
#pragma unroll
            for (int m = 0; m < 4; ++m) { const int r = ai * 128 + wr * 64 + m * 16 + fr, li = u.v + r; const int lc = li < cnt ? li : 0;
                if (u.ui < 7) { const u32x2 t = *(const LAS u32x2*)(tab + 2 * (u.ui * 256 + r)); ent[ai][m] = t.x; w[ai][m] = __uint_as_float(t.y); }
                else { ent[ai][m] = lrow[(size_t)e * LIST_CAP + lc]; w[ai][m] = lw[(size_t)e * LIST_CAP + lc] * (1.0f / WD_SCALE); } }
#pragma unroll
        for (int ai = 0; ai < 2; ++ai)
#pragma unroll
            for (int m = 0; m < 4; ++m) { const int li = u.v + ai * 128 + wr * 64 + m * 16 + fr;
                if (li < cnt) { bf16* dst = YT + (size_t)ent[ai][m] * D + col0;
#pragma unroll
                    for (int bj = 0; bj < 2; ++bj) *(GAS u32x4*)(dst + bj * 128) = pack8(acc[ai][bj][m][0] * w[ai][m], acc[ai][bj][m][1] * w[ai][m]); } }
    }
};
struct MoeOrder {
    const LAS int* utab; int n;
    __device__ __forceinline__ bool next(int i, pg8::Unit& u) const { if (i >= n) return false;
        u.pm = __builtin_amdgcn_readfirstlane(utab[4 * i]); u.pn = __builtin_amdgcn_readfirstlane(utab[4 * i + 1]); u.v = __builtin_amdgcn_readfirstlane(utab[4 * i + 2]); u.e = __builtin_amdgcn_readfirstlane(utab[4 * i + 3]); u.ui = i; return true; }
};
__device__ __forceinline__ int moe_tables(Frame& F, bool rows) {
    LAS int* utab = (LAS int*)(F.lds + TAB_UNITS); LAS int* cnts = (LAS int*)(F.lds + TAB_CNT); LAS int* nun = cnts + 72;
    LAS unsigned* rowtab = (LAS unsigned*)(F.lds + TAB_ROWS);
    __syncthreads();
    if (rows || MK_N_LAUNCHES != 1) {
        if (F.tid < 64) {
            const int lane = F.tid, c = lane < 32 ? (int)__hip_atomic_load(F.ctl + CW_CNT + 64 * lane, RLX_AGENT) : 0, tiles = (c + 255) >> 8;
            int x = tiles;
#pragma unroll
            for (int o = 1; o < 32; o <<= 1) { const int y = __shfl_up(x, o); if (lane >= o) x += y; }
            const int excl = x - tiles, total = __shfl(x, 31) * 4;
            int n = 0;
            for (int i = 0; i < MAX_WG_UNITS; ++i) { const int L = i * F.G + F.vcu; if (L >= total) break;
                const int rt = L >> 2, pn = L & 3;
                const unsigned long long m = __ballot(lane < 32 && excl <= rt && rt < excl + tiles);
                const int e = m ? __builtin_ctzll(m) : 0, ce = __shfl(c, e), lt = rt - __shfl(excl, e);
                if (lane == 0) { utab[4 * i] = rt; utab[4 * i + 1] = pn; utab[4 * i + 2] = lt * 256; utab[4 * i + 3] = e | (ce << 6); }
                ++n; }
            if (lane == 0) nun[0] = n;
        }
        __syncthreads();
    }
    const int n = nun[0];
    if (rows) {
        const unsigned* lrow = (const unsigned*)(F.ws + WS_LROW);
        for (int q = F.tid; q < n * 256; q += 512) { const int i = q >> 8, r = q & 255, e = utab[4 * i + 3] & 63, cnt = utab[4 * i + 3] >> 6, li = utab[4 * i + 2] + r;
            const unsigned tok = li < cnt ? (lrow[(size_t)e * LIST_CAP + li] >> 1) : 0u; rowtab[q] = tok * (unsigned)D; }
    } else {
        const unsigned* lrow = (const unsigned*)(F.ws + WS_LROW); const float* lw = (const float*)(F.ws + WS_LW);
        for (int q = F.tid; q < n * 256 && q < 7 * 256; q += 512) { const int i = q >> 8, r = q & 255, e = utab[4 * i + 3] & 63, cnt = utab[4 * i + 3] >> 6, li = utab[4 * i + 2] + r, lc = li < cnt ? li : 0;
            rowtab[2 * q] = lrow[(size_t)e * LIST_CAP + lc]; rowtab[2 * q + 1] = __float_as_uint(lw[(size_t)e * LIST_CAP + lc] * (1.0f / WD_SCALE)); }
    }
    __syncthreads();
    return n;
}

constexpr int KCH = 4112;
constexpr int AT_K = 0, AT_V = 8 * KCH  , AT_POS = AT_V + 32768, AT_TAB = AT_POS + 1024  , AT_TABT = AT_TAB + 4 * 132 * 4  ,
              AT_OST = 72704  , AT_END = AT_OST + 8 * 4096;
static_assert(AT_TABT + 4 * 200 * 4 <= AT_OST, "attention LDS");
static_assert(AT_END <= RING_BYTES, "attention LDS");
__device__ __forceinline__ int crow(int r, int hi) { return (r & 3) + 8 * (r >> 2) + 4 * hi; }
__device__ __forceinline__ s16x4 vtr(const LAS unsigned char* p) { typedef short v4i16_t __attribute__((ext_vector_type(4))); return __builtin_bit_cast(s16x4, __builtin_amdgcn_ds_read_tr16_b64_v4i16((LAS v4i16_t*)p)); }
__device__ __forceinline__ bf16x8 mk8(const s16x4 lo, const s16x4 hi) { return (bf16x8){lo[0], lo[1], lo[2], lo[3], hi[0], hi[1], hi[2], hi[3]}; }

__device__ __forceinline__ void attn_unit(Frame& F, const Args& A, int b, int blk, int kvh) {
    int tid = F.tid; asm volatile("" : "+v"(tid));
    const int lane = tid & 63, wid = F.wave, r32 = lane & 31, hi = lane >> 5;
    LAS unsigned char* L = F.lds + RING_OFF;
    const bf16* Q = (const bf16*)(F.ws + WS_Q); const bf16* KV = (const bf16*)(F.ws + WS_KV); bf16* YAB = (bf16*)(F.ws + WS_YAB);
    const int r0 = b * SEQ + blk * 128, rp = blk > 0 ? r0 - 128 : r0;
    __syncthreads();
#pragma unroll
    for (int j = 0; j < 4; ++j) { const int p = tid + 512 * j, key = p >> 3, c = p & 7; const int grow = key < 128 ? rp + key : r0 + key - 128;
        const u32x4 kk = *(const GAS u32x4*)(KV + (size_t)grow * NKV + kvh * 64 + c * 8);
        const u32x4 vv = *(const GAS u32x4*)(KV + (size_t)grow * NKV + 128 + kvh * 64 + c * 8);
        *(LAS u32x4*)(L + AT_K + c * KCH + key * 16) = kk;
        *(LAS u32x4*)(L + AT_V + ((key >> 4) * 2 + (c >> 2)) * 1024 + (key & 15) * 64 + (c & 3) * 16) = vv; }
    if (tid < 256) { const int grow = tid < 128 ? rp + tid : r0 + tid - 128; ((LAS int*)(L + AT_POS))[tid] = ((const int*)A.in[I_POS])[grow]; }
    if (tid < 200) { int n = tid - 36; n = n < 0 ? 0 : (n > 128 ? 128 : n); int bucket;
        if (n < 16) bucket = n; else { const int lg = (int)(logf((float)n / 16.0f) / logf(8.0f) * 16.0f); bucket = 16 + lg; if (bucket > 31) bucket = 31; }
#pragma unroll
        for (int g = 0; g < 4; ++g) { const float v = A.in[I_RELB][bucket * 8 + kvh * 4 + g] * LOG2E; ((LAS float*)(L + AT_TABT))[g * 200 + tid] = v; if (tid >= 36 && tid <= 164) ((LAS float*)(L + AT_TAB))[g * 132 + tid - 36] = v; } }
    __syncthreads();
    const int toep = __syncthreads_and(tid >= 255 || (blk == 0 && tid < 128) || ((const LAS int*)(L + AT_POS))[tid + 1] - ((const LAS int*)(L + AT_POS))[tid] == 1);
    const int g = wid & 3, qh = wid >> 2, head = kvh * 4 + g;
    const float sink2 = A.in[I_SINKS][head] * LOG2E;
    const LAS float* tab = (const LAS float*)(L + AT_TAB) + g * 132;
    const LAS int* posl = (const LAS int*)(L + AT_POS);
#pragma unroll 1
    for (int s = 0; s < 2; ++s) {
        const int i0 = 64 * qh + 32 * s, T0 = i0 >> 5;
        bf16x8 qr[4];
#pragma unroll
        for (int ks = 0; ks < 4; ++ks) qr[ks] = *(const GAS bf16x8*)(Q + (size_t)(r0 + i0 + r32) * NQ + head * 64 + ks * 16 + hi * 8);
        const int pq = posl[128 + i0 + r32];
        f32x16 p[5];
#pragma unroll
        for (int j = 0; j < 5; ++j) {
            f32x16 a = {};
#pragma unroll
            for (int ks = 0; ks < 4; ++ks) { const bf16x8 kf = *(const LAS bf16x8*)(L + AT_K + (2 * ks + hi) * KCH + (32 * (T0 + j) + r32) * 16);
                a = __builtin_amdgcn_mfma_f32_32x32x16_bf16(kf, qr[ks], a, 0, 0, 0); }
            p[j] = a;
        }
        float mx = sink2;
        if (toep) {
            const LAS float* tb = (const LAS float*)(L + AT_TABT) + g * 200 + (r32 - 4 * hi + 4);
#pragma unroll
            for (int j = 0; j < 5; ++j) {
                const bool tile_dead = (blk == 0) && (T0 + j < 4);
#pragma unroll
                for (int r = 0; r < 16; ++r) { const int kl = (r & 3) + 8 * (r >> 2) + 4 * hi;
                    float sv = p[j][r] + tb[160 - 32 * j - (r & 3) - 8 * (r >> 2)];
                    bool ok = !tile_dead;
                    if (j == 0) ok = ok && (kl > r32);
                    if (j == 4) ok = ok && (kl <= r32);
                    sv = ok ? sv : -1e30f;
                    p[j][r] = sv; mx = fmaxf(mx, sv); }
            }
        } else {
#pragma unroll
        for (int j = 0; j < 5; ++j) {
            const bool tile_dead = (blk == 0) && (T0 + j < 4);
#pragma unroll
            for (int rq = 0; rq < 4; ++rq) {
                const int k0 = 32 * (T0 + j) + 8 * rq + 4 * hi;
                typedef int i32x4 __attribute__((ext_vector_type(4))); const i32x4 pk = *(const LAS i32x4*)(posl + k0);
#pragma unroll
                for (int q = 0; q < 4; ++q) { const int r = 4 * rq + q, kl = 8 * rq + 4 * hi + q;
                    const int pkv = pk[q];
                    int n = pq - pkv; n = n < 0 ? 0 : (n > 128 ? 128 : n);
                    float sv = p[j][r] + tab[n];
                    bool ok = !tile_dead;
                    if (j == 0) ok = ok && (kl > r32);
                    if (j == 4) ok = ok && (kl <= r32);
                    sv = ok ? sv : -1e30f;
                    p[j][r] = sv; mx = fmaxf(mx, sv); }
            }
        }
        }
        mx = fmaxf(mx, __shfl_xor(mx, 32));
        float l = 0.f;
#pragma unroll
        for (int j = 0; j < 5; ++j)
#pragma unroll
            for (int r = 0; r < 16; ++r) { const float e = __builtin_amdgcn_exp2f(p[j][r] - mx); p[j][r] = e; l += e; }
        l += __shfl_xor(l, 32);
        l += __builtin_amdgcn_exp2f(sink2 - mx);
        const float rl = 1.0f / l;
        f32x16 o[2]; o[0] = (f32x16){}; o[1] = (f32x16){};
        const int vlane = (4 * hi + ((lane & 15) >> 2)) * 64 + ((lane >> 4) & 1) * 32 + (lane & 3) * 8;
#pragma unroll
        for (int j = 0; j < 5; ++j)
#pragma unroll
            for (int s2 = 0; s2 < 2; ++s2) {
                u32x4 pw; pw.x = cvtpk(p[j][8 * s2 + 0] * rl, p[j][8 * s2 + 1] * rl); pw.y = cvtpk(p[j][8 * s2 + 2] * rl, p[j][8 * s2 + 3] * rl);
                pw.z = cvtpk(p[j][8 * s2 + 4] * rl, p[j][8 * s2 + 5] * rl); pw.w = cvtpk(p[j][8 * s2 + 6] * rl, p[j][8 * s2 + 7] * rl);
                const bf16x8 pa = __builtin_bit_cast(bf16x8, pw);
                const int kg = 2 * (T0 + j) + s2;
#pragma unroll
                for (int d0 = 0; d0 < 2; ++d0) { const LAS unsigned char* vp = L + AT_V + (kg * 2 + d0) * 1024 + vlane;
                    const bf16x8 vf = mk8(vtr(vp), vtr(vp + 512));
                    o[d0] = __builtin_amdgcn_mfma_f32_32x32x16_bf16(pa, vf, o[d0], 0, 0, 0); }
            }
        {
            LAS bf16* stg = (LAS bf16*)(L + AT_OST + wid * 4096);
#pragma unroll
            for (int d0 = 0; d0 < 2; ++d0)
#pragma unroll
                for (int r = 0; r < 16; ++r) stg[crow(r, hi) * 64 + 32 * d0 + r32] = (bf16)(cvtpk(o[d0][r], 0.f) & 0xffffu);
#pragma unroll
            for (int i = 0; i < 4; ++i) { const int pc = lane + 64 * i, row = pc >> 3, ch = pc & 7;
                const u32x4 v = *(const LAS u32x4*)(stg + row * 64 + ch * 8);
                *(GAS u32x4*)(YAB + (size_t)(r0 + i0 + row) * D + head * 64 + ch * 8) = v; }
        }
    }
}

__device__ __forceinline__ void gmlp_unit(Frame& F, const Args& A, int b, int ch) {
    int tid = F.tid; asm volatile("" : "+v"(tid));
    const int lane = tid & 63, wid = F.wave, r32 = lane & 31, hi = lane >> 5;
    LAS unsigned char* L = F.lds + RING_OFF;
    const bf16* GU = (const bf16*)(F.ws + WS_GU); const bf16* GV = (const bf16*)(F.ws + WS_GV); bf16* YAB = (bf16*)(F.ws + WS_YAB);
    const bf16* WST = (const bf16*)(F.ws + WS_WST);
    const int r0 = b * SEQ + ch * 128;
    const int g = wid >> 1, chalf = wid & 1;
    bf16x8 wfl[20];
#pragma unroll
    for (int tt = 0; tt < 4; ++tt)
#pragma unroll
        for (int ks = 0; ks < 8; ++ks) if (ks <= 2 * tt + 1) wfl[tt * (tt + 1) + ks] = *(const GAS bf16x8*)(WST + ((size_t)g * 128 + 32 * tt + r32) * 128 + 16 * ks + 8 * hi);
    float bin[4]; u32x4 gun[4];
#pragma unroll
    for (int i = 0; i < 4; ++i) { const int pc = lane + 64 * i; bin[i] = A.in[I_GBS][g * 128 + (pc >> 3)]; gun[i] = *(const GAS u32x4*)(GU + (size_t)(r0 + (pc >> 3)) * GMW + g * 128 + 64 * chalf + 8 * (pc & 7)); }
    __syncthreads();
    {
        const float* lg = A.in[I_LNG]; const float* lb = A.in[I_LNB];
        const f32x4 g0 = *(const GAS f32x4*)(lg + 8 * lane), g1 = *(const GAS f32x4*)(lg + 8 * lane + 4), b0 = *(const GAS f32x4*)(lb + 8 * lane), b1 = *(const GAS f32x4*)(lb + 8 * lane + 4);
        const int grp = lane >> 4, cb = (lane & 15) >> 2;
        u32x4 gvr[16];
#pragma unroll
        for (int j = 0; j < 16; ++j) gvr[j] = *(const GAS u32x4*)(GV + (size_t)(r0 + 16 * wid + j) * GMW + 8 * lane);
#pragma unroll
        for (int j = 0; j < 16; ++j) {
            f32x4 v0, v1; unpack8(gvr[j], v0, v1);
            const float mu = wave_sum((v0[0] + v0[1]) + (v0[2] + v0[3]) + (v1[0] + v1[1]) + (v1[2] + v1[3])) * (1.0f / GMW);
            v0 = v0 - mu; v1 = v1 - mu;
            const float var = wave_sum((v0[0] * v0[0] + v0[1] * v0[1]) + (v0[2] * v0[2] + v0[3] * v0[3]) + (v1[0] * v1[0] + v1[1] * v1[1]) + (v1[2] * v1[2] + v1[3] * v1[3])) * (1.0f / GMW);
            const float rstd = __builtin_amdgcn_rsqf(var + EPS);
            *(LAS u32x4*)(L + grp * 32768 + (wid * 4 + cb) * 1024 + j * 64 + (lane & 3) * 16) = pack8(v0 * rstd * g0 + b0, v1 * rstd * g1 + b1); }
    }
    __syncthreads();
    const int vlane = (8 * hi + ((lane & 15) >> 2)) * 64 + ((lane >> 4) & 1) * 32 + (lane & 3) * 8;
    bf16x8 bfr[2][8];
#pragma unroll
    for (int ct = 0; ct < 2; ++ct)
#pragma unroll
        for (int ks = 0; ks < 8; ++ks) { const LAS unsigned char* vp = L + g * 32768 + (ks * 4 + 2 * chalf + ct) * 1024 + vlane; bfr[ct][ks] = mk8(vtr(vp), vtr(vp + 256)); }
    __syncthreads();
    LAS float* stg = (LAS float*)(L + wid * (32 * 68 * 4));
#pragma unroll
    for (int tt = 0; tt < 4; ++tt) {
        f32x16 acc[2]; acc[0] = (f32x16){}; acc[1] = (f32x16){};
#pragma unroll
        for (int ks = 0; ks < 8; ++ks) if (ks <= 2 * tt + 1) {
            acc[0] = __builtin_amdgcn_mfma_f32_32x32x16_bf16(wfl[tt * (tt + 1) + ks], bfr[0][ks], acc[0], 0, 0, 0);
            acc[1] = __builtin_amdgcn_mfma_f32_32x32x16_bf16(wfl[tt * (tt + 1) + ks], bfr[1][ks], acc[1], 0, 0, 0); }
#pragma unroll
        for (int ct = 0; ct < 2; ++ct)
#pragma unroll
            for (int r = 0; r < 16; ++r) stg[crow(r, hi) * 68 + 32 * ct + r32] = acc[ct][r];
        u32x4 gu[4]; float bi[4];
#pragma unroll
        for (int i = 0; i < 4; ++i) { gu[i] = gun[i]; bi[i] = bin[i]; }
        if (tt < 3) {
#pragma unroll
            for (int i = 0; i < 4; ++i) { const int pc = lane + 64 * i; bin[i] = A.in[I_GBS][g * 128 + 32 * (tt + 1) + (pc >> 3)];
                gun[i] = *(const GAS u32x4*)(GU + (size_t)(r0 + 32 * (tt + 1) + (pc >> 3)) * GMW + g * 128 + 64 * chalf + 8 * (pc & 7)); } }
#pragma unroll
        for (int i = 0; i < 4; ++i) { const int pc = lane + 64 * i, row = pc >> 3, chn = pc & 7, t = 32 * tt + row, c = g * 128 + 64 * chalf + 8 * chn;
            const f32x4 s0 = *(const LAS f32x4*)(stg + row * 68 + 8 * chn), s1 = *(const LAS f32x4*)(stg + row * 68 + 8 * chn + 4);
            const float bb = bi[i]; f32x4 u0, u1; unpack8(gu[i], u0, u1);
            *(GAS u32x4*)(YAB + (size_t)(r0 + t) * D + NQ + c) = pack8(u0 * (s0 + bb), u1 * (s1 + bb)); }
    }
}

__device__ __forceinline__ void router_images(Frame& F, const Args& A) {
    const float* mod = (const float*)(F.ws + WS_MOD); bf16* GT = (bf16*)(F.ws + WS_GT); float* GC = (float*)(F.ws + WS_GC);
    LAS float* red = (LAS float*)(F.lds + RING_OFF);
    for (int it = F.vcu; it < 8 * 48; it += F.G) { const int b = it / 48, n = it % 48; float part = 0.f;
#pragma unroll
        for (int cc = 0; cc < 2; ++cc) { const int c = F.tid + 512 * cc;
            const float sh = mod[(size_t)b * 6 * D + 3 * D + c], sc = mod[(size_t)b * 6 * D + 4 * D + c], a2 = A.in[I_N2G][c] * (1.0f + sc);
            const float w = n < 4 ? A.in[I_WRG][(size_t)c * 4 + n] : (n < 36 ? A.in[I_WRE][(size_t)c * 32 + (n - 4)] : 0.f);
            GT[((size_t)b * 48 + n) * D + c] = (bf16)(cvtpk(a2 * w, 0.f) & 0xffffu); part += sh * w; }
        part = wave_sum(part);
        __syncthreads(); if (F.lane == 0) red[F.wave] = part; __syncthreads();
        if (F.tid == 0) { float s = n < 4 ? A.in[I_BRG][n] : (n < 36 ? A.in[I_BRE][n - 4] : 0.f);
#pragma unroll
            for (int w = 0; w < 8; ++w) s += red[w];
            GC[b * 48 + n] = s; }
    }
}

constexpr int GT_STRIDE = 2064;
constexpr int R6_GT = 0, R6_A2 = 48 * GT_STRIDE  , R6_B2 = R6_A2 + 4096, R6_CONST = R6_B2 + 4096, R6_LCNT = R6_CONST + 256, R6_LBASE = R6_LCNT + 128, R6_RED = R6_LBASE + 128, R6_LOG = R6_RED + 8 * 40 * 4, R6_END = R6_LOG + 8 * 16 * 40 * 4;
static_assert(R6_END <= RING_BYTES, "router LDS");
__device__ __forceinline__ void p6_router(Frame& F, const Args& A) {
    const int wid = F.wave;
    LAS unsigned char* L = F.lds + RING_OFF;
    const float* mod = (const float*)(F.ws + WS_MOD);
    const bf16* XM = (const bf16*)(F.ws + WS_XMID); unsigned char* H2 = (unsigned char*)(F.ws + WS_H2);
    unsigned* lrow = (unsigned*)(F.ws + WS_LROW); float* lw = (float*)(F.ws + WS_LW);
    LAS float* A2 = (LAS float*)(L + R6_A2); LAS float* B2 = (LAS float*)(L + R6_B2); LAS float* cst = (LAS float*)(L + R6_CONST);
    LAS int* lcnt = (LAS int*)(L + R6_LCNT); LAS int* lbase = (LAS int*)(L + R6_LBASE); LAS float* red = (LAS float*)(L + R6_RED);
    LAS float* lg = (LAS float*)(L + R6_LOG) + wid * 16 * 40;
    for (int rb = F.vcu; rb < M / 128; rb += F.G) {
        const int b = rb / (SEQ / 128);
        int tid = F.tid; asm volatile("" : "+v"(tid)); const int lane = tid & 63;
        const int rloc = lane & 15, kq = lane >> 4, row = rb * 128 + wid * 16 + rloc;
        u32x4 xk[32];
#pragma unroll
        for (int ks = 0; ks < 32; ++ks) xk[ks] = *(const GAS u32x4*)(XM + (size_t)row * D + 32 * ks + 8 * kq);
        asm volatile("" ::: "memory");
        __syncthreads();
        {
            const bf16* GTb = (const bf16*)(F.ws + WS_GT) + (size_t)b * 48 * D;
            u32x4 gt[12];
#pragma unroll
            for (int i = 0; i < 12; ++i) gt[i] = *(const GAS u32x4*)(GTb + (size_t)(tid + 512 * i) * 8);
#pragma unroll
            for (int cc = 0; cc < 2; ++cc) { const int c = tid + 512 * cc; A2[c] = A.in[I_N2G][c] * (1.0f + mod[(size_t)b * 6 * D + 4 * D + c]); B2[c] = mod[(size_t)b * 6 * D + 3 * D + c]; }
            if (tid < 48) cst[tid] = ((const float*)(F.ws + WS_GC))[b * 48 + tid];
            if (tid < 32) lcnt[tid] = 0;
#pragma unroll
            for (int i = 0; i < 12; ++i) { const int pc = tid + 512 * i, n = pc >> 7, ch = pc & 127; *(LAS u32x4*)(L + R6_GT + n * GT_STRIDE + ch * 16) = gt[i]; }
        }
        __syncthreads();
        float ss = 0.f;
#pragma unroll
        for (int ks = 0; ks < 32; ++ks) { f32x4 a, c; unpack8(xk[ks], a, c); ss += (a[0] * a[0] + a[1] * a[1]) + (a[2] * a[2] + a[3] * a[3]) + (c[0] * c[0] + c[1] * c[1]) + (c[2] * c[2] + c[3] * c[3]); }
        ss += __shfl_xor(ss, 16); ss += __shfl_xor(ss, 32);
        const float rinv = 1.0f / sqrtf(ss * (1.0f / D) + EPS);
        f32x4 acc[3]; acc[0] = (f32x4){0.f, 0.f, 0.f, 0.f}; acc[1] = acc[0]; acc[2] = acc[0];
#pragma unroll
        for (int ks = 0; ks < 32; ++ks) { const bf16x8 af = __builtin_bit_cast(bf16x8, xk[ks]);
#pragma unroll
            for (int nt = 0; nt < 3; ++nt) { const bf16x8 bfg = *(const LAS bf16x8*)(L + R6_GT + (16 * nt + rloc) * GT_STRIDE + (32 * ks + 8 * kq) * 2);
                acc[nt] = __builtin_amdgcn_mfma_f32_16x16x32_bf16(af, bfg, acc[nt], 0, 0, 0); }
            if ((ks & 3) == 3) asm volatile("" ::: "memory"); }
#pragma unroll
        for (int nt = 0; nt < 3; ++nt) { const int n = 16 * nt + rloc; if (n < 36) {
#pragma unroll
            for (int q = 0; q < 4; ++q) lg[(4 * kq + q) * 40 + n] = acc[nt][q]; } }
#pragma unroll
        for (int ks = 0; ks < 32; ++ks) asm volatile("" : "+v"(xk[ks]));
#pragma unroll
        for (int ks = 0; ks < 32; ++ks) { const int c0 = 32 * ks + 8 * kq; f32x4 a, c; unpack8(xk[ks], a, c);
            const f32x4 a0 = *(const LAS f32x4*)(A2 + c0), a1 = *(const LAS f32x4*)(A2 + c0 + 4), b0 = *(const LAS f32x4*)(B2 + c0), b1 = *(const LAS f32x4*)(B2 + c0 + 4);
            *(GAS u32x2*)(H2 + (size_t)row * D + c0) = pack8_fp8(a * rinv * a0 + b0, c * rinv * a1 + b1);
            if ((ks & 3) == 3) asm volatile("" ::: "memory"); }
        LDS_WAIT(); asm volatile("" ::: "memory");
        int e1 = 0, e2 = 0, lp1 = 0, lp2 = 0; float w1 = 0.f, w2 = 0.f;
        if (lane < 16) {
            const LAS float* lr = lg + lane * 40;
            float l0[4]; int gi = 0;
#pragma unroll
            for (int n = 0; n < 4; ++n) l0[n] = lr[n] * rinv + cst[n];
            float gm = l0[0];
#pragma unroll
            for (int n = 1; n < 4; ++n) if (l0[n] > gm) { gm = l0[n]; gi = n; }
            float gs = 0.f;
#pragma unroll
            for (int n = 0; n < 4; ++n) gs += __expf(l0[n] - gm);
            const float pg = 1.0f / gs;
            float le[8];
#pragma unroll
            for (int j = 0; j < 8; ++j) le[j] = lr[4 + 8 * gi + j] * rinv + cst[4 + 8 * gi + j];
            int i1 = 0; float m1 = le[0];
#pragma unroll
            for (int j = 1; j < 8; ++j) if (le[j] > m1) { m1 = le[j]; i1 = j; }
            int i2 = -1; float m2 = -INFINITY;
#pragma unroll
            for (int j = 0; j < 8; ++j) if (j != i1 && le[j] > m2) { m2 = le[j]; i2 = j; }
            const float ex = __expf(m2 - m1); const float t1 = 1.0f / (1.0f + ex);
            w1 = pg * t1; w2 = pg * (ex * t1);
            if (i2 < 0) i2 = (i1 + 1) & 7;
            e1 = gi * 8 + i1; e2 = gi * 8 + i2;
            lp1 = atomicAdd((int*)&lcnt[e1], 1); lp2 = atomicAdd((int*)&lcnt[e2], 1);
        }
        __syncthreads();
        if (tid < 32) { const int c = lcnt[tid]; lbase[tid] = c > 0 ? (int)__hip_atomic_fetch_add(F.ctl + CW_CNT + 64 * tid, (unsigned)c, RLX_AGENT) : 0; }
        __syncthreads();
        if (lane < 16) {
            const int p1 = lbase[e1] + lp1, p2 = lbase[e2] + lp2;
            lrow[(size_t)e1 * LIST_CAP + p1] = (unsigned)row * 2u; lw[(size_t)e1 * LIST_CAP + p1] = w1;
            lrow[(size_t)e2 * LIST_CAP + p2] = (unsigned)row * 2u + 1u; lw[(size_t)e2 * LIST_CAP + p2] = w2;
#if DEBUG_CHECKS
            { float* rec = (float*)(F.ws + 490 * MiB) + (size_t)row * 4; rec[0] = (float)e1; rec[1] = (float)e2; rec[2] = w1; rec[3] = w2; }
#endif
        }
    }
}

__device__ __forceinline__ void p9_final(Frame& F, const Args& A) {
    const int lane = F.lane, wid = F.wave;
    const float* mod = (const float*)(F.ws + WS_MOD); const bf16* XM = (const bf16*)(F.ws + WS_XMID); const bf16* YT = (const bf16*)(F.ws + WS_YT);
    for (int rb = F.vcu; rb < M / 128; rb += F.G) {
        const int b = rb / (SEQ / 128);
        f32x4 g2[2][2], fg[2][2];
#pragma unroll
        for (int jj = 0; jj < 2; ++jj)
#pragma unroll
            for (int q = 0; q < 2; ++q) { const int c = 512 * jj + 8 * lane + 4 * q; g2[jj][q] = *(const GAS f32x4*)(mod + (size_t)b * 6 * D + 5 * D + c); fg[jj][q] = *(const GAS f32x4*)(A.in[I_FG] + c); }
#pragma unroll 1
        for (int j0 = 0; j0 < 16; j0 += 4) {
            u32x4 xm[4][2], y0[4][2], y1[4][2];
#pragma unroll
            for (int jr = 0; jr < 4; ++jr) { const int row = rb * 128 + wid * 16 + j0 + jr;
#pragma unroll
                for (int jj = 0; jj < 2; ++jj) { const int c = 512 * jj + 8 * lane;
                    xm[jr][jj] = __builtin_nontemporal_load((const GAS u32x4*)(XM + (size_t)row * D + c));
                    y0[jr][jj] = __builtin_nontemporal_load((const GAS u32x4*)(YT + (size_t)row * 2 * D + c));
                    y1[jr][jj] = __builtin_nontemporal_load((const GAS u32x4*)(YT + (size_t)row * 2 * D + D + c)); } }
#pragma unroll
            for (int jr = 0; jr < 4; ++jr) { const int row = rb * 128 + wid * 16 + j0 + jr;
                f32x4 v[2][2]; float ss = 0.f;
#pragma unroll
                for (int jj = 0; jj < 2; ++jj) { f32x4 x0, x1, a0, a1, z0, z1;
                    unpack8(xm[jr][jj], x0, x1); unpack8(y0[jr][jj], a0, a1); unpack8(y1[jr][jj], z0, z1);
                    v[jj][0] = x0 + g2[jj][0] * (a0 + z0); v[jj][1] = x1 + g2[jj][1] * (a1 + z1);
#pragma unroll
                    for (int q = 0; q < 2; ++q) ss += (v[jj][q][0] * v[jj][q][0] + v[jj][q][1] * v[jj][q][1]) + (v[jj][q][2] * v[jj][q][2] + v[jj][q][3] * v[jj][q][3]); }
                const float rinv = 1.0f / sqrtf(wave_sum(ss) * (1.0f / D) + EPS);
#pragma unroll
                for (int jj = 0; jj < 2; ++jj)
#pragma unroll
                    for (int q = 0; q < 2; ++q) __builtin_nontemporal_store(v[jj][q] * rinv * fg[jj][q], (GAS f32x4*)(A.out + (size_t)row * D + 512 * jj + 8 * lane + 4 * q)); }
        }
    }
}

__global__ void __launch_bounds__(NWAVES * 64, 2) mk_fwd(Args args) {
    extern __shared__ __attribute__((aligned(16))) unsigned char lds[];
    Frame F;
    F.lds = (LAS unsigned char*)lds;
    F.MISC = (volatile LAS unsigned*)(F.lds + MISC_OFF);
    F.tid = threadIdx.x; F.lane = F.tid & 63; F.wave = __builtin_amdgcn_readfirstlane(F.tid >> 6);
    F.G = gridDim.x; { const int bx = blockIdx.x; F.vcu = (F.G % 8 == 0) ? (bx % 8) * (F.G / 8) + bx / 8 : bx; }
    F.ws = args.ws; F.ctl = (gu32*)(args.ws + WS_CTL);
    for (int u = F.tid; u < (TAB_OFF - LDSCTL_OFF) / 4; u += NWAVES * 64) ((LAS unsigned*)(F.lds + LDSCTL_OFF))[u] = 0u;
    __syncthreads();
    XcdBarrier bar; bar.bar = (unsigned*)(F.ctl + CW_BAR); bar.x = 0; bar.st = nullptr;
    if (MK_N_LAUNCHES == 1) bar = xcd_barrier_post((unsigned*)(F.ctl + CW_BAR), F.MISC + 8);
#define GRID_BAR() do { if (MK_N_LAUNCHES == 1) xcd_barrier(bar); } while (0)
    const int lo = args.ph_lo, hi = args.ph_hi;
#ifdef ONLY_PHASE
#define IN(k) ((k) == ONLY_PHASE && lo <= (k) && (k) < hi)
#else
#define IN(k) (lo <= (k) && (k) < hi)
#endif
#define BOTH(k) (IN(k) && IN((k) + 1))

    if (IN(0)) { p0_prologue(F, args); if (BOTH(0)) GRID_BAR(); }
    if (IN(1)) { p1_h1(F, args); if (BOTH(1)) GRID_BAR(); }
    if (IN(2)) {
        const bool fp8_first = (blockIdx.x & 1) != 0;
#define P2_BF16() do { ProbDense P{D * 2, D * 2u, D * 2u, (const char*)(F.ws + WS_A), (const char*)(F.ws + WS_WIN), nullptr}; \
            pg8::DenseOrder S; S.init(M, NBF, F.G, (int)blockIdx.x); EpiInProj E{F.ws, 0, 1.0f}; \
            pg8::gemm_phase<ProbDense, EpiInProj, pg8::DenseOrder, true>(F.lds + RING_OFF, P, S, E); } while (0)
#define P2_FP8() do { ProbDense8 P{D, (unsigned)D, (unsigned)D, (const char*)(F.ws + WS_H1F8), (const char*)(F.ws + WS_WIN8), nullptr}; \
            pg8::BackfillOrder S; S.init(M, INW - NBF, F.G, (int)blockIdx.x); EpiInProj E{F.ws, NBF / 256, 1.0f / WGU_SCALE}; \
            pg8::gemm_phase<ProbDense8, EpiInProj, pg8::BackfillOrder, true>(F.lds + RING_OFF, P, S, E); } while (0)
        if (fp8_first) { P2_FP8(); P2_BF16(); } else { P2_BF16(); P2_FP8(); }
#undef P2_BF16
#undef P2_FP8
        if (BOTH(2)) GRID_BAR();
    }
    if (IN(3)) {
        router_images(F, args);
        for (int ub = F.vcu; ub < M / 128; ub += F.G) { const int b = ub / (SEQ / 128), blk = ub % (SEQ / 128);

#ifndef NO_ATTN
#pragma unroll 1
            for (int kvh = 0; kvh < 2; ++kvh) attn_unit(F, args, b, blk, kvh);
            asm volatile("" ::: "memory");
#endif
#ifndef NO_GMLP
            gmlp_unit(F, args, b, blk);
#endif
        }
        __syncthreads();
        if (BOTH(3)) GRID_BAR();
    }
    if (IN(4)) {
        ProbDense P{D * 2, D * 2u, D * 2u, (const char*)(F.ws + WS_YAB), (const char*)(F.ws + WS_PA), nullptr};
        pg8::DenseOrder S; S.init(M, D, F.G, (int)blockIdx.x);
        EpiMerge E{(const unsigned char*)(F.ws + WS_GA), (const unsigned char*)(F.ws + WS_GB), (bf16*)(F.ws + WS_A)};
        pg8::gemm_phase<ProbDense, EpiMerge, pg8::DenseOrder, true>(F.lds + RING_OFF, P, S, E);
        if (BOTH(4)) GRID_BAR();
    }
    if (IN(5)) {
        ProbDense P{D * 2, D * 2u, D * 2u, (const char*)(F.ws + WS_A), (const char*)(F.ws + WS_WO), nullptr};
        pg8::DenseOrder S; S.init(M, D, F.G, (int)blockIdx.x);
        EpiWo E{args.in[I_X], (const float*)(F.ws + WS_MOD), (bf16*)(F.ws + WS_XMID)};
        pg8::gemm_phase<ProbDense, EpiWo, pg8::DenseOrder, true>(F.lds + RING_OFF, P, S, E);
        if (BOTH(5)) GRID_BAR();
    }
    if (IN(6)) { p6_router(F, args); __syncthreads(); if (BOTH(6)) GRID_BAR(); }
    if (IN(7)) {
        const int n = moe_tables(F, true);
        ProbGateUp P{D, (unsigned)D, (unsigned)D, (const char*)(F.ws + WS_H2), (const char*)(F.ws + WS_WGU), (const LAS unsigned*)(F.lds + TAB_ROWS)};
        MoeOrder S{(const LAS int*)(F.lds + TAB_UNITS), n};
        EpiGateUp E{(unsigned char*)(F.ws + WS_HACT)};
        pg8::gemm_phase<ProbGateUp, EpiGateUp, MoeOrder, true>(F.lds + RING_OFF, P, S, E);
        if (BOTH(7)) GRID_BAR();
    }
    if (IN(8)) {
        const int n = moe_tables(F, false);
        ProbDown P{DEXP, (unsigned)DEXP, (unsigned)DEXP, (const char*)(F.ws + WS_HACT), (const char*)(F.ws + WS_WD), nullptr};
        MoeOrder S{(const LAS int*)(F.lds + TAB_UNITS), n};
        EpiDown E{(const unsigned*)(F.ws + WS_LROW), (const float*)(F.ws + WS_LW), (bf16*)(F.ws + WS_YT), (const LAS unsigned*)(F.lds + TAB_ROWS)};
        pg8::gemm_phase<ProbDown, EpiDown, MoeOrder, true>(F.lds + RING_OFF, P, S, E);
        if (BOTH(8)) GRID_BAR();
    }
    if (IN(9)) { p9_final(F, args); }
#undef IN
#undef BOTH
}


#if DEBUG_CHECKS
constexpr size_t WS_DBG = 490 * MiB;
constexpr int CW_DBG = 200000;
constexpr int NSAMP = 512;
__device__ __forceinline__ int samp_row(int i) { return 64 * i + ((i * 7) & 63); }
__device__ __forceinline__ float bfr(float v) { return bf_lo(cvtpk(v, 0.f) & 0xffffu); }
__device__ __forceinline__ float ldbf(const bf16* p) { return __uint_as_float((unsigned)(*p) << 16); }
__device__ __forceinline__ float f8dec(unsigned char b) { return __builtin_amdgcn_cvt_f32_fp8((int)b, 0); }
__device__ __forceinline__ float f8r(float v) { return f8dec((unsigned char)(pk4_fp8(v, 0.f, 0.f, 0.f) & 0xffu)); }
__device__ __forceinline__ void dbg_acc(unsigned char* ws, int k, float err, float ref) { float* a = (float*)(ws + WS_CTL) + CW_DBG; atomicAdd(a + 2 * k, err * err); atomicAdd(a + 2 * k + 1, ref * ref); }
__device__ __forceinline__ float block_sum256(float v, float* sh) {
    v = wave_sum(v); __syncthreads(); if ((threadIdx.x & 63) == 0) sh[threadIdx.x >> 6] = v; __syncthreads(); const float r = sh[0] + sh[1] + sh[2] + sh[3]; __syncthreads(); return r; }
__global__ void __launch_bounds__(256) chk_h1(Args a) {
    __shared__ float sh[8];
    const int row = samp_row(blockIdx.x), b = row / SEQ, t = threadIdx.x;
    float sc[4], shf[4];
#pragma unroll
    for (int q = 0; q < 4; ++q) { sc[q] = a.in[I_BADA][D + t + 256 * q]; shf[q] = a.in[I_BADA][t + 256 * q]; }
    for (int k = 0; k < D; ++k) { const float cv = a.in[I_C][b * D + k]; const float cs = cv / (1.0f + expf(-cv));
#pragma unroll
        for (int q = 0; q < 4; ++q) { sc[q] += cs * a.in[I_WADA][(size_t)k * 6 * D + D + t + 256 * q]; shf[q] += cs * a.in[I_WADA][(size_t)k * 6 * D + t + 256 * q]; } }
    float ss = 0.f; float xv[4];
#pragma unroll
    for (int q = 0; q < 4; ++q) { xv[q] = a.in[I_X][(size_t)row * D + t + 256 * q]; ss += xv[q] * xv[q]; }
    const float rinv = 1.0f / sqrtf(block_sum256(ss, sh) / D + EPS);
    const bf16* h1 = (const bf16*)(a.ws + WS_A);
#pragma unroll
    for (int q = 0; q < 4; ++q) { const int c = t + 256 * q; const float ref = xv[q] * rinv * a.in[I_N1G][c] * (1.0f + sc[q]) + shf[q]; dbg_acc(a.ws, 0, ldbf(h1 + (size_t)row * D + c) - ref, ref); }
}
__global__ void __launch_bounds__(256) chk_inproj(Args a) {
    const int idx = blockIdx.x * 256 + threadIdx.x; if (idx >= NSAMP * INW) return;
    const int row = samp_row(idx / INW), n = idx % INW;
    const bf16* h1 = (const bf16*)(a.ws + WS_A); float s = 0.f;
    if (n < NBF) { for (int k = 0; k < D; ++k) s += ldbf(h1 + (size_t)row * D + k) * bfr(a.in[I_WIN][(size_t)k * INW + n]); }
    else { for (int k = 0; k < D; ++k) s += f8dec(((const unsigned char*)(a.ws + WS_H1F8))[(size_t)row * D + k]) * f8r(a.in[I_WIN][(size_t)k * INW + n] * WGU_SCALE); s *= 1.0f / WGU_SCALE; }
    float ref, got;
    if (n < 512) { ref = s * QSCALE; got = ldbf((const bf16*)(a.ws + WS_Q) + (size_t)row * NQ + n); }
    else if (n < 768) { ref = s; got = ldbf((const bf16*)(a.ws + WS_KV) + (size_t)row * NKV + n - 512); }
    else if (n < 1280) { ref = 0.5f * s * (1.0f + tanhf(0.7978845608f * (s + 0.044715f * s * s * s))); got = ldbf((const bf16*)(a.ws + WS_GU) + (size_t)row * GMW + n - 768); }
    else if (n < 1792) { ref = 0.5f * s * (1.0f + tanhf(0.7978845608f * (s + 0.044715f * s * s * s))); got = ldbf((const bf16*)(a.ws + WS_GV) + (size_t)row * GMW + n - 1280); }
    else if (n < 2816) { ref = 1.0f / (1.0f + expf(-s)); got = (float)((const unsigned char*)(a.ws + WS_GA))[(size_t)row * D + n - 1792] * (1.0f / 255.0f); }
    else { ref = fmaxf(1.0f / (1.0f + expf(-s)), 1.0f / 255.0f); got = (float)((const unsigned char*)(a.ws + WS_GB))[(size_t)row * D + n - 2816] * (1.0f / 255.0f); }
    dbg_acc(a.ws, 1, got - ref, ref);
}
__global__ void __launch_bounds__(256) chk_attn(Args a) {
    const int idx = blockIdx.x * 256 + threadIdx.x; if (idx >= NSAMP * 8 * 4) return;
    const int row = samp_row(idx / 32), head = (idx >> 2) & 7, dq = idx & 3, b = row / SEQ, tpos = row % SEQ, blk = tpos / 128, kvh = head >> 2;
    const bf16* Q = (const bf16*)(a.ws + WS_Q); const bf16* KV = (const bf16*)(a.ws + WS_KV); const int* pos = (const int*)a.in[I_POS];
    const int band0 = b * SEQ + blk * 128 - 128;
    const int i = tpos % 128;
    float m = a.in[I_SINKS][head], l = 0.f; float o[16];
#pragma unroll
    for (int d = 0; d < 16; ++d) o[d] = 0.f;
    for (int kj = i + 1; kj <= i + 128; ++kj) { if (blk == 0 && kj < 128) continue; const int kr = band0 + kj;
        float s = 0.f; for (int d = 0; d < 64; ++d) s += ldbf(Q + (size_t)row * NQ + head * 64 + d) * ldbf(KV + (size_t)kr * NKV + kvh * 64 + d);
        s *= (1.0f / LOG2E);
        int n = pos[row] - pos[kr]; if (n < 0) n = 0; int bucket; if (n < 16) bucket = n; else { bucket = 16 + (int)(logf((float)n / 16.0f) / logf(8.0f) * 16.0f); if (bucket > 31) bucket = 31; }
        s += a.in[I_RELB][bucket * 8 + head]; m = fmaxf(m, s); }
    for (int kj = i + 1; kj <= i + 128; ++kj) { if (blk == 0 && kj < 128) continue; const int kr = band0 + kj;
        float s = 0.f; for (int d = 0; d < 64; ++d) s += ldbf(Q + (size_t)row * NQ + head * 64 + d) * ldbf(KV + (size_t)kr * NKV + kvh * 64 + d);
        s *= (1.0f / LOG2E);
        int n = pos[row] - pos[kr]; if (n < 0) n = 0; int bucket; if (n < 16) bucket = n; else { bucket = 16 + (int)(logf((float)n / 16.0f) / logf(8.0f) * 16.0f); if (bucket > 31) bucket = 31; }
        s += a.in[I_RELB][bucket * 8 + head]; const float p = expf(s - m); l += p;
#pragma unroll
        for (int d = 0; d < 16; ++d) o[d] += p * ldbf(KV + (size_t)kr * NKV + 128 + kvh * 64 + dq * 16 + d); }
    l += expf(a.in[I_SINKS][head] - m);
    const bf16* yab = (const bf16*)(a.ws + WS_YAB);
#pragma unroll
    for (int d = 0; d < 16; ++d) { const float ref = o[d] / l; dbg_acc(a.ws, 2, ldbf(yab + (size_t)row * D + head * 64 + dq * 16 + d) - ref, ref); }
}
__global__ void __launch_bounds__(512) chk_gmlp(Args a) {
    __shared__ float sh[16];
    const int row = samp_row(blockIdx.x), c = threadIdx.x, g = c >> 7, r0 = row & ~127, t = row & 127;
    const bf16* GU = (const bf16*)(a.ws + WS_GU); const bf16* GV = (const bf16*)(a.ws + WS_GV);
    float acc = 0.f;
    for (int s = 0; s <= t; ++s) { const float v = ldbf(GV + (size_t)(r0 + s) * GMW + c);
        float x = wave_sum(v); __syncthreads(); if ((c & 63) == 0) sh[c >> 6] = x; __syncthreads(); float tot = 0.f; for (int w = 0; w < 8; ++w) tot += sh[w]; const float mu = tot / GMW;
        x = wave_sum((v - mu) * (v - mu)); __syncthreads(); if ((c & 63) == 0) sh[c >> 6] = x; __syncthreads(); tot = 0.f; for (int w = 0; w < 8; ++w) tot += sh[w]; const float rstd = 1.0f / sqrtf(tot / GMW + EPS);
        const float vn = bfr((v - mu) * rstd * a.in[I_LNG][c] + a.in[I_LNB][c]);
        acc += bfr(a.in[I_GWS][((size_t)g * 128 + t) * 128 + s]) * vn; }
    const float ref = ldbf(GU + (size_t)row * GMW + c) * (acc + a.in[I_GBS][g * 128 + t]);
    dbg_acc(a.ws, 3, ldbf((const bf16*)(a.ws + WS_YAB) + (size_t)row * D + NQ + c) - ref, ref);
}
__global__ void __launch_bounds__(256) chk_merge(Args a) {
    const int idx = blockIdx.x * 256 + threadIdx.x; if (idx >= NSAMP * D) return;
    const int row = samp_row(idx / D), n = idx % D; const bf16* yab = (const bf16*)(a.ws + WS_YAB);
    float sa = 0.f, sb = 0.f;
    for (int k = 0; k < 512; ++k) { sa += ldbf(yab + (size_t)row * D + k) * bfr(a.in[I_PA][(size_t)k * D + n]); sb += ldbf(yab + (size_t)row * D + 512 + k) * bfr(a.in[I_PB][(size_t)k * D + n]); }
    const float ref = (float)((const unsigned char*)(a.ws + WS_GA))[(size_t)row * D + n] * (1.0f / 255.0f) * sa + (float)((const unsigned char*)(a.ws + WS_GB))[(size_t)row * D + n] * (1.0f / 255.0f) * sb;
    dbg_acc(a.ws, 4, ldbf((const bf16*)(a.ws + WS_A) + (size_t)row * D + n) - ref, ref);
}
__global__ void __launch_bounds__(256) chk_wo(Args a) {
    const int idx = blockIdx.x * 256 + threadIdx.x; if (idx >= NSAMP * D) return;
    const int row = samp_row(idx / D), n = idx % D, b = row / SEQ; const bf16* mg = (const bf16*)(a.ws + WS_A);
    float s = 0.f; for (int k = 0; k < D; ++k) s += ldbf(mg + (size_t)row * D + k) * bfr(a.in[I_WO][(size_t)k * D + n]);
    const float ref = a.in[I_X][(size_t)row * D + n] + ((const float*)(a.ws + WS_MOD))[(size_t)b * 6 * D + 2 * D + n] * s;
    dbg_acc(a.ws, 5, ldbf((const bf16*)(a.ws + WS_XMID) + (size_t)row * D + n) - ref, ref);
}
__global__ void __launch_bounds__(256) chk_router(Args a) {
    __shared__ float sh[8]; __shared__ float lgt[36];
    const int row = samp_row(blockIdx.x), b = row / SEQ, t = threadIdx.x; const float* mod = (const float*)(a.ws + WS_MOD);
    float xv[4], hv[4], ss = 0.f;
#pragma unroll
    for (int q = 0; q < 4; ++q) { xv[q] = ldbf((const bf16*)(a.ws + WS_XMID) + (size_t)row * D + t + 256 * q); ss += xv[q] * xv[q]; }
    const float rinv = 1.0f / sqrtf(block_sum256(ss, sh) / D + EPS);
#pragma unroll
    for (int q = 0; q < 4; ++q) { const int c = t + 256 * q; hv[q] = xv[q] * rinv * a.in[I_N2G][c] * (1.0f + mod[(size_t)b * 6 * D + 4 * D + c]) + mod[(size_t)b * 6 * D + 3 * D + c];
        dbg_acc(a.ws, 6, f8dec(((const unsigned char*)(a.ws + WS_H2))[(size_t)row * D + c]) - f8r(hv[q]), hv[q]); }
    for (int n = 0; n < 36; ++n) { float p = 0.f;
#pragma unroll
        for (int q = 0; q < 4; ++q) { const int c = t + 256 * q; p += hv[q] * (n < 4 ? a.in[I_WRG][c * 4 + n] : a.in[I_WRE][c * 32 + n - 4]); }
        const float tot = block_sum256(p, sh); if (t == 0) lgt[n] = tot + (n < 4 ? a.in[I_BRG][n] : a.in[I_BRE][n - 4]); }
    __syncthreads();
    if (t == 0) { int gi = 0; for (int n = 1; n < 4; ++n) if (lgt[n] > lgt[gi]) gi = n; float gs = 0.f; for (int n = 0; n < 4; ++n) gs += expf(lgt[n] - lgt[gi]); const float pg = 1.0f / gs;
        int i1 = 0; for (int j = 1; j < 8; ++j) if (lgt[4 + 8 * gi + j] > lgt[4 + 8 * gi + i1]) i1 = j; int i2 = -1; for (int j = 0; j < 8; ++j) if (j != i1 && (i2 < 0 || lgt[4 + 8 * gi + j] > lgt[4 + 8 * gi + i2])) i2 = j;
        const float ex = expf(lgt[4 + 8 * gi + i2] - lgt[4 + 8 * gi + i1]), w1 = pg / (1.0f + ex), w2 = pg * ex / (1.0f + ex);
        const float* rec = (const float*)(a.ws + WS_DBG) + (size_t)row * 4;
        const bool same = ((int)rec[0] == gi * 8 + i1) && ((int)rec[1] == gi * 8 + i2);
        dbg_acc(a.ws, 7, same ? 0.f : 1.f, 1.f);
        if (same) { dbg_acc(a.ws, 8, rec[2] - w1, w1); dbg_acc(a.ws, 8, rec[3] - w2, w2); } }
}
__global__ void __launch_bounds__(256) chk_moe(Args a) {
    __shared__ float hs[D]; __shared__ float act[DEXP];
    const int row = samp_row(blockIdx.x >> 1), k = blockIdx.x & 1, t = threadIdx.x;
    const float* rec = (const float*)(a.ws + WS_DBG) + (size_t)row * 4; const int e = (int)rec[k]; const float w = rec[2 + k];
    for (int c = t; c < D; c += 256) hs[c] = f8dec(((const unsigned char*)(a.ws + WS_H2))[(size_t)row * D + c]);
    __syncthreads();
    for (int j = t; j < DEXP; j += 256) { float gsum = 0.f, usum = 0.f; for (int c = 0; c < D; ++c) { gsum += hs[c] * f8r(a.in[I_WG][((size_t)e * D + c) * DEXP + j] * WGU_SCALE); usum += hs[c] * f8r(a.in[I_WU][((size_t)e * D + c) * DEXP + j] * WGU_SCALE); }
        gsum *= 1.0f / WGU_SCALE; usum *= 1.0f / WGU_SCALE;
        act[j] = f8r(gsum / (1.0f + expf(-gsum)) * usum); }
    __syncthreads();
    for (int n = t; n < D; n += 256) { float s = 0.f; for (int j = 0; j < DEXP; ++j) s += act[j] * f8r(a.in[I_WDN][((size_t)e * DEXP + j) * D + n] * WD_SCALE);
        const float ref = w * s * (1.0f / WD_SCALE); dbg_acc(a.ws, 9, ldbf((const bf16*)(a.ws + WS_YT) + ((size_t)row * 2 + k) * D + n) - ref, ref); }
}
__global__ void __launch_bounds__(256) chk_final(Args a) {
    __shared__ float sh[8];
    const int row = samp_row(blockIdx.x), b = row / SEQ, t = threadIdx.x; const float* mod = (const float*)(a.ws + WS_MOD);
    float v[4], ss = 0.f;
#pragma unroll
    for (int q = 0; q < 4; ++q) { const int c = t + 256 * q; v[q] = ldbf((const bf16*)(a.ws + WS_XMID) + (size_t)row * D + c) + mod[(size_t)b * 6 * D + 5 * D + c] * (ldbf((const bf16*)(a.ws + WS_YT) + (size_t)row * 2 * D + c) + ldbf((const bf16*)(a.ws + WS_YT) + (size_t)row * 2 * D + D + c)); ss += v[q] * v[q]; }
    const float rinv = 1.0f / sqrtf(block_sum256(ss, sh) / D + EPS);
#pragma unroll
    for (int q = 0; q < 4; ++q) { const int c = t + 256 * q; const float ref = v[q] * rinv * a.in[I_FG][c]; dbg_acc(a.ws, 10, a.out[(size_t)row * D + c] - ref, ref); }
}
__global__ void __launch_bounds__(256) chk_report(Args a) {
    const float* acc = (const float*)(a.ws + WS_CTL) + CW_DBG; int code = 0;
    for (int k = 10; k >= 0; --k) { if (k < DBG_FIRST) continue; const float tol = (k == 7) ? 0.02f : 1e-3f; if (!(acc[2 * k] <= tol * acc[2 * k + 1])) code = k + 1; }
    const float f = 1.0f + 0.5f * (float)code;
    for (size_t i = (size_t)blockIdx.x * 256 + threadIdx.x; i < (size_t)M * D; i += (size_t)gridDim.x * 256) a.out[i] *= f;
}
#endif

extern "C" void kernel_launch(void* const* d_in, const int* in_sizes, int n_in, void* d_out, int out_size, void* d_ws, size_t ws_size, hipStream_t stream) {
    static int grid = 0;
    if (grid == 0) {
        if (n_in != 25 || in_sizes[0] != M * D || out_size != M * D || ws_size < WS_END) { fprintf(stderr, "kernel_launch: unexpected shapes (n_in %d, in0 %d, out %d, ws %zu); nothing launched\n", n_in, n_in > 0 ? in_sizes[0] : -1, out_size, ws_size); grid = -1; return; }
        int dev = 0, cus = 0, per_cu = 0;
        if (hipGetDevice(&dev) != hipSuccess || hipDeviceGetAttribute(&cus, hipDeviceAttributeMultiprocessorCount, dev) != hipSuccess) { grid = -1; return; }
        if (hipFuncSetAttribute((const void*)mk_fwd, hipFuncAttributeMaxDynamicSharedMemorySize, LDS_BYTES) != hipSuccess) { fprintf(stderr, "kernel_launch: hipFuncSetAttribute failed\n"); grid = -1; return; }
        if (hipOccupancyMaxActiveBlocksPerMultiprocessor(&per_cu, (const void*)mk_fwd, NWAVES * 64, LDS_BYTES) != hipSuccess || per_cu < 1) fprintf(stderr, "kernel_launch: occupancy query reports %d\n", per_cu);
        (void)hipGetLastError();
        grid = cus;
    }
    if (grid < 0) return;
    if (hipMemsetAsync((char*)d_ws + WS_CTL, 0, DEBUG_CHECKS ? (size_t)(1 * MiB) : CTL_ZERO_BYTES, stream) != hipSuccess) return;
    Args a{};
    for (int i = 0; i < 25; ++i) a.in[i] = (const float*)d_in[i];
    a.out = (float*)d_out; a.ws = (unsigned char*)d_ws;
    if (MK_N_LAUNCHES == 1) { a.ph_lo = 0; a.ph_hi = N_PHASES; a.li = 0; hipLaunchKernelGGL(mk_fwd, dim3(grid), dim3(NWAVES * 64), LDS_BYTES, stream, a); }
    else for (int li = 0; li < RUN_PHASES; ++li) { a.ph_lo = li; a.ph_hi = li + 1; a.li = li; hipLaunchKernelGGL(mk_fwd, dim3(grid), dim3(NWAVES * 64), LDS_BYTES, stream, a);
#if DEBUG_CHECKS
        if (li == 2) { hipLaunchKernelGGL(chk_h1, dim3(NSAMP), dim3(256), 0, stream, a); hipLaunchKernelGGL(chk_inproj, dim3(NSAMP * INW / 256), dim3(256), 0, stream, a); }
        if (li == 3) { hipLaunchKernelGGL(chk_attn, dim3(NSAMP * 32 / 256), dim3(256), 0, stream, a); hipLaunchKernelGGL(chk_gmlp, dim3(NSAMP), dim3(512), 0, stream, a); }
        if (li == 4) hipLaunchKernelGGL(chk_merge, dim3(NSAMP * D / 256), dim3(256), 0, stream, a);
        if (li == 5) hipLaunchKernelGGL(chk_wo, dim3(NSAMP * D / 256), dim3(256), 0, stream, a);
        if (li == 6) hipLaunchKernelGGL(chk_router, dim3(NSAMP), dim3(256), 0, stream, a);
        if (li == 8) hipLaunchKernelGGL(chk_moe, dim3(NSAMP * 2), dim3(256), 0, stream, a);
        if (li == 9) { hipLaunchKernelGGL(chk_final, dim3(NSAMP), dim3(256), 0, stream, a); hipLaunchKernelGGL(chk_report, dim3(2048), dim3(256), 0, stream, a); }
#endif
    }
}
```

```cpp
#include <hip/hip_runtime.h>
#include <cstdio>
#include <cstdint>
#include <cmath>
#include <type_traits>

#ifndef MK_N_LAUNCHES
#define MK_N_LAUNCHES 1
#endif

#ifndef DEBUG_CHECKS
#define DEBUG_CHECKS 0
#endif
#ifndef DBG_FIRST
#define DBG_FIRST 0
#endif
#ifndef RUN_PHASES
#define RUN_PHASES 10
#endif
#define GAS __attribute__((address_space(1)))
#define LAS __attribute__((address_space(3)))
typedef unsigned short bf16;
typedef short bf16x8 __attribute__((ext_vector_type(8)));
typedef short s16x4 __attribute__((ext_vector_type(4)));
typedef float f32x2 __attribute__((ext_vector_type(2)));
typedef float f32x4 __attribute__((ext_vector_type(4)));
typedef float f32x16 __attribute__((ext_vector_type(16)));
typedef unsigned u32x2 __attribute__((ext_vector_type(2)));
typedef unsigned u32x4 __attribute__((ext_vector_type(4)));
typedef __bf16 bf16x2_t __attribute__((ext_vector_type(2)));
typedef GAS unsigned gu32;

constexpr int BATCH = 8, SEQ = 4096, D = 1024, M = BATCH * SEQ;
constexpr int NQ = 512, NKV = 256  , GMW = 512, INW = 3840;
constexpr int NEXP = 32, DEXP = 512;
constexpr float EPS = 1e-6f;
constexpr float LOG2E = 1.4426950408889634f;
constexpr float QSCALE = 0.125f * LOG2E;
constexpr int LIST_CAP = 32768;
constexpr int HACT_ROWS = 73728;

constexpr size_t MiB = 1u << 20;
constexpr size_t WS_CTL = 0, CTL_ZERO_BYTES = 32 * 1024;
constexpr size_t WS_MOD = 1 * MiB;
constexpr size_t WS_MODP = 1 * MiB + 256 * 1024;
constexpr size_t WS_WST = 4 * MiB + 512 * 1024;
constexpr size_t WS_LROW = 5 * MiB;
constexpr size_t WS_LW = 9 * MiB;
constexpr size_t WS_GT = 13 * MiB;
constexpr size_t WS_GC = 13 * MiB + 800 * 1024;
constexpr size_t WS_WIN = 14 * MiB;
constexpr size_t WS_WIN8 = 18 * MiB;
constexpr size_t WS_H1F8 = 186 * MiB;
constexpr int NBF = 1792;
constexpr size_t WS_PA = 22 * MiB;
constexpr size_t WS_WO = 24 * MiB;
constexpr size_t WS_WGU = 26 * MiB;
constexpr size_t WS_WD = 90 * MiB;
constexpr size_t WS_A = 122 * MiB;
constexpr size_t WS_YAB = 186 * MiB;
constexpr size_t WS_YT = 122 * MiB;
constexpr size_t WS_Q = 250 * MiB;
constexpr size_t WS_KV = 282 * MiB;
constexpr size_t WS_GU = 298 * MiB, WS_GV = 330 * MiB;
constexpr size_t WS_T = 298 * MiB;
constexpr size_t WS_HACT = 250 * MiB;
constexpr size_t WS_GA = 362 * MiB;
constexpr size_t WS_XMID = 362 * MiB;
constexpr size_t WS_GB = 426 * MiB;
constexpr size_t WS_H2 = 426 * MiB;
constexpr size_t WS_END = 490 * MiB;
static_assert(WS_HACT + (size_t)HACT_ROWS * 1024 <= WS_GA, "HACT overlay");
constexpr int CW_TMO = 0, CW_CODE = 1;
constexpr int CW_CNT = 1024;
constexpr int CW_BAR = 4096;

constexpr int RING_OFF = 0, RING_BYTES = 131072;
constexpr int LDSCTL_OFF = RING_BYTES, MISC_OFF = LDSCTL_OFF + 320;
constexpr int TAB_OFF = RING_BYTES + 512;
constexpr int TAB_UNITS = TAB_OFF, TAB_CNT = TAB_OFF + 256, TAB_ROWS = TAB_OFF + 1024, MAX_WG_UNITS = 14;
constexpr int CSH_OFF = TAB_ROWS + MAX_WG_UNITS * 1024;
constexpr int LDS_BYTES = CSH_OFF + 16384;
static_assert(CSH_OFF % 16 == 0 && LDS_BYTES <= 163840 - 256, "LDS map");
constexpr int NWAVES = 8;
constexpr int N_PHASES = 10;

#define LDS_WAIT() asm volatile("s_waitcnt lgkmcnt(0)" ::: "memory")
#define VM_WAIT() asm volatile("s_waitcnt vmcnt(0)" ::: "memory")
#define RLX_AGENT __ATOMIC_RELAXED, __HIP_MEMORY_SCOPE_AGENT
__device__ __forceinline__ unsigned cvtpk(float lo, float hi) { f32x2 v = {lo, hi}; bf16x2_t b = __builtin_convertvector(v, bf16x2_t); return __builtin_bit_cast(unsigned, b); }
__device__ __forceinline__ float bf_lo(unsigned w) { return __uint_as_float(w << 16); }
__device__ __forceinline__ float bf_hi(unsigned w) { return __uint_as_float(w & 0xffff0000u); }
__device__ __forceinline__ float wave_sum(float v) {
    int x = __float_as_int(v);
#define WS_DPP(ctrl, rmask) x = __float_as_int(__int_as_float(x) + __int_as_float(__builtin_amdgcn_update_dpp(0, x, (ctrl), (rmask), 0xf, false)))
    WS_DPP(0xB1, 0xf);
    WS_DPP(0x4E, 0xf);
    WS_DPP(0x141, 0xf);
    WS_DPP(0x140, 0xf);
    WS_DPP(0x142, 0xa);
    WS_DPP(0x143, 0xc);
#undef WS_DPP
    return __int_as_float(__builtin_amdgcn_readlane(x, 63));
}
__device__ __forceinline__ float clamp448(float v) { return __builtin_amdgcn_fmed3f(v, -448.0f, 448.0f); }
__device__ __forceinline__ unsigned pk4_fp8(float a, float b, float c, float d) {
    unsigned r = 0; r = __builtin_amdgcn_cvt_pk_fp8_f32(clamp448(a), clamp448(b), r, false); r = __builtin_amdgcn_cvt_pk_fp8_f32(clamp448(c), clamp448(d), r, true); return r; }
__device__ __forceinline__ u32x2 pack8_fp8(const f32x4 a, const f32x4 b) { u32x2 w; w.x = pk4_fp8(a[0], a[1], a[2], a[3]); w.y = pk4_fp8(b[0], b[1], b[2], b[3]); return w; }
constexpr float WGU_SCALE = 64.0f, WD_SCALE = 32.0f;
__device__ __forceinline__ unsigned pk4_u8(float a, float b, float c, float d) {
    return (unsigned)(a * 255.0f + 0.5f) | ((unsigned)(b * 255.0f + 0.5f) << 8) | ((unsigned)(c * 255.0f + 0.5f) << 16) | ((unsigned)(d * 255.0f + 0.5f) << 24); }
__device__ __forceinline__ void unpack8_u8(const u32x2 w, f32x4& a, f32x4& b) {
    a = (f32x4){(float)(w.x & 0xffu), (float)((w.x >> 8) & 0xffu), (float)((w.x >> 16) & 0xffu), (float)(w.x >> 24)};
    b = (f32x4){(float)(w.y & 0xffu), (float)((w.y >> 8) & 0xffu), (float)((w.y >> 16) & 0xffu), (float)(w.y >> 24)}; }
__device__ __forceinline__ float sigmoid_f(float x) { return __builtin_amdgcn_rcpf(1.0f + __builtin_amdgcn_exp2f(-x * LOG2E)); }
__device__ __forceinline__ float gelu_tanh_f(float x) {
    const float t = x * __builtin_fmaf(x * x, -2.3022081987f * 0.044715f, -2.3022081987f);
    return x * __builtin_amdgcn_rcpf(1.0f + __builtin_amdgcn_exp2f(t));
}
__device__ __forceinline__ float silu_f(float x) { return x * __builtin_amdgcn_rcpf(1.0f + __builtin_amdgcn_exp2f(-x * LOG2E)); }

namespace pg8 {
constexpr int BM = 256, BK = 64, HALF = 128, HTB = HALF * BK * 2, STAGE_BYTES = 8 * HTB, NXCD = 8, WGM = 8;
__host__ __device__ __forceinline__ int lds_byte(int r, int c) { const int st = (r >> 4) * 2 + (c >> 5), rr = r & 15, cc = c & 31, ob = rr * 64 + cc * 2; return st * 1024 + (ob ^ (((ob >> 9) & 1) << 5)); }
__host__ __device__ __forceinline__ void stage_rc(int b, int& R, int& C) { const int st = b / 1024, sb = b % 1024, swz = sb ^ (((sb >> 9) & 1) << 5); R = (st >> 1) * 16 + swz / 64; C = (st & 1) * 32 + (swz % 64) / 2; }
__host__ __device__ __forceinline__ int perm32(int rho) { const int n = rho >> 4, i = rho & 15; return 8 * (i >> 2) + 4 * n + (i & 3); }

struct Unit { int pm, pn, v, e, ui; };

struct DenseOrder {
    int nM, nN, nwg, G, c;
    __device__ void init(int M_, int N_, int G_, int c_) { nM = M_ / BM; nN = N_ / BM; nwg = nM * nN; G = G_; c = c_; }
    __device__ bool tile(int i, Unit& u) const { return tileL((long)i * G + c, u); }
    __device__ bool tileL(long L, Unit& u) const {
        if (L >= nwg) return false;
        int wgid = (int)L; { const int q = nwg / NXCD, r = nwg % NXCD, xcd = wgid % NXCD, off = wgid / NXCD; wgid = (xcd < r ? xcd * (q + 1) : r * (q + 1) + (xcd - r) * q) + off; }
        const int nig = WGM * nN, gid = wgid / nig, fm = gid * WGM, gsz = (nM - fm) < WGM ? (nM - fm) : WGM;
        u.pm = fm + ((wgid % nig) % gsz); u.pn = (wgid % nig) / gsz; u.v = 0; u.e = 0; u.ui = 0; return true;
    }
    __device__ bool next(int i, Unit& u) const { return tile(i, u); }
};
struct BackfillOrder : DenseOrder {
    __device__ bool next(int i, Unit& u) const {
        if (i < 3) return tileL((long)i * G + c, u);
        if (c >= G / 2) return tileL((long)3 * G + (long)(i - 3) * (G - G / 2) + (c - G / 2), u);
        return false; }
};

template <class Prob, class Epi, class Sched, bool ALIGN_EPI>
__device__ __forceinline__ void gemm_phase(LAS unsigned char* lds, const Prob& P, const Sched& S, const Epi& E) {
    const int tid = threadIdx.x, wid = __builtin_amdgcn_readfirstlane(tid >> 6), lane = tid & 63, wr = wid >> 2, wc = wid & 3, fr = lane & 15, fq = lane >> 4;
    const int nt = P.Kb / 128;
    int Rr[2], Cc[2]; unsigned voffB[2], aoc[2][2], aon[2][2];
#pragma unroll
    for (int i = 0; i < 2; ++i) { int R, C; stage_rc(tid * 16 + i * 8192, R, C); Rr[i] = R; Cc[i] = C; const int Rb = Epi::PERM ? ((R & ~31) + perm32(R & 31)) : R;
        voffB[i] = (unsigned)Rb * P.ldb + (unsigned)C * 2u; }
    const size_t kstep = (size_t)(BK * 2);
    const size_t hstepB = (size_t)HALF * P.ldb;
    const unsigned ldsw = (unsigned)wid * 1024u;
    const int aoff = lds_byte(wr * 64 + fr, fq * 8), boff = lds_byte(wc * 32 + fr, fq * 8);
#define PG8_SA(b, h) (((b) * 2 + (h)) * HTB)
#define PG8_SB(b, h) ((4 + (b) * 2 + (h)) * HTB)
#define PG8_STG(bufoff, p0, p1) do { \
        __builtin_amdgcn_global_load_lds((const unsigned*)(p0), (LAS unsigned*)(lds + (bufoff) + ldsw), 16, 0, 0); \
        __builtin_amdgcn_global_load_lds((const unsigned*)(p1), (LAS unsigned*)(lds + (bufoff) + ldsw + 8192), 16, 0, 0); } while (0)
#define PG8_STGB(bufoff, base) PG8_STG(bufoff, (base) + voffB[0], (base) + voffB[1])
#define PG8_STGA(bufoff, base, off, h) PG8_STG(bufoff, (base) + off[h][0], (base) + off[h][1])
#define PG8_LDF(dst, addr) do { if constexpr (Prob::F8) { const i32x4 lo_ = *(const LAS i32x4*)(addr), hi_ = *(const LAS i32x4*)((addr) + 1024); dst.v = __builtin_shufflevector(lo_, hi_, 0, 1, 2, 3, 4, 5, 6, 7); } \
        else { dst.k[0] = *(const LAS bf16x8*)(addr); dst.k[1] = *(const LAS bf16x8*)((addr) + 1024); } } while (0)
#define PG8_LDA(dst, b, h) do { _Pragma("unroll") for (int m = 0; m < 4; ++m) PG8_LDF(dst[m], lds + PG8_SA(b, h) + aoff + m * 2048); } while (0)
#define PG8_LDB(dst, b, h) do { _Pragma("unroll") for (int n = 0; n < 2; ++n) PG8_LDF(dst[n], lds + PG8_SB(b, h) + boff + n * 2048); } while (0)
#define PG8_MMA(ai, bj, At, Bt) do { __builtin_amdgcn_s_setprio(1); _Pragma("unroll") for (int m = 0; m < 4; ++m) _Pragma("unroll") for (int n = 0; n < 2; ++n) { \
        if constexpr (Prob::F8) asm volatile("v_mfma_scale_f32_16x16x128_f8f6f4 %0, %1, %2, %0, %3, %3 op_sel_hi:[0,0,0]" : "+v"(acc[ai][bj][m][n]) : "v"(Bt[n].v), "v"(At[m].v), "v"(f8scale));   \
        else { _Pragma("unroll") for (int k = 0; k < 2; ++k) acc[ai][bj][m][n] = __builtin_amdgcn_mfma_f32_16x16x32_bf16(Bt[n].k[k], At[m].k[k], acc[ai][bj][m][n], 0, 0, 0); } } \
        __builtin_amdgcn_s_setprio(0); } while (0)
#define PG8_WAIT_V(n) asm volatile("s_waitcnt vmcnt(" #n ")" ::: "memory")
#define PG8_WAIT_L(n) asm volatile("s_waitcnt lgkmcnt(" #n ")" ::: "memory")
#define PG8_BAR __builtin_amdgcn_s_barrier()
#define PG8_SCHED __builtin_amdgcn_sched_barrier(0)
#define PG8_AOFF(dst, ui_) do { _Pragma("unroll") for (int h = 0; h < 2; ++h) _Pragma("unroll") for (int i = 0; i < 2; ++i) { \
        if constexpr (Prob::GATHER) dst[h][i] = P.rowtab[(ui_) * 256 + h * HALF + Rr[i]] + (unsigned)Cc[i] * 2u; \
        else dst[h][i] = (unsigned)(h * HALF + Rr[i]) * P.lda + (unsigned)Cc[i] * 2u; } } while (0)
    Unit cur, nxt; int ui = 0;
    if (!S.next(0, cur)) return;
    f32x4 acc[2][2][4][2];
#pragma unroll
    for (int a = 0; a < 2; ++a)
#pragma unroll
        for (int b = 0; b < 2; ++b)
#pragma unroll
            for (int m = 0; m < 4; ++m)
#pragma unroll
                for (int n = 0; n < 2; ++n) acc[a][b][m][n] = (f32x4){0.f, 0.f, 0.f, 0.f};
    typedef int i32x8 __attribute__((ext_vector_type(8))); typedef int i32x4 __attribute__((ext_vector_type(4)));
    struct FragBf { bf16x8 k[2]; }; struct FragF8 { i32x8 v; };
    typedef typename std::conditional<Prob::F8, FragF8, FragBf>::type Frag;
    Frag At[4], B0[2], B1[2];
    int f8scale = 0x7f7f7f7f; asm volatile("" : "+v"(f8scale));
    const char* cA = P.a_ptr(cur); const char* cB = P.b_ptr(cur);
    PG8_AOFF(aoc, 0);
#pragma unroll
    for (int h = 0; h < 2; ++h)
#pragma unroll
        for (int i = 0; i < 2; ++i) aon[h][i] = aoc[h][i];
    PG8_STGB(PG8_SB(0, 0), cB); PG8_STGB(PG8_SB(0, 1), cB + hstepB); PG8_STGA(PG8_SA(0, 0), cA, aoc, 0); PG8_STGA(PG8_SA(0, 1), cA, aoc, 1);
    if (wr == 1) PG8_BAR;
    PG8_WAIT_V(2); PG8_BAR;
    PG8_STGB(PG8_SB(1, 0), cB + kstep); PG8_STGA(PG8_SA(1, 0), cA + kstep, aoc, 0); PG8_STGB(PG8_SB(1, 1), cB + hstepB + kstep);
    PG8_WAIT_V(6); PG8_BAR;
    for (;;) {
        const bool has_next = S.next(ui + 1, nxt);
        const char* nA = has_next ? P.a_ptr(nxt) : cA; const char* nB = has_next ? P.b_ptr(nxt) : cB;
        for (int t = 0; t < nt; t += 2) {
            const bool last = (t == nt - 2);
            const char* a1 = cA + (size_t)(t + 1) * kstep;
            const char* a2 = last ? nA : cA + (size_t)(t + 2) * kstep; const char* b2 = last ? nB : cB + (size_t)(t + 2) * kstep;
            const char* a3 = a2 + kstep; const char* b3 = b2 + kstep;
            unsigned ao2[2][2];
            if constexpr (Prob::GATHER) {
                if (last && has_next) PG8_AOFF(aon, ui + 1);
#pragma unroll
                for (int h = 0; h < 2; ++h)
#pragma unroll
                    for (int i = 0; i < 2; ++i) ao2[h][i] = (last && has_next) ? aon[h][i] : aoc[h][i];
            } else {
#pragma unroll
                for (int h = 0; h < 2; ++h)
#pragma unroll
                    for (int i = 0; i < 2; ++i) ao2[h][i] = aoc[h][i];
            }
            if constexpr (Epi::MIDK) { if (t == nt / 2) E.mid(acc, cur, wr, wc, fr, fq); }
            PG8_LDB(B0, 0, 0); PG8_LDB(B1, 0, 1); PG8_SCHED; PG8_LDA(At, 0, 0); PG8_STGA(PG8_SA(1, 1), a1, aoc, 1);
            PG8_WAIT_V(8); PG8_WAIT_L(0); PG8_BAR; PG8_MMA(0, 0, At, B0); PG8_MMA(0, 1, At, B1); PG8_BAR; PG8_SCHED;
            PG8_LDA(At, 0, 1); PG8_STGB(PG8_SB(0, 0), b2); PG8_STGB(PG8_SB(0, 1), b2 + hstepB); PG8_STGA(PG8_SA(0, 0), a2, ao2, 0);
            PG8_WAIT_V(8); PG8_WAIT_L(0); PG8_BAR; PG8_MMA(1, 0, At, B0); PG8_MMA(1, 1, At, B1); PG8_BAR; PG8_SCHED;
            PG8_LDB(B0, 1, 0); PG8_LDB(B1, 1, 1); PG8_SCHED; PG8_LDA(At, 1, 0); PG8_STGA(PG8_SA(0, 1), a2, ao2, 1);
            PG8_WAIT_V(8); PG8_WAIT_L(0); PG8_BAR; PG8_MMA(0, 0, At, B0); PG8_MMA(0, 1, At, B1); PG8_BAR; PG8_SCHED;
            PG8_LDA(At, 1, 1); PG8_STGB(PG8_SB(1, 0), b3); PG8_STGB(PG8_SB(1, 1), b3 + hstepB); PG8_STGA(PG8_SA(1, 0), a3, ao2, 0);
            PG8_WAIT_V(8); PG8_WAIT_L(0); PG8_BAR; PG8_MMA(1, 0, At, B0); PG8_MMA(1, 1, At, B1); PG8_BAR; PG8_SCHED;
        }
        if constexpr (ALIGN_EPI) { if (wr == 0) PG8_BAR; }
        if constexpr (Prob::F8) asm volatile("s_nop 15\n\ts_nop 15\n\ts_nop 15" ::: "memory");
        E(acc, cur, wr, wc, fr, fq);
        if (!has_next) break;
#pragma unroll
        for (int a = 0; a < 2; ++a)
#pragma unroll
            for (int b = 0; b < 2; ++b)
#pragma unroll
                for (int m = 0; m < 4; ++m)
#pragma unroll
                    for (int n = 0; n < 2; ++n) acc[a][b][m][n] = (f32x4){0.f, 0.f, 0.f, 0.f};
        cur = nxt; cA = nA; cB = nB; ++ui;
        if constexpr (Prob::GATHER) {
#pragma unroll
            for (int h = 0; h < 2; ++h)
#pragma unroll
                for (int i = 0; i < 2; ++i) aoc[h][i] = aon[h][i];
        }
        if constexpr (ALIGN_EPI) { if (wr == 1) PG8_BAR; }
    }
    PG8_WAIT_V(0);
    if constexpr (!ALIGN_EPI) { if (wr == 0) PG8_BAR; }
    PG8_BAR;
#undef PG8_SA
#undef PG8_SB
#undef PG8_STG
#undef PG8_STGA
#undef PG8_STGB
#undef PG8_LDA
#undef PG8_LDF
#undef PG8_LDB
#undef PG8_MMA
#undef PG8_WAIT_V
#undef PG8_WAIT_L
#undef PG8_BAR
#undef PG8_SCHED
#undef PG8_AOFF
}
}

#define XB_TMO      128
#define XB_XCNT(j)  (256  + 64 * (j))
#define XB_XSUB(j)  (1280 + 64 * (j))
#define XB_XGEN(j)  (2304 + 64 * (j))
#define XB_TOP      3328
#define XB_TOPGEN   3392
#define XCD_BAR_WORDS 3456
#define XB_SPIN_CAP (1u << 18)
__device__ __forceinline__ unsigned xb_ld(unsigned* p)              { return __hip_atomic_load(p, __ATOMIC_RELAXED, __HIP_MEMORY_SCOPE_AGENT); }
__device__ __forceinline__ unsigned xb_add(unsigned* p, unsigned v) { return __hip_atomic_fetch_add(p, v, __ATOMIC_RELAXED, __HIP_MEMORY_SCOPE_AGENT); }
__device__ __forceinline__ unsigned xb_xcc_id() { return (unsigned)__builtin_amdgcn_s_getreg((3 << 11) | 20) & 0xFu; }
#define XB_SPIN(cond, bar) do { unsigned _sp = 0; while (cond) { __builtin_amdgcn_s_sleep(1); \
    if ((++_sp & 255u) == 0u) { if (xb_ld(&(bar)[XB_TMO])) break; if (_sp > XB_SPIN_CAP) { atomicAdd(&(bar)[XB_TMO], 1u); break; } } } } while (0)
struct XcdBarrier { unsigned* bar; unsigned x; volatile LAS unsigned* st; };
__device__ __forceinline__ XcdBarrier xcd_barrier_post(unsigned* bar, volatile LAS unsigned* st) {
    XcdBarrier b; b.bar = bar; b.x = xb_xcc_id(); b.st = st;
    if (threadIdx.x == 0) (void)xb_add(&bar[XB_XCNT(b.x)], 1u);
    return b;
}
__device__ __forceinline__ void xcd_barrier_complete(unsigned* bar, unsigned x, unsigned& nloc, unsigned& nx) {
    const unsigned G = gridDim.x * gridDim.y * gridDim.z;
    unsigned sum, cnt, mine, sp = 0u;
    for (;;) {
        sum = 0u; cnt = 0u; mine = 0u;
#pragma unroll
        for (unsigned j = 0; j < 16; ++j) { const unsigned c = xb_ld(&bar[XB_XCNT(j)]); sum += c; cnt += (c > 0u) ? 1u : 0u; mine = (j == x) ? c : mine; }
        if (sum == G) break;
        __builtin_amdgcn_s_sleep(1);
        if ((++sp & 255u) == 0u) { if (xb_ld(&bar[XB_TMO])) break; if (sp > XB_SPIN_CAP) { atomicAdd(&bar[XB_TMO], 1u); break; } }
    }
    nloc = mine > 0u ? mine : 1u; nx = cnt > 0u ? cnt : 1u;
}
__device__ __forceinline__ void xcd_barrier(const XcdBarrier& b) {
    asm volatile("s_waitcnt vmcnt(0)" ::: "memory");
    __syncthreads();
    if (threadIdx.x == 0) {
        unsigned* bar = b.bar;
        __builtin_amdgcn_s_waitcnt(0);
        unsigned nloc = b.st[0], nx = b.st[1];
        if (nloc == 0u) { xcd_barrier_complete(bar, b.x, nloc, nx); b.st[0] = nloc; b.st[1] = nx; }
        const unsigned old = xb_add(&bar[XB_XSUB(b.x)], 1u);
        const unsigned gen = old / nloc;
        if (old + 1u == (gen + 1u) * nloc) {
            __builtin_amdgcn_fence(__ATOMIC_RELEASE, "agent");
            asm volatile("s_waitcnt vmcnt(0)" ::: "memory");
            const unsigned og = xb_add(&bar[XB_TOP], 1u);
            const unsigned tg = og / nx;
            if (og + 1u == (tg + 1u) * nx) xb_add(&bar[XB_TOPGEN], 1u);
            else XB_SPIN(xb_ld(&bar[XB_TOPGEN]) == tg, bar);
            __builtin_amdgcn_fence(__ATOMIC_ACQUIRE, "agent");
            xb_add(&bar[XB_XGEN(b.x)], 1u);
            asm volatile("s_waitcnt vmcnt(0)" ::: "memory");
        } else {
            XB_SPIN(xb_ld(&bar[XB_XGEN(b.x)]) == gen, bar);
            __builtin_amdgcn_fence(__ATOMIC_ACQUIRE, "agent");
            asm volatile("s_waitcnt vmcnt(0)" ::: "memory");
        }
    }
    __syncthreads();
}

struct Args {
    const float* in[25]; float* out; unsigned char* ws; int ph_lo, ph_hi, li, pad;
};
struct Frame {
    LAS unsigned char* lds;
    volatile LAS unsigned* MISC;
    gu32* ctl;
    unsigned char* ws;
    int tid, lane, wave, vcu, G;
};
enum { I_X = 0, I_C, I_POS, I_RELB, I_WADA, I_BADA, I_N1G, I_WIN, I_SINKS, I_LNG, I_LNB, I_GWS, I_GBS, I_PA, I_PB, I_WO, I_N2G, I_WRG, I_BRG, I_WRE, I_BRE, I_WG, I_WU, I_WDN, I_FG };

__device__ __forceinline__ void p0_transpose_tile(const float* W, int N, int k0, int n0, bf16* WT, int ldt, int drow0, LAS float* scr, int lane) {
    {
        f32x4 t[8];
#pragma unroll
        for (int i = 0; i < 8; ++i) t[i] = __builtin_nontemporal_load((const GAS f32x4*)(W + (size_t)(k0 + 8 * i + (lane >> 3)) * N + n0 + 4 * (lane & 7)));
#pragma unroll
        for (int i = 0; i < 8; ++i) { LAS float* d = scr + (8 * i + (lane >> 3)) * 33 + 4 * (lane & 7); d[0] = t[i][0]; d[1] = t[i][1]; d[2] = t[i][2]; d[3] = t[i][3]; }
    }
    LDS_WAIT(); asm volatile("" ::: "memory");
    const int c = lane & 7;
#pragma unroll
    for (int j = 0; j < 4; ++j) { const int n = (lane >> 3) + 8 * j; const LAS float* s = scr + (8 * c) * 33 + n;
        u32x4 o; o.x = cvtpk(s[0 * 33], s[1 * 33]); o.y = cvtpk(s[2 * 33], s[3 * 33]); o.z = cvtpk(s[4 * 33], s[5 * 33]); o.w = cvtpk(s[6 * 33], s[7 * 33]);
        *(GAS u32x4*)(WT + (size_t)(drow0 + n) * ldt + k0 + 8 * c) = o; }
    LDS_WAIT(); asm volatile("" ::: "memory");
}
__device__ __forceinline__ void p0_transpose_tile_f8(const float* W, int N, int k0, int n0, unsigned char* WT, int ldt, int drow0, float scale, LAS float* scr, int lane) {
    {
        f32x4 t[16];
#pragma unroll
        for (int i = 0; i < 16; ++i) t[i] = __builtin_nontemporal_load((const GAS f32x4*)(W + (size_t)(k0 + 8 * i + (lane >> 3)) * N + n0 + 4 * (lane & 7)));
#pragma unroll
        for (int i = 0; i < 16; ++i) { const int k = 8 * i + (lane >> 3); *(LAS f32x4*)(scr + k * 32 + ((4 * (lane & 7)) ^ (4 * (k >> 4)))) = t[i]; }
    }
    LDS_WAIT(); asm volatile("" ::: "memory");
    const int c = lane & 7;
#pragma unroll
    for (int j = 0; j < 4; ++j) { const int n = (lane >> 3) + 8 * j; const LAS float* sp = scr + (16 * c) * 32 + (n ^ (4 * c));
        u32x4 o;
        o.x = pk4_fp8(sp[0 * 32] * scale, sp[1 * 32] * scale, sp[2 * 32] * scale, sp[3 * 32] * scale); o.y = pk4_fp8(sp[4 * 32] * scale, sp[5 * 32] * scale, sp[6 * 32] * scale, sp[7 * 32] * scale);
        o.z = pk4_fp8(sp[8 * 32] * scale, sp[9 * 32] * scale, sp[10 * 32] * scale, sp[11 * 32] * scale); o.w = pk4_fp8(sp[12 * 32] * scale, sp[13 * 32] * scale, sp[14 * 32] * scale, sp[15 * 32] * scale);
        *(GAS u32x4*)(WT + (size_t)(drow0 + n) * ldt + k0 + 16 * c) = o; }
    LDS_WAIT(); asm volatile("" ::: "memory");
}
__device__ __forceinline__ void p0_prologue(Frame& F, const Args& A) {
    const int gw = F.vcu * NWAVES + F.wave, NGW = F.G * NWAVES, lane = F.lane;
    {
        const float* c = A.in[I_C]; const float* w = A.in[I_WADA]; float* modp = (float*)(F.ws + WS_MODP);
        for (int it = gw; it < 96 * 16; it += NGW) {
            const int cg = it % 96, ks = it / 96, k0 = ks * 64, col = cg * 64 + lane;
            float csv[8], acc[8];
#pragma unroll
            for (int b = 0; b < 8; ++b) { const float v = c[b * D + k0 + lane]; csv[b] = silu_f(v); acc[b] = 0.f; }
            float wv[64];
#pragma unroll
            for (int kk = 0; kk < 64; ++kk) wv[kk] = __builtin_nontemporal_load((const GAS float*)(w + (size_t)(k0 + kk) * (6 * D) + col));
#pragma unroll
            for (int kk = 0; kk < 64; ++kk) {
#pragma unroll
                for (int b = 0; b < 8; ++b) acc[b] += __int_as_float(__builtin_amdgcn_readlane(__float_as_int(csv[b]), kk)) * wv[kk];
            }
#pragma unroll
            for (int b = 0; b < 8; ++b) modp[((size_t)ks * 8 + b) * (6 * D) + col] = acc[b];
        }
    }
    {
        LAS float* scr = (LAS float*)(F.lds + RING_OFF + F.wave * 16384);
        constexpr int S0 = 16 * 56  , S0F = 8 * 64  , S1 = 8 * 32, S2 = 8 * 32, S3 = 16 * 32, S4 = 32 * 128, S5 = 32 * 128, S6 = 32 * 128;
        constexpr int NITEMS = S0 + S0F + S1 + S2 + S3 + S4 + S5 + S6;
        for (int it = gw; it < NITEMS; it += NGW) {
            int r = it;
            if (r < S0) { const int kb = r / 56, nb = r % 56; p0_transpose_tile(A.in[I_WIN], INW, 64 * kb, 32 * nb, (bf16*)(F.ws + WS_WIN), D, 32 * nb, scr, lane); continue; } r -= S0;
            if (r < S0F) { const int kb = r / 64, nb = r % 64; p0_transpose_tile_f8(A.in[I_WIN], INW, 128 * kb, NBF + 32 * nb, (unsigned char*)(F.ws + WS_WIN8), D, 32 * nb, WGU_SCALE, scr, lane); continue; } r -= S0F;
            if (r < S1) { const int kb = r / 32, nb = r % 32; p0_transpose_tile(A.in[I_PA], D, 64 * kb, 32 * nb, (bf16*)(F.ws + WS_PA), D, 32 * nb, scr, lane); continue; } r -= S1;
            if (r < S2) { const int kb = r / 32, nb = r % 32; p0_transpose_tile(A.in[I_PB], D, 64 * kb, 32 * nb, (bf16*)(F.ws + WS_PA) + NQ, D, 32 * nb, scr, lane); continue; } r -= S2;
            if (r < S3) { const int kb = r / 32, nb = r % 32; p0_transpose_tile(A.in[I_WO], D, 64 * kb, 32 * nb, (bf16*)(F.ws + WS_WO), D, 32 * nb, scr, lane); continue; } r -= S3;
            if (r < S4 + S5) { const int up = r >= S4 ? 1 : 0; if (up) r -= S4; const int e = r >> 7, q = r & 127, kb = q / 16, nb = q % 16, n0 = 32 * nb;
                p0_transpose_tile_f8(A.in[up ? I_WU : I_WG] + (size_t)e * D * DEXP, DEXP, 128 * kb, n0, (unsigned char*)(F.ws + WS_WGU) + (size_t)e * 1024 * 1024, D, (n0 >> 7) * 256 + up * 128 + (n0 & 127), WGU_SCALE, scr, lane); continue; }
            r -= S4 + S5;
            { const int e = r >> 7, q = r & 127, kb = q / 32, nb = q % 32; p0_transpose_tile_f8(A.in[I_WDN] + (size_t)e * DEXP * D, D, 128 * kb, 32 * nb, (unsigned char*)(F.ws + WS_WD) + (size_t)e * 1024 * DEXP, DEXP, 32 * nb, WD_SCALE, scr, lane); }
        }
        const float* gws = A.in[I_GWS]; bf16* wst = (bf16*)(F.ws + WS_WST);
        for (int i = F.vcu * 512 + F.tid; i < 4 * 128 * 128 / 2; i += F.G * 512) { const int e0 = 2 * i, t = (e0 >> 7) & 127, s = e0 & 127;
            const float a = s <= t ? gws[e0] : 0.f, b = (s + 1) <= t ? gws[e0 + 1] : 0.f; ((unsigned*)wst)[i] = cvtpk(a, b); }
    }
}

__device__ __forceinline__ float mod_sum(const float* modp, const float* bada, int b, int j) {
    float s = bada[j];
#pragma unroll
    for (int ks = 0; ks < 16; ++ks) s += modp[((size_t)ks * 8 + b) * (6 * D) + j];
    return s;
}
__device__ __forceinline__ void p1_h1(Frame& F, const Args& A) {
    const float* modp = (const float*)(F.ws + WS_MODP); const float* bada = A.in[I_BADA]; float* mod = (float*)(F.ws + WS_MOD);
    for (int idx = F.vcu * 512 + F.tid; idx < 8 * 6 * D; idx += F.G * 512) { const int b = idx / (6 * D), j = idx % (6 * D); mod[idx] = mod_sum(modp, bada, b, j); }
    LAS float* Av = (LAS float*)(F.lds + RING_OFF); LAS float* Bv = Av + D;
    const float* x = A.in[I_X]; const float* g = A.in[I_N1G]; bf16* h1 = (bf16*)(F.ws + WS_A);
    for (int rb = F.vcu; rb < M / 128; rb += F.G) {
        const int b = rb / (SEQ / 128);
        __syncthreads();
        for (int c = F.tid; c < D; c += 512) { const float sh = mod_sum(modp, bada, b, c), sc = mod_sum(modp, bada, b, D + c); Av[c] = g[c] * (1.0f + sc); Bv[c] = sh; }
        __syncthreads();
        for (int j = 0; j < 16; ++j) {
            const int row = rb * 128 + F.wave * 16 + j; const float* xr = x + (size_t)row * D;
            f32x4 v[2][2]; float ss = 0.f;
#pragma unroll
            for (int jj = 0; jj < 2; ++jj)
#pragma unroll
                for (int q = 0; q < 2; ++q) { v[jj][q] = __builtin_nontemporal_load((const GAS f32x4*)(xr + 512 * jj + 8 * F.lane + 4 * q)); ss += (v[jj][q].x * v[jj][q].x + v[jj][q].y * v[jj][q].y) + (v[jj][q].z * v[jj][q].z + v[jj][q].w * v[jj][q].w); }
            const float rinv = 1.0f / sqrtf(wave_sum(ss) * (1.0f / D) + EPS);
#pragma unroll
            for (int jj = 0; jj < 2; ++jj) { const int c0 = 512 * jj + 8 * F.lane;
                const f32x4 a0 = *(const LAS f32x4*)(Av + c0), a1 = *(const LAS f32x4*)(Av + c0 + 4), b0 = *(const LAS f32x4*)(Bv + c0), b1 = *(const LAS f32x4*)(Bv + c0 + 4);
                const f32x4 o0 = v[jj][0] * rinv * a0 + b0, o1 = v[jj][1] * rinv * a1 + b1;
                u32x4 w; w.x = cvtpk(o0.x, o0.y); w.y = cvtpk(o0.z, o0.w); w.z = cvtpk(o1.x, o1.y); w.w = cvtpk(o1.z, o1.w);
                *(GAS u32x4*)(h1 + (size_t)row * D + c0) = w;
                *(GAS u32x2*)((unsigned char*)(F.ws + WS_H1F8) + (size_t)row * D + c0) = pack8_fp8(o0, o1); }
        }
    }
}

struct ProbDense { int Kb; unsigned lda, ldb; const char* A; const char* B; static constexpr bool GATHER = false, F8 = false; const LAS unsigned* rowtab;
    __device__ __forceinline__ const char* a_ptr(const pg8::Unit& u) const { return A + (size_t)u.pm * 256 * lda; }
    __device__ __forceinline__ const char* b_ptr(const pg8::Unit& u) const { return B + (size_t)u.pn * 256 * ldb; } };
struct ProbDense8 { int Kb; unsigned lda, ldb; const char* A; const char* B; static constexpr bool GATHER = false, F8 = true; const LAS unsigned* rowtab;
    __device__ __forceinline__ const char* a_ptr(const pg8::Unit& u) const { return A + (size_t)u.pm * 256 * lda; }
    __device__ __forceinline__ const char* b_ptr(const pg8::Unit& u) const { return B + (size_t)u.pn * 256 * ldb; } };
struct ProbGateUp { int Kb; unsigned lda, ldb; const char* A; const char* B; static constexpr bool GATHER = true, F8 = true; const LAS unsigned* rowtab;
    __device__ __forceinline__ const char* a_ptr(const pg8::Unit&) const { return A; }
    __device__ __forceinline__ const char* b_ptr(const pg8::Unit& u) const { return B + ((size_t)(u.e & 63) * 1024 + (size_t)u.pn * 256) * ldb; } };
struct ProbDown { int Kb; unsigned lda, ldb; const char* A; const char* B; static constexpr bool GATHER = false, F8 = true; const LAS unsigned* rowtab;
    __device__ __forceinline__ const char* a_ptr(const pg8::Unit& u) const { return A + (size_t)u.pm * 256 * lda; }
    __device__ __forceinline__ const char* b_ptr(const pg8::Unit& u) const { return B + ((size_t)(u.e & 63) * 1024 + (size_t)u.pn * 256) * ldb; } };

struct CSh {
    LAS unsigned char* slab; unsigned woff, roff; int rrow, rpc;
    __device__ __forceinline__ CSh(int wr, int wc, int fr, int fq) {
        extern __shared__ __attribute__((aligned(16))) unsigned char lds_dyn[];
        int lane = fq * 16 + fr; asm volatile("" : "+v"(lane));
        fr = lane & 15; fq = lane >> 4; rrow = lane >> 2; rpc = lane & 3;
        slab = (LAS unsigned char*)lds_dyn + CSH_OFF + (wr * 4 + wc) * 2048;
        woff = (unsigned)(fr * 64 + ((fq ^ ((fr >> 1) & 3)) << 4)); roff = (unsigned)(rrow * 64 + ((rpc ^ ((rrow >> 1) & 3)) << 4)); }
    __device__ __forceinline__ u32x4 xch(int k, const u32x4 w) const { LAS unsigned char* s_ = slab + (k & 1) * 1024; *(LAS u32x4*)(s_ + woff) = w; return *(const LAS u32x4*)(s_ + roff); }
};
__device__ __forceinline__ u32x4 pack8(const f32x4 a, const f32x4 b) { u32x4 w; w.x = cvtpk(a[0], a[1]); w.y = cvtpk(a[2], a[3]); w.z = cvtpk(b[0], b[1]); w.w = cvtpk(b[2], b[3]); return w; }
__device__ __forceinline__ void unpack8(const u32x4 w, f32x4& a, f32x4& b) { a = (f32x4){bf_lo(w.x), bf_hi(w.x), bf_lo(w.y), bf_hi(w.y)}; b = (f32x4){bf_lo(w.z), bf_hi(w.z), bf_lo(w.w), bf_hi(w.w)}; }

struct EpiInProj {
    static constexpr bool PERM = true, MIDK = false;
    unsigned char* ws; int pn0; float scl;
    __device__ __forceinline__ void operator()(const f32x4 (&acc)[2][2][4][2], const pg8::Unit& u, int wr, int wc, int fr, int fq) const {
        const int pn = u.pn + pn0; bf16* base; int ldc, colt, act;
        if (pn < 2) { base = (bf16*)(ws + WS_Q); ldc = NQ; colt = 256 * pn; act = 0; }
        else if (pn == 2) { base = (bf16*)(ws + WS_KV); ldc = NKV; colt = 0; act = 1; }
        else if (pn < 5) { base = (bf16*)(ws + WS_GU); ldc = GMW; colt = 256 * (pn - 3); act = 2; }
        else if (pn < 7) { base = (bf16*)(ws + WS_GV); ldc = GMW; colt = 256 * (pn - 5); act = 2; }
        else if (pn < 11) { base = (bf16*)(ws + WS_GA); ldc = D; colt = 256 * (pn - 7); act = 3; }
        else { base = (bf16*)(ws + WS_GB); ldc = D; colt = 256 * (pn - 11); act = 4; }
        const int row0 = u.pm * 256 + wr * 64 + fr, col0 = colt + wc * 32 + 8 * fq;
        const CSh cs(wr, wc, fr, fq); int kk = 0;
#pragma unroll
        for (int ai = 0; ai < 2; ++ai)
#pragma unroll
            for (int m = 0; m < 4; ++m) { bf16* rowp = base + (size_t)(u.pm * 256 + wr * 64 + cs.rrow + ai * 128 + m * 16) * ldc + colt + wc * 32 + 8 * cs.rpc;
#pragma unroll
                for (int bj = 0; bj < 2; ++bj) { f32x4 v0 = acc[ai][bj][m][0], v1 = acc[ai][bj][m][1];
                    if (act == 0) { v0 = v0 * QSCALE; v1 = v1 * QSCALE; }
                    else if (act == 2) {
#pragma unroll
                        for (int q = 0; q < 4; ++q) { v0[q] = gelu_tanh_f(v0[q]); v1[q] = gelu_tanh_f(v1[q]); } }
                    else if (act >= 3) {
                        const float kx = -LOG2E * scl, lo = act == 4 ? 1.0f : 0.0f; unsigned wx = 0u, wy = 0u;
#pragma unroll
                        for (int q = 0; q < 4; ++q) {
                            const float c0 = fmaxf(__builtin_amdgcn_rcpf(__builtin_fmaf(__builtin_amdgcn_exp2f(acc[ai][bj][m][0][q] * kx), 1.0f / 255.0f, 1.0f / 255.0f)), lo);
                            const float c1 = fmaxf(__builtin_amdgcn_rcpf(__builtin_fmaf(__builtin_amdgcn_exp2f(acc[ai][bj][m][1][q] * kx), 1.0f / 255.0f, 1.0f / 255.0f)), lo);
                            wx = __builtin_amdgcn_cvt_pk_u8_f32(c0, q, wx); wy = __builtin_amdgcn_cvt_pk_u8_f32(c1, q, wy); }
                        u32x2 w; w.x = wx; w.y = wy;
                        *(GAS u32x2*)((unsigned char*)base + (size_t)(row0 + ai * 128 + m * 16) * ldc + col0 + bj * 128) = w; continue; }
                    *(GAS u32x4*)(rowp + bj * 128) = cs.xch(kk++, pack8(v0, v1)); } }
    }
};
struct EpiMerge {
    static constexpr bool PERM = true, MIDK = true;
    const unsigned char* GA; const unsigned char* GB; bf16* MG;
    __device__ __forceinline__ void mid(f32x4 (&acc)[2][2][4][2], const pg8::Unit& u, int wr, int wc, int fr_, int fq) const {
        int fr = fr_; asm volatile("" : "+v"(fr));
        const int row0 = u.pm * 256 + wr * 64 + fr, col0 = u.pn * 256 + wc * 32 + 8 * fq;
#pragma unroll
        for (int ai = 0; ai < 2; ++ai) {
            u32x2 ga[4][2], gb[4][2];
#pragma unroll
            for (int m = 0; m < 4; ++m)
#pragma unroll
                for (int bj = 0; bj < 2; ++bj) { const size_t off = (size_t)(row0 + ai * 128 + m * 16) * D + col0 + bj * 128; ga[m][bj] = *(const GAS u32x2*)(GA + off); gb[m][bj] = *(const GAS u32x2*)(GB + off); }
#pragma unroll
            for (int m = 0; m < 4; ++m)
#pragma unroll
                for (int bj = 0; bj < 2; ++bj) { f32x4 a0, a1, b0, b1; unpack8_u8(ga[m][bj], a0, a1); unpack8_u8(gb[m][bj], b0, b1);
#pragma unroll
                    for (int q = 0; q < 4; ++q) { acc[ai][bj][m][0][q] *= a0[q] * __builtin_amdgcn_rcpf(b0[q]); acc[ai][bj][m][1][q] *= a1[q] * __builtin_amdgcn_rcpf(b1[q]); } }
            asm volatile("" ::: "memory");
        }
    }
    __device__ __forceinline__ void operator()(const f32x4 (&acc)[2][2][4][2], const pg8::Unit& u, int wr, int wc, int fr, int fq) const {
        const int row0 = u.pm * 256 + wr * 64 + fr, col0 = u.pn * 256 + wc * 32 + 8 * fq;
        u32x2 gb[2][4][2];
#pragma unroll
        for (int ai = 0; ai < 2; ++ai)
#pragma unroll
            for (int m = 0; m < 4; ++m)
#pragma unroll
                for (int bj = 0; bj < 2; ++bj) gb[ai][m][bj] = *(const GAS u32x2*)(GB + (size_t)(row0 + ai * 128 + m * 16) * D + col0 + bj * 128);
        const CSh cs(wr, wc, fr, fq); int kk = 0;
#pragma unroll
        for (int ai = 0; ai < 2; ++ai)
#pragma unroll
            for (int m = 0; m < 4; ++m) { const size_t off = (size_t)(u.pm * 256 + wr * 64 + cs.rrow + ai * 128 + m * 16) * D + u.pn * 256 + wc * 32 + 8 * cs.rpc;
#pragma unroll
                for (int bj = 0; bj < 2; ++bj) { f32x4 b0, b1; unpack8_u8(gb[ai][m][bj], b0, b1);
                    *(GAS u32x4*)(MG + off + bj * 128) = cs.xch(kk++, pack8(acc[ai][bj][m][0] * b0 * (1.0f / 255.0f), acc[ai][bj][m][1] * b1 * (1.0f / 255.0f))); } }
    }
};
struct EpiWo {
    static constexpr bool PERM = true, MIDK = false;
    const float* x; const float* mod; bf16* XM;
    __device__ __forceinline__ void operator()(const f32x4 (&acc)[2][2][4][2], const pg8::Unit& u, int wr, int wc, int fr, int fq) const {
        const int row0 = u.pm * 256 + wr * 64 + fr, col0 = u.pn * 256 + wc * 32 + 8 * fq, b = u.pm >> 4;
        const CSh cs(wr, wc, fr, fq); int kk = 0;
        f32x4 g[2][2];
#pragma unroll
        for (int bj = 0; bj < 2; ++bj)
#pragma unroll
            for (int n = 0; n < 2; ++n) g[bj][n] = *(const GAS f32x4*)(mod + (size_t)b * 6 * D + 2 * D + col0 + bj * 128 + 4 * n);
#pragma unroll
        for (int ai = 0; ai < 2; ++ai) {
            f32x4 xv[4][2][2];
#pragma unroll
            for (int m = 0; m < 4; ++m)
#pragma unroll
                for (int bj = 0; bj < 2; ++bj)
#pragma unroll
                    for (int n = 0; n < 2; ++n) xv[m][bj][n] = __builtin_nontemporal_load((const GAS f32x4*)(x + (size_t)(row0 + ai * 128 + m * 16) * D + col0 + bj * 128 + 4 * n));
#pragma unroll
            for (int m = 0; m < 4; ++m) { const size_t off = (size_t)(u.pm * 256 + wr * 64 + cs.rrow + ai * 128 + m * 16) * D + u.pn * 256 + wc * 32 + 8 * cs.rpc;
#pragma unroll
                for (int bj = 0; bj < 2; ++bj) *(GAS u32x4*)(XM + off + bj * 128) = cs.xch(kk++, pack8(xv[m][bj][0] + g[bj][0] * acc[ai][bj][m][0], xv[m][bj][1] + g[bj][1] * acc[ai][bj][m][1])); }
            asm volatile("" ::: "memory");
        }
    }
};
struct EpiGateUp {
    static constexpr bool PERM = true, MIDK = false;
    unsigned char* H;
    __device__ __forceinline__ void operator()(const f32x4 (&acc)[2][2][4][2], const pg8::Unit& u, int wr, int wc, int fr, int fq) const {
        const int row0 = u.pm * 256 + wr * 64 + fr, col0 = u.pn * 128 + wc * 32 + 8 * fq;
#pragma unroll
        for (int ai = 0; ai < 2; ++ai)
#pragma unroll
            for (int m = 0; m < 4; ++m) { f32x4 v0, v1;
#pragma unroll
                for (int q = 0; q < 4; ++q) { constexpr float is = 1.0f / WGU_SCALE, k1 = -LOG2E * is, is2 = is * is;
                    v0[q] = acc[ai][0][m][0][q] * acc[ai][1][m][0][q] * (is2 * __builtin_amdgcn_rcpf(1.0f + __builtin_amdgcn_exp2f(acc[ai][0][m][0][q] * k1)));
                    v1[q] = acc[ai][0][m][1][q] * acc[ai][1][m][1][q] * (is2 * __builtin_amdgcn_rcpf(1.0f + __builtin_amdgcn_exp2f(acc[ai][0][m][1][q] * k1))); }
                *(GAS u32x2*)(H + (size_t)(row0 + ai * 128 + m * 16) * DEXP + col0) = pack8_fp8(v0, v1); }
    }
};
struct EpiDown {
    static constexpr bool PERM = true, MIDK = false;
    const unsigned* lrow; const float* lw; bf16* YT; const LAS unsigned* tab;
    __device__ __forceinline__ void operator()(const f32x4 (&acc)[2][2][4][2], const pg8::Unit& u, int wr, int wc, int fr, int fq) const {
        const int col0 = u.pn * 256 + wc * 32 + 8 * fq, lt0 = u.pn  ; (void)lt0;
        const int e = u.e & 63, cnt = u.e >> 6;
        const CSh cs(wr, wc, fr, fq); int kk = 0; (void)col0;
#pragma unroll
        for (int ai = 0; ai < 2; ++ai)
#pragma unroll
            for (int m = 0; m < 4; ++m) { const int rb = ai * 128 + wr * 64 + m * 16, r = rb + fr, rs = rb + cs.rrow, li = u.v + rs;
                const float wq = u.ui < 7 ? __uint_as_float(tab[2 * (u.ui * 256 + r) + 1]) : lw[(size_t)e * LIST_CAP + (u.v + r < cnt ? u.v + r : 0)] * (1.0f / WD_SCALE);
                const unsigned ent = u.ui < 7 ? tab[2 * (u.ui * 256 + rs)] : lrow[(size_t)e * LIST_CAP + (li < cnt ? li : 0)];
                bf16* dst = YT + (size_t)ent * D + u.pn * 256 + wc * 32 + 8 * cs.rpc;
#pragma unroll
                for (int bj = 0; bj < 2; ++bj) { const u32x4 t = cs.xch(kk++, pack8(acc[ai][bj][m][0] * wq, acc[ai][bj][m][1] * wq));
                    if (li < cnt) *(GAS u32x4*)(dst + bj * 128) = t; } }
    }
};
struct MoeOrder {
    const LAS int* utab; int n;
    __device__ __forceinline__ bool next(int i, pg8::Unit& u) const { if (i >= n) return false;
        u.pm = __builtin_amdgcn_readfirstlane(utab[4 * i]); u.pn = __builtin_amdgcn_readfirstlane(utab[4 * i + 1]); u.v = __builtin_amdgcn_readfirstlane(utab[4 * i + 2]); u.e = __builtin_amdgcn_readfirstlane(utab[4 * i + 3]); u.ui = i; return true; }
};
__device__ __forceinline__ int moe_tables(Frame& F, bool rows) {
    LAS int* utab = (LAS int*)(F.lds + TAB_UNITS); LAS int* cnts = (LAS int*)(F.lds + TAB_CNT); LAS int* nun = cnts + 72;
    LAS unsigned* rowtab = (LAS unsigned*)(F.lds + TAB_ROWS);
    __syncthreads();
    if (rows || MK_N_LAUNCHES != 1) {
        if (F.tid < 64) {
            const int lane = F.tid, c = lane < 32 ? (int)__hip_atomic_load(F.ctl + CW_CNT + 64 * lane, RLX_AGENT) : 0, tiles = (c + 255) >> 8;
            int x = tiles;
#pragma unroll
            for (int o = 1; o < 32; o <<= 1) { const int y = __shfl_up(x, o); if (lane >= o) x += y; }
            const int excl = x - tiles, total = __shfl(x, 31) * 4;
            int n = 0;
            for (int i = 0; i < MAX_WG_UNITS; ++i) { const int L = i * F.G + F.vcu; if (L >= total) break;
                const int rt = L >> 2, pn = L & 3;
                const unsigned long long m = __ballot(lane < 32 && excl <= rt && rt < excl + tiles);
                const int e = m ? __builtin_ctzll(m) : 0, ce = __shfl(c, e), lt = rt - __shfl(excl, e);
                if (lane == 0) { utab[4 * i] = rt; utab[4 * i + 1] = pn; utab[4 * i + 2] = lt * 256; utab[4 * i + 3] = e | (ce << 6); }
                ++n; }
            if (lane == 0) nun[0] = n;
        }
        __syncthreads();
    }
    const int n = nun[0];
    if (rows) {
        const unsigned* lrow = (const unsigned*)(F.ws + WS_LROW);
        for (int q = F.tid; q < n * 256; q += 512) { const int i = q >> 8, r = q & 255, e = utab[4 * i + 3] & 63, cnt = utab[4 * i + 3] >> 6, li = utab[4 * i + 2] + r;
            const unsigned tok = li < cnt ? (lrow[(size_t)e * LIST_CAP + li] >> 1) : 0u; rowtab[q] = tok * (unsigned)D; }
    } else {
        const unsigned* lrow = (const unsigned*)(F.ws + WS_LROW); const float* lw = (const float*)(F.ws + WS_LW);
        for (int q = F.tid; q < n * 256 && q < 7 * 256; q += 512) { const int i = q >> 8, r = q & 255, e = utab[4 * i + 3] & 63, cnt = utab[4 * i + 3] >> 6, li = utab[4 * i + 2] + r, lc = li < cnt ? li : 0;
            rowtab[2 * q] = lrow[(size_t)e * LIST_CAP + lc]; rowtab[2 * q + 1] = __float_as_uint(lw[(size_t)e * LIST_CAP + lc] * (1.0f / WD_SCALE)); }
    }
    __syncthreads();
    return n;
}

constexpr int KCH = 4112;
constexpr int AT_K = 0, AT_V = 8 * KCH  , AT_POS = AT_V + 32768, AT_TAB = AT_POS + 1024  , AT_TABT = AT_TAB + 4 * 132 * 4  ,
              AT_OST = 72704  , AT_END = AT_OST + 8 * 4096;
static_assert(AT_TABT + 4 * 200 * 4 <= AT_OST, "attention LDS");
static_assert(AT_END <= RING_BYTES, "attention LDS");
__device__ __forceinline__ int crow(int r, int hi) { return (r & 3) + 8 * (r >> 2) + 4 * hi; }
__device__ __forceinline__ s16x4 vtr(const LAS unsigned char* p) { typedef short v4i16_t __attribute__((ext_vector_type(4))); return __builtin_bit_cast(s16x4, __builtin_amdgcn_ds_read_tr16_b64_v4i16((LAS v4i16_t*)p)); }
__device__ __forceinline__ bf16x8 mk8(const s16x4 lo, const s16x4 hi) { return (bf16x8){lo[0], lo[1], lo[2], lo[3], hi[0], hi[1], hi[2], hi[3]}; }

__device__ __forceinline__ void attn_unit(Frame& F, const Args& A, int b, int blk, int kvh) {
    int tid = F.tid; asm volatile("" : "+v"(tid));
    const int lane = tid & 63, wid = F.wave, r32 = lane & 31, hi = lane >> 5;
    LAS unsigned char* L = F.lds + RING_OFF;
    const bf16* Q = (const bf16*)(F.ws + WS_Q); const bf16* KV = (const bf16*)(F.ws + WS_KV); bf16* YAB = (bf16*)(F.ws + WS_YAB);
    const int r0 = b * SEQ + blk * 128, rp = blk > 0 ? r0 - 128 : r0;
    __syncthreads();
#pragma unroll
    for (int j = 0; j < 4; ++j) { const int p = tid + 512 * j, key = p >> 3, c = p & 7; const int grow = key < 128 ? rp + key : r0 + key - 128;
        const u32x4 kk = *(const GAS u32x4*)(KV + (size_t)grow * NKV + kvh * 64 + c * 8);
        const u32x4 vv = *(const GAS u32x4*)(KV + (size_t)grow * NKV + 128 + kvh * 64 + c * 8);
        *(LAS u32x4*)(L + AT_K + c * KCH + key * 16) = kk;
        *(LAS u32x4*)(L + AT_V + ((key >> 4) * 2 + (c >> 2)) * 1024 + (key & 15) * 64 + (c & 3) * 16) = vv; }
    if (tid < 256) { const int grow = tid < 128 ? rp + tid : r0 + tid - 128; ((LAS int*)(L + AT_POS))[tid] = ((const int*)A.in[I_POS])[grow]; }
    if (tid < 200) { int n = tid - 36; n = n < 0 ? 0 : (n > 128 ? 128 : n); int bucket;
        if (n < 16) bucket = n; else { const int lg = (int)(logf((float)n / 16.0f) / logf(8.0f) * 16.0f); bucket = 16 + lg; if (bucket > 31) bucket = 31; }
#pragma unroll
        for (int g = 0; g < 4; ++g) { const float v = A.in[I_RELB][bucket * 8 + kvh * 4 + g] * LOG2E; ((LAS float*)(L + AT_TABT))[g * 200 + tid] = v; if (tid >= 36 && tid <= 164) ((LAS float*)(L + AT_TAB))[g * 132 + tid - 36] = v; } }
    __syncthreads();
    const int toep = __syncthreads_and(tid >= 255 || (blk == 0 && tid < 128) || ((const LAS int*)(L + AT_POS))[tid + 1] - ((const LAS int*)(L + AT_POS))[tid] == 1);
    const int g = wid & 3, qh = wid >> 2, head = kvh * 4 + g;
    const float sink2 = A.in[I_SINKS][head] * LOG2E;
    const LAS float* tab = (const LAS float*)(L + AT_TAB) + g * 132;
    const LAS int* posl = (const LAS int*)(L + AT_POS);
#pragma unroll 1
    for (int s = 0; s < 2; ++s) {
        const int i0 = 64 * qh + 32 * s, T0 = i0 >> 5;
        bf16x8 qr[4];
#pragma unroll
        for (int ks = 0; ks < 4; ++ks) qr[ks] = *(const GAS bf16x8*)(Q + (size_t)(r0 + i0 + r32) * NQ + head * 64 + ks * 16 + hi * 8);
        const int pq = posl[128 + i0 + r32];
        f32x16 p[5];
#pragma unroll
        for (int j = 0; j < 5; ++j) {
            f32x16 a = {};
#pragma unroll
            for (int ks = 0; ks < 4; ++ks) { const bf16x8 kf = *(const LAS bf16x8*)(L + AT_K + (2 * ks + hi) * KCH + (32 * (T0 + j) + r32) * 16);
                a = __builtin_amdgcn_mfma_f32_32x32x16_bf16(kf, qr[ks], a, 0, 0, 0); }
            p[j] = a;
        }
        float mx = sink2;
        if (toep) {
            const LAS float* tb = (const LAS float*)(L + AT_TABT) + g * 200 + (r32 - 4 * hi + 4);
#pragma unroll
            for (int j = 0; j < 5; ++j) {
                const bool tile_dead = (blk == 0) && (T0 + j < 4);
#pragma unroll
                for (int r = 0; r < 16; ++r) { const int kl = (r & 3) + 8 * (r >> 2) + 4 * hi;
                    float sv = p[j][r] + tb[160 - 32 * j - (r & 3) - 8 * (r >> 2)];
                    bool ok = !tile_dead;
                    if (j == 0) ok = ok && (kl > r32);
                    if (j == 4) ok = ok && (kl <= r32);
                    sv = ok ? sv : -1e30f;
                    p[j][r] = sv; mx = fmaxf(mx, sv); }
            }
        } else {
#pragma unroll
        for (int j = 0; j < 5; ++j) {
            const bool tile_dead = (blk == 0) && (T0 + j < 4);
#pragma unroll
            for (int rq = 0; rq < 4; ++rq) {
                const int k0 = 32 * (T0 + j) + 8 * rq + 4 * hi;
                typedef int i32x4 __attribute__((ext_vector_type(4))); const i32x4 pk = *(const LAS i32x4*)(posl + k0);
#pragma unroll
                for (int q = 0; q < 4; ++q) { const int r = 4 * rq + q, kl = 8 * rq + 4 * hi + q;
                    const int pkv = pk[q];
                    int n = pq - pkv; n = n < 0 ? 0 : (n > 128 ? 128 : n);
                    float sv = p[j][r] + tab[n];
                    bool ok = !tile_dead;
                    if (j == 0) ok = ok && (kl > r32);
                    if (j == 4) ok = ok && (kl <= r32);
                    sv = ok ? sv : -1e30f;
                    p[j][r] = sv; mx = fmaxf(mx, sv); }
            }
        }
        }
        mx = fmaxf(mx, __shfl_xor(mx, 32));
        float l = 0.f;
#pragma unroll
        for (int j = 0; j < 5; ++j)
#pragma unroll
            for (int r = 0; r < 16; ++r) { const float e = __builtin_amdgcn_exp2f(p[j][r] - mx); p[j][r] = e; l += e; }
        l += __shfl_xor(l, 32);
        l += __builtin_amdgcn_exp2f(sink2 - mx);
        const float rl = 1.0f / l;
        f32x16 o[2]; o[0] = (f32x16){}; o[1] = (f32x16){};
        const int vlane = (4 * hi + ((lane & 15) >> 2)) * 64 + ((lane >> 4) & 1) * 32 + (lane & 3) * 8;
#pragma unroll
        for (int j = 0; j < 5; ++j)
#pragma unroll
            for (int s2 = 0; s2 < 2; ++s2) {
                u32x4 pw; pw.x = cvtpk(p[j][8 * s2 + 0] * rl, p[j][8 * s2 + 1] * rl); pw.y = cvtpk(p[j][8 * s2 + 2] * rl, p[j][8 * s2 + 3] * rl);
                pw.z = cvtpk(p[j][8 * s2 + 4] * rl, p[j][8 * s2 + 5] * rl); pw.w = cvtpk(p[j][8 * s2 + 6] * rl, p[j][8 * s2 + 7] * rl);
                const bf16x8 pa = __builtin_bit_cast(bf16x8, pw);
                const int kg = 2 * (T0 + j) + s2;
#pragma unroll
                for (int d0 = 0; d0 < 2; ++d0) { const LAS unsigned char* vp = L + AT_V + (kg * 2 + d0) * 1024 + vlane;
                    const bf16x8 vf = mk8(vtr(vp), vtr(vp + 512));
                    o[d0] = __builtin_amdgcn_mfma_f32_32x32x16_bf16(pa, vf, o[d0], 0, 0, 0); }
            }
        {
            LAS bf16* stg = (LAS bf16*)(L + AT_OST + wid * 4096);
#pragma unroll
            for (int d0 = 0; d0 < 2; ++d0)
#pragma unroll
                for (int r = 0; r < 16; ++r) stg[crow(r, hi) * 64 + 32 * d0 + r32] = (bf16)(cvtpk(o[d0][r], 0.f) & 0xffffu);
#pragma unroll
            for (int i = 0; i < 4; ++i) { const int pc = lane + 64 * i, row = pc >> 3, ch = pc & 7;
                const u32x4 v = *(const LAS u32x4*)(stg + row * 64 + ch * 8);
                *(GAS u32x4*)(YAB + (size_t)(r0 + i0 + row) * D + head * 64 + ch * 8) = v; }
        }
    }
}

__device__ __forceinline__ void gmlp_unit(Frame& F, const Args& A, int b, int ch) {
    int tid = F.tid; asm volatile("" : "+v"(tid));
    const int lane = tid & 63, wid = F.wave, r32 = lane & 31, hi = lane >> 5;
    LAS unsigned char* L = F.lds + RING_OFF;
    const bf16* GU = (const bf16*)(F.ws + WS_GU); const bf16* GV = (const bf16*)(F.ws + WS_GV); bf16* YAB = (bf16*)(F.ws + WS_YAB);
    const bf16* WST = (const bf16*)(F.ws + WS_WST);
    const int r0 = b * SEQ + ch * 128;
    const int g = wid >> 1, chalf = wid & 1;
    bf16x8 wfl[20];
#pragma unroll
    for (int tt = 0; tt < 4; ++tt)
#pragma unroll
        for (int ks = 0; ks < 8; ++ks) if (ks <= 2 * tt + 1) wfl[tt * (tt + 1) + ks] = *(const GAS bf16x8*)(WST + ((size_t)g * 128 + 32 * tt + r32) * 128 + 16 * ks + 8 * hi);
    float bin[4]; u32x4 gun[4];
#pragma unroll
    for (int i = 0; i < 4; ++i) { const int pc = lane + 64 * i; bin[i] = A.in[I_GBS][g * 128 + (pc >> 3)]; gun[i] = *(const GAS u32x4*)(GU + (size_t)(r0 + (pc >> 3)) * GMW + g * 128 + 64 * chalf + 8 * (pc & 7)); }
    __syncthreads();
    {
        const float* lg = A.in[I_LNG]; const float* lb = A.in[I_LNB];
        const f32x4 g0 = *(const GAS f32x4*)(lg + 8 * lane), g1 = *(const GAS f32x4*)(lg + 8 * lane + 4), b0 = *(const GAS f32x4*)(lb + 8 * lane), b1 = *(const GAS f32x4*)(lb + 8 * lane + 4);
        const int grp = lane >> 4, cb = (lane & 15) >> 2;
        u32x4 gvr[16];
#pragma unroll
        for (int j = 0; j < 16; ++j) gvr[j] = *(const GAS u32x4*)(GV + (size_t)(r0 + 16 * wid + j) * GMW + 8 * lane);
#pragma unroll
        for (int j = 0; j < 16; ++j) {
            f32x4 v0, v1; unpack8(gvr[j], v0, v1);
            const float mu = wave_sum((v0[0] + v0[1]) + (v0[2] + v0[3]) + (v1[0] + v1[1]) + (v1[2] + v1[3])) * (1.0f / GMW);
            v0 = v0 - mu; v1 = v1 - mu;
            const float var = wave_sum((v0[0] * v0[0] + v0[1] * v0[1]) + (v0[2] * v0[2] + v0[3] * v0[3]) + (v1[0] * v1[0] + v1[1] * v1[1]) + (v1[2] * v1[2] + v1[3] * v1[3])) * (1.0f / GMW);
            const float rstd = __builtin_amdgcn_rsqf(var + EPS);
            *(LAS u32x4*)(L + grp * 32768 + (wid * 4 + cb) * 1024 + j * 64 + (lane & 3) * 16) = pack8(v0 * rstd * g0 + b0, v1 * rstd * g1 + b1); }
    }
    __syncthreads();
    const int vlane = (8 * hi + ((lane & 15) >> 2)) * 64 + ((lane >> 4) & 1) * 32 + (lane & 3) * 8;
    bf16x8 bfr[2][8];
#pragma unroll
    for (int ct = 0; ct < 2; ++ct)
#pragma unroll
        for (int ks = 0; ks < 8; ++ks) { const LAS unsigned char* vp = L + g * 32768 + (ks * 4 + 2 * chalf + ct) * 1024 + vlane; bfr[ct][ks] = mk8(vtr(vp), vtr(vp + 256)); }
    __syncthreads();
    LAS float* stg = (LAS float*)(L + wid * (32 * 68 * 4));
#pragma unroll
    for (int tt = 0; tt < 4; ++tt) {
        f32x16 acc[2]; acc[0] = (f32x16){}; acc[1] = (f32x16){};
#pragma unroll
        for (int ks = 0; ks < 8; ++ks) if (ks <= 2 * tt + 1) {
            acc[0] = __builtin_amdgcn_mfma_f32_32x32x16_bf16(wfl[tt * (tt + 1) + ks], bfr[0][ks], acc[0], 0, 0, 0);
            acc[1] = __builtin_amdgcn_mfma_f32_32x32x16_bf16(wfl[tt * (tt + 1) + ks], bfr[1][ks], acc[1], 0, 0, 0); }
#pragma unroll
        for (int ct = 0; ct < 2; ++ct)
#pragma unroll
            for (int r = 0; r < 16; ++r) stg[crow(r, hi) * 68 + 32 * ct + r32] = acc[ct][r];
        u32x4 gu[4]; float bi[4];
#pragma unroll
        for (int i = 0; i < 4; ++i) { gu[i] = gun[i]; bi[i] = bin[i]; }
        if (tt < 3) {
#pragma unroll
            for (int i = 0; i < 4; ++i) { const int pc = lane + 64 * i; bin[i] = A.in[I_GBS][g * 128 + 32 * (tt + 1) + (pc >> 3)];
                gun[i] = *(const GAS u32x4*)(GU + (size_t)(r0 + 32 * (tt + 1) + (pc >> 3)) * GMW + g * 128 + 64 * chalf + 8 * (pc & 7)); } }
#pragma unroll
        for (int i = 0; i < 4; ++i) { const int pc = lane + 64 * i, row = pc >> 3, chn = pc & 7, t = 32 * tt + row, c = g * 128 + 64 * chalf + 8 * chn;
            const f32x4 s0 = *(const LAS f32x4*)(stg + row * 68 + 8 * chn), s1 = *(const LAS f32x4*)(stg + row * 68 + 8 * chn + 4);
            const float bb = bi[i]; f32x4 u0, u1; unpack8(gu[i], u0, u1);
            *(GAS u32x4*)(YAB + (size_t)(r0 + t) * D + NQ + c) = pack8(u0 * (s0 + bb), u1 * (s1 + bb)); }
    }
}

__device__ __forceinline__ void router_images(Frame& F, const Args& A) {
    const float* mod = (const float*)(F.ws + WS_MOD); bf16* GT = (bf16*)(F.ws + WS_GT); float* GC = (float*)(F.ws + WS_GC);
    LAS float* red = (LAS float*)(F.lds + RING_OFF);
    for (int it = F.vcu; it < 8 * 48; it += F.G) { const int b = it / 48, n = it % 48; float part = 0.f;
#pragma unroll
        for (int cc = 0; cc < 2; ++cc) { const int c = F.tid + 512 * cc;
            const float sh = mod[(size_t)b * 6 * D + 3 * D + c], sc = mod[(size_t)b * 6 * D + 4 * D + c], a2 = A.in[I_N2G][c] * (1.0f + sc);
            const float w = n < 4 ? A.in[I_WRG][(size_t)c * 4 + n] : (n < 36 ? A.in[I_WRE][(size_t)c * 32 + (n - 4)] : 0.f);
            GT[((size_t)b * 48 + n) * D + c] = (bf16)(cvtpk(a2 * w, 0.f) & 0xffffu); part += sh * w; }
        part = wave_sum(part);
        __syncthreads(); if (F.lane == 0) red[F.wave] = part; __syncthreads();
        if (F.tid == 0) { float s = n < 4 ? A.in[I_BRG][n] : (n < 36 ? A.in[I_BRE][n - 4] : 0.f);
#pragma unroll
            for (int w = 0; w < 8; ++w) s += red[w];
            GC[b * 48 + n] = s; }
    }
}

constexpr int GT_STRIDE = 2064;
constexpr int R6_GT = 0, R6_A2 = 48 * GT_STRIDE  , R6_B2 = R6_A2 + 4096, R6_CONST = R6_B2 + 4096, R6_LCNT = R6_CONST + 256, R6_LBASE = R6_LCNT + 128, R6_RED = R6_LBASE + 128, R6_LOG = R6_RED + 8 * 40 * 4, R6_END = R6_LOG + 8 * 16 * 40 * 4;
static_assert(R6_END <= RING_BYTES, "router LDS");
__device__ __forceinline__ void p6_router(Frame& F, const Args& A) {
    const int wid = F.wave;
    LAS unsigned char* L = F.lds + RING_OFF;
    const float* mod = (const float*)(F.ws + WS_MOD);
    const bf16* XM = (const bf16*)(F.ws + WS_XMID); unsigned char* H2 = (unsigned char*)(F.ws + WS_H2);
    unsigned* lrow = (unsigned*)(F.ws + WS_LROW); float* lw = (float*)(F.ws + WS_LW);
    LAS float* A2 = (LAS float*)(L + R6_A2); LAS float* B2 = (LAS float*)(L + R6_B2); LAS float* cst = (LAS float*)(L + R6_CONST);
    LAS int* lcnt = (LAS int*)(L + R6_LCNT); LAS int* lbase = (LAS int*)(L + R6_LBASE); LAS float* red = (LAS float*)(L + R6_RED);
    LAS float* lg = (LAS float*)(L + R6_LOG) + wid * 16 * 40;
    for (int rb = F.vcu; rb < M / 128; rb += F.G) {
        const int b = rb / (SEQ / 128);
        int tid = F.tid; asm volatile("" : "+v"(tid)); const int lane = tid & 63;
        const int rloc = lane & 15, kq = lane >> 4, row = rb * 128 + wid * 16 + rloc;
        u32x4 xk[32];
#pragma unroll
        for (int ks = 0; ks < 32; ++ks) xk[ks] = *(const GAS u32x4*)(XM + (size_t)row * D + 32 * ks + 8 * kq);
        asm volatile("" ::: "memory");
        __syncthreads();
        {
            const bf16* GTb = (const bf16*)(F.ws + WS_GT) + (size_t)b * 48 * D;
            u32x4 gt[12];
#pragma unroll
            for (int i = 0; i < 12; ++i) gt[i] = *(const GAS u32x4*)(GTb + (size_t)(tid + 512 * i) * 8);
#pragma unroll
            for (int cc = 0; cc < 2; ++cc) { const int c = tid + 512 * cc; A2[c] = A.in[I_N2G][c] * (1.0f + mod[(size_t)b * 6 * D + 4 * D + c]); B2[c] = mod[(size_t)b * 6 * D + 3 * D + c]; }
            if (tid < 48) cst[tid] = ((const float*)(F.ws + WS_GC))[b * 48 + tid];
            if (tid < 32) lcnt[tid] = 0;
#pragma unroll
            for (int i = 0; i < 12; ++i) { const int pc = tid + 512 * i, n = pc >> 7, ch = pc & 127; *(LAS u32x4*)(L + R6_GT + n * GT_STRIDE + ch * 16) = gt[i]; }
        }
        __syncthreads();
        float ss = 0.f;
#pragma unroll
        for (int ks = 0; ks < 32; ++ks) { f32x4 a, c; unpack8(xk[ks], a, c); ss += (a[0] * a[0] + a[1] * a[1]) + (a[2] * a[2] + a[3] * a[3]) + (c[0] * c[0] + c[1] * c[1]) + (c[2] * c[2] + c[3] * c[3]); }
        ss += __shfl_xor(ss, 16); ss += __shfl_xor(ss, 32);
        const float rinv = 1.0f / sqrtf(ss * (1.0f / D) + EPS);
        f32x4 acc[3]; acc[0] = (f32x4){0.f, 0.f, 0.f, 0.f}; acc[1] = acc[0]; acc[2] = acc[0];
#pragma unroll
        for (int ks = 0; ks < 32; ++ks) { const bf16x8 af = __builtin_bit_cast(bf16x8, xk[ks]);
#pragma unroll
            for (int nt = 0; nt < 3; ++nt) { const bf16x8 bfg = *(const LAS bf16x8*)(L + R6_GT + (16 * nt + rloc) * GT_STRIDE + (32 * ks + 8 * kq) * 2);
                acc[nt] = __builtin_amdgcn_mfma_f32_16x16x32_bf16(af, bfg, acc[nt], 0, 0, 0); }
            if ((ks & 3) == 3) asm volatile("" ::: "memory"); }
#pragma unroll
        for (int nt = 0; nt < 3; ++nt) { const int n = 16 * nt + rloc; if (n < 36) {
#pragma unroll
            for (int q = 0; q < 4; ++q) lg[(4 * kq + q) * 40 + n] = acc[nt][q]; } }
#pragma unroll
        for (int ks = 0; ks < 32; ++ks) asm volatile("" : "+v"(xk[ks]));
#pragma unroll
        for (int ks = 0; ks < 32; ++ks) { const int c0 = 32 * ks + 8 * kq; f32x4 a, c; unpack8(xk[ks], a, c);
            const f32x4 a0 = *(const LAS f32x4*)(A2 + c0), a1 = *(const LAS f32x4*)(A2 + c0 + 4), b0 = *(const LAS f32x4*)(B2 + c0), b1 = *(const LAS f32x4*)(B2 + c0 + 4);
            *(GAS u32x2*)(H2 + (size_t)row * D + c0) = pack8_fp8(a * rinv * a0 + b0, c * rinv * a1 + b1);
            if ((ks & 3) == 3) asm volatile("" ::: "memory"); }
        LDS_WAIT(); asm volatile("" ::: "memory");
        int e1 = 0, e2 = 0, lp1 = 0, lp2 = 0; float w1 = 0.f, w2 = 0.f;
        if (lane < 16) {
            const LAS float* lr = lg + lane * 40;
            float l0[4]; int gi = 0;
#pragma unroll
            for (int n = 0; n < 4; ++n) l0[n] = lr[n] * rinv + cst[n];
            float gm = l0[0];
#pragma unroll
            for (int n = 1; n < 4; ++n) if (l0[n] > gm) { gm = l0[n]; gi = n; }
            float gs = 0.f;
#pragma unroll
            for (int n = 0; n < 4; ++n) gs += __expf(l0[n] - gm);
            const float pg = 1.0f / gs;
            float le[8];
#pragma unroll
            for (int j = 0; j < 8; ++j) le[j] = lr[4 + 8 * gi + j] * rinv + cst[4 + 8 * gi + j];
            int i1 = 0; float m1 = le[0];
#pragma unroll
            for (int j = 1; j < 8; ++j) if (le[j] > m1) { m1 = le[j]; i1 = j; }
            int i2 = -1; float m2 = -INFINITY;
#pragma unroll
            for (int j = 0; j < 8; ++j) if (j != i1 && le[j] > m2) { m2 = le[j]; i2 = j; }
            const float ex = __expf(m2 - m1); const float t1 = 1.0f / (1.0f + ex);
            w1 = pg * t1; w2 = pg * (ex * t1);
            if (i2 < 0) i2 = (i1 + 1) & 7;
            e1 = gi * 8 + i1; e2 = gi * 8 + i2;
            lp1 = atomicAdd((int*)&lcnt[e1], 1); lp2 = atomicAdd((int*)&lcnt[e2], 1);
        }
        __syncthreads();
        if (tid < 32) { const int c = lcnt[tid]; lbase[tid] = c > 0 ? (int)__hip_atomic_fetch_add(F.ctl + CW_CNT + 64 * tid, (unsigned)c, RLX_AGENT) : 0; }
        __syncthreads();
        if (lane < 16) {
            const int p1 = lbase[e1] + lp1, p2 = lbase[e2] + lp2;
            lrow[(size_t)e1 * LIST_CAP + p1] = (unsigned)row * 2u; lw[(size_t)e1 * LIST_CAP + p1] = w1;
            lrow[(size_t)e2 * LIST_CAP + p2] = (unsigned)row * 2u + 1u; lw[(size_t)e2 * LIST_CAP + p2] = w2;
#if DEBUG_CHECKS
            { float* rec = (float*)(F.ws + 490 * MiB) + (size_t)row * 4; rec[0] = (float)e1; rec[1] = (float)e2; rec[2] = w1; rec[3] = w2; }
#endif
        }
    }
}

__device__ __forceinline__ void p9_final(Frame& F, const Args& A) {
    const int lane = F.lane, wid = F.wave;
    const float* mod = (const float*)(F.ws + WS_MOD); const bf16* XM = (const bf16*)(F.ws + WS_XMID); const bf16* YT = (const bf16*)(F.ws + WS_YT);
    for (int rb = F.vcu; rb < M / 128; rb += F.G) {
        const int b = rb / (SEQ / 128);
        f32x4 g2[2][2], fg[2][2];
#pragma unroll
        for (int jj = 0; jj < 2; ++jj)
#pragma unroll
            for (int q = 0; q < 2; ++q) { const int c = 512 * jj + 8 * lane + 4 * q; g2[jj][q] = *(const GAS f32x4*)(mod + (size_t)b * 6 * D + 5 * D + c); fg[jj][q] = *(const GAS f32x4*)(A.in[I_FG] + c); }
#pragma unroll 1
        for (int j0 = 0; j0 < 16; j0 += 4) {
            u32x4 xm[4][2], y0[4][2], y1[4][2];
#pragma unroll
            for (int jr = 0; jr < 4; ++jr) { const int row = rb * 128 + wid * 16 + j0 + jr;
#pragma unroll
                for (int jj = 0; jj < 2; ++jj) { const int c = 512 * jj + 8 * lane;
                    xm[jr][jj] = __builtin_nontemporal_load((const GAS u32x4*)(XM + (size_t)row * D + c));
                    y0[jr][jj] = __builtin_nontemporal_load((const GAS u32x4*)(YT + (size_t)row * 2 * D + c));
                    y1[jr][jj] = __builtin_nontemporal_load((const GAS u32x4*)(YT + (size_t)row * 2 * D + D + c)); } }
#pragma unroll
            for (int jr = 0; jr < 4; ++jr) { const int row = rb * 128 + wid * 16 + j0 + jr;
                f32x4 v[2][2]; float ss = 0.f;
#pragma unroll
                for (int jj = 0; jj < 2; ++jj) { f32x4 x0, x1, a0, a1, z0, z1;
                    unpack8(xm[jr][jj], x0, x1); unpack8(y0[jr][jj], a0, a1); unpack8(y1[jr][jj], z0, z1);
                    v[jj][0] = x0 + g2[jj][0] * (a0 + z0); v[jj][1] = x1 + g2[jj][1] * (a1 + z1);
#pragma unroll
                    for (int q = 0; q < 2; ++q) ss += (v[jj][q][0] * v[jj][q][0] + v[jj][q][1] * v[jj][q][1]) + (v[jj][q][2] * v[jj][q][2] + v[jj][q][3] * v[jj][q][3]); }
                const float rinv = 1.0f / sqrtf(wave_sum(ss) * (1.0f / D) + EPS);
#pragma unroll
                for (int jj = 0; jj < 2; ++jj)
#pragma unroll
                    for (int q = 0; q < 2; ++q) __builtin_nontemporal_store(v[jj][q] * rinv * fg[jj][q], (GAS f32x4*)(A.out + (size_t)row * D + 512 * jj + 8 * lane + 4 * q)); }
        }
    }
}

__global__ void __launch_bounds__(NWAVES * 64, 2) mk_fwd(Args args) {
    extern __shared__ __attribute__((aligned(16))) unsigned char lds[];
    Frame F;
    F.lds = (LAS unsigned char*)lds;
    F.MISC = (volatile LAS unsigned*)(F.lds + MISC_OFF);
    F.tid = threadIdx.x; F.lane = F.tid & 63; F.wave = __builtin_amdgcn_readfirstlane(F.tid >> 6);
    F.G = gridDim.x; { const int bx = blockIdx.x; F.vcu = (F.G % 8 == 0) ? (bx % 8) * (F.G / 8) + bx / 8 : bx; }
    F.ws = args.ws; F.ctl = (gu32*)(args.ws + WS_CTL);
    for (int u = F.tid; u < (TAB_OFF - LDSCTL_OFF) / 4; u += NWAVES * 64) ((LAS unsigned*)(F.lds + LDSCTL_OFF))[u] = 0u;
    __syncthreads();
    XcdBarrier bar; bar.bar = (unsigned*)(F.ctl + CW_BAR); bar.x = 0; bar.st = nullptr;
    if (MK_N_LAUNCHES == 1) bar = xcd_barrier_post((unsigned*)(F.ctl + CW_BAR), F.MISC + 8);
#define GRID_BAR() do { if (MK_N_LAUNCHES == 1) xcd_barrier(bar); } while (0)
    const int lo = args.ph_lo, hi = args.ph_hi;
#ifdef ONLY_PHASE
#define IN(k) ((k) == ONLY_PHASE && lo <= (k) && (k) < hi)
#else
#define IN(k) (lo <= (k) && (k) < hi)
#endif
#define BOTH(k) (IN(k) && IN((k) + 1))

    if (IN(0)) { p0_prologue(F, args); if (BOTH(0)) GRID_BAR(); }
    if (IN(1)) { p1_h1(F, args); if (BOTH(1)) GRID_BAR(); }
    if (IN(2)) {
        const bool fp8_first = (blockIdx.x & 1) != 0;
#define P2_BF16() do { ProbDense P{D * 2, D * 2u, D * 2u, (const char*)(F.ws + WS_A), (const char*)(F.ws + WS_WIN), nullptr}; \
            pg8::DenseOrder S; S.init(M, NBF, F.G, (int)blockIdx.x); EpiInProj E{F.ws, 0, 1.0f}; \
            pg8::gemm_phase<ProbDense, EpiInProj, pg8::DenseOrder, true>(F.lds + RING_OFF, P, S, E); } while (0)
#define P2_FP8() do { ProbDense8 P{D, (unsigned)D, (unsigned)D, (const char*)(F.ws + WS_H1F8), (const char*)(F.ws + WS_WIN8), nullptr}; \
            pg8::BackfillOrder S; S.init(M, INW - NBF, F.G, (int)blockIdx.x); EpiInProj E{F.ws, NBF / 256, 1.0f / WGU_SCALE}; \
            pg8::gemm_phase<ProbDense8, EpiInProj, pg8::BackfillOrder, true>(F.lds + RING_OFF, P, S, E); } while (0)
        if (fp8_first) { P2_FP8(); P2_BF16(); } else { P2_BF16(); P2_FP8(); }
#undef P2_BF16
#undef P2_FP8
        if (BOTH(2)) GRID_BAR();
    }
    if (IN(3)) {
        router_images(F, args);
        for (int ub = F.vcu; ub < M / 128; ub += F.G) { const int b = ub / (SEQ / 128), blk = ub % (SEQ / 128);

#ifndef NO_ATTN
#pragma unroll 1
            for (int kvh = 0; kvh < 2; ++kvh) attn_unit(F, args, b, blk, kvh);
            asm volatile("" ::: "memory");
#endif
#ifndef NO_GMLP
            gmlp_unit(F, args, b, blk);
#endif
        }
        __syncthreads();
        if (BOTH(3)) GRID_BAR();
    }
    if (IN(4)) {
        ProbDense P{D * 2, D * 2u, D * 2u, (const char*)(F.ws + WS_YAB), (const char*)(F.ws + WS_PA), nullptr};
        pg8::DenseOrder S; S.init(M, D, F.G, (int)blockIdx.x);
        EpiMerge E{(const unsigned char*)(F.ws + WS_GA), (const unsigned char*)(F.ws + WS_GB), (bf16*)(F.ws + WS_A)};
        pg8::gemm_phase<ProbDense, EpiMerge, pg8::DenseOrder, true>(F.lds + RING_OFF, P, S, E);
        if (BOTH(4)) GRID_BAR();
    }
    if (IN(5)) {
        ProbDense P{D * 2, D * 2u, D * 2u, (const char*)(F.ws + WS_A), (const char*)(F.ws + WS_WO), nullptr};
        pg8::DenseOrder S; S.init(M, D, F.G, (int)blockIdx.x);
        EpiWo E{args.in[I_X], (const float*)(F.ws + WS_MOD), (bf16*)(F.ws + WS_XMID)};
        pg8::gemm_phase<ProbDense, EpiWo, pg8::DenseOrder, true>(F.lds + RING_OFF, P, S, E);
        if (BOTH(5)) GRID_BAR();
    }
    if (IN(6)) { p6_router(F, args); __syncthreads(); if (BOTH(6)) GRID_BAR(); }
    if (IN(7)) {
        const int n = moe_tables(F, true);
        ProbGateUp P{D, (unsigned)D, (unsigned)D, (const char*)(F.ws + WS_H2), (const char*)(F.ws + WS_WGU), (const LAS unsigned*)(F.lds + TAB_ROWS)};
        MoeOrder S{(const LAS int*)(F.lds + TAB_UNITS), n};
        EpiGateUp E{(unsigned char*)(F.ws + WS_HACT)};
        pg8::gemm_phase<ProbGateUp, EpiGateUp, MoeOrder, true>(F.lds + RING_OFF, P, S, E);
        if (BOTH(7)) GRID_BAR();
    }
    if (IN(8)) {
        const int n = moe_tables(F, false);
        ProbDown P{DEXP, (unsigned)DEXP, (unsigned)DEXP, (const char*)(F.ws + WS_HACT), (const char*)(F.ws + WS_WD), nullptr};
        MoeOrder S{(const LAS int*)(F.lds + TAB_UNITS), n};
        EpiDown E{(const unsigned*)(F.ws + WS_LROW), (const float*)(F.ws + WS_LW), (bf16*)(F.ws + WS_YT), (const LAS unsigned*)(F.lds + TAB_ROWS)};
        pg8::gemm_phase<ProbDown, EpiDown, MoeOrder, true>(F.lds + RING_OFF, P, S, E);
        if (BOTH(8)) GRID_BAR();
    }
    if (IN(9)) { p9_final(F, args); }
#undef IN
#undef BOTH
}


#if DEBUG_CHECKS
constexpr size_t WS_DBG = 490 * MiB;
constexpr int CW_DBG = 200000;
constexpr int NSAMP = 512;
__device__ __forceinline__ int samp_row(int i) { return 64 * i + ((i * 7) & 63); }
__device__ __forceinline__ float bfr(float v) { return bf_lo(cvtpk(v, 0.f) & 0xffffu); }
__device__ __forceinline__ float ldbf(const bf16* p) { return __uint_as_float((unsigned)(*p) << 16); }
__device__ __forceinline__ float f8dec(unsigned char b) { return __builtin_amdgcn_cvt_f32_fp8((int)b, 0); }
__device__ __forceinline__ float f8r(float v) { return f8dec((unsigned char)(pk4_fp8(v, 0.f, 0.f, 0.f) & 0xffu)); }
__device__ __forceinline__ void dbg_acc(unsigned char* ws, int k, float err, float ref) { float* a = (float*)(ws + WS_CTL) + CW_DBG; atomicAdd(a + 2 * k, err * err); atomicAdd(a + 2 * k + 1, ref * ref); }
__device__ __forceinline__ float block_sum256(float v, float* sh) {
    v = wave_sum(v); __syncthreads(); if ((threadIdx.x & 63) == 0) sh[threadIdx.x >> 6] = v; __syncthreads(); const float r = sh[0] + sh[1] + sh[2] + sh[3]; __syncthreads(); return r; }
__global__ void __launch_bounds__(256) chk_h1(Args a) {
    __shared__ float sh[8];
    const int row = samp_row(blockIdx.x), b = row / SEQ, t = threadIdx.x;
    float sc[4], shf[4];
#pragma unroll
    for (int q = 0; q < 4; ++q) { sc[q] = a.in[I_BADA][D + t + 256 * q]; shf[q] = a.in[I_BADA][t + 256 * q]; }
    for (int k = 0; k < D; ++k) { const float cv = a.in[I_C][b * D + k]; const float cs = cv / (1.0f + expf(-cv));
#pragma unroll
        for (int q = 0; q < 4; ++q) { sc[q] += cs * a.in[I_WADA][(size_t)k * 6 * D + D + t + 256 * q]; shf[q] += cs * a.in[I_WADA][(size_t)k * 6 * D + t + 256 * q]; } }
    float ss = 0.f; float xv[4];
#pragma unroll
    for (int q = 0; q < 4; ++q) { xv[q] = a.in[I_X][(size_t)row * D + t + 256 * q]; ss += xv[q] * xv[q]; }
    const float rinv = 1.0f / sqrtf(block_sum256(ss, sh) / D + EPS);
    const bf16* h1 = (const bf16*)(a.ws + WS_A);
#pragma unroll
    for (int q = 0; q < 4; ++q) { const int c = t + 256 * q; const float ref = xv[q] * rinv * a.in[I_N1G][c] * (1.0f + sc[q]) + shf[q]; dbg_acc(a.ws, 0, ldbf(h1 + (size_t)row * D + c) - ref, ref); }
}
__global__ void __launch_bounds__(256) chk_inproj(Args a) {
    const int idx = blockIdx.x * 256 + threadIdx.x; if (idx >= NSAMP * INW) return;
    const int row = samp_row(idx / INW), n = idx % INW;
    const bf16* h1 = (const bf16*)(a.ws + WS_A); float s = 0.f;
    if (n < NBF) { for (int k = 0; k < D; ++k) s += ldbf(h1 + (size_t)row * D + k) * bfr(a.in[I_WIN][(size_t)k * INW + n]); }
    else { for (int k = 0; k < D; ++k) s += f8dec(((const unsigned char*)(a.ws + WS_H1F8))[(size_t)row * D + k]) * f8r(a.in[I_WIN][(size_t)k * INW + n] * WGU_SCALE); s *= 1.0f / WGU_SCALE; }
    float ref, got;
    if (n < 512) { ref = s * QSCALE; got = ldbf((const bf16*)(a.ws + WS_Q) + (size_t)row * NQ + n); }
    else if (n < 768) { ref = s; got = ldbf((const bf16*)(a.ws + WS_KV) + (size_t)row * NKV + n - 512); }
    else if (n < 1280) { ref = 0.5f * s * (1.0f + tanhf(0.7978845608f * (s + 0.044715f * s * s * s))); got = ldbf((const bf16*)(a.ws + WS_GU) + (size_t)row * GMW + n - 768); }
    else if (n < 1792) { ref = 0.5f * s * (1.0f + tanhf(0.7978845608f * (s + 0.044715f * s * s * s))); got = ldbf((const bf16*)(a.ws + WS_GV) + (size_t)row * GMW + n - 1280); }
    else if (n < 2816) { ref = 1.0f / (1.0f + expf(-s)); got = (float)((const unsigned char*)(a.ws + WS_GA))[(size_t)row * D + n - 1792] * (1.0f / 255.0f); }
    else { ref = fmaxf(1.0f / (1.0f + expf(-s)), 1.0f / 255.0f); got = (float)((const unsigned char*)(a.ws + WS_GB))[(size_t)row * D + n - 2816] * (1.0f / 255.0f); }
    dbg_acc(a.ws, 1, got - ref, ref);
}
__global__ void __launch_bounds__(256) chk_attn(Args a) {
    const int idx = blockIdx.x * 256 + threadIdx.x; if (idx >= NSAMP * 8 * 4) return;
    const int row = samp_row(idx / 32), head = (idx >> 2) & 7, dq = idx & 3, b = row / SEQ, tpos = row % SEQ, blk = tpos / 128, kvh = head >> 2;
    const bf16* Q = (const bf16*)(a.ws + WS_Q); const bf16* KV = (const bf16*)(a.ws + WS_KV); const int* pos = (const int*)a.in[I_POS];
    const int band0 = b * SEQ + blk * 128 - 128;
    const int i = tpos % 128;
    float m = a.in[I_SINKS][head], l = 0.f; float o[16];
#pragma unroll
    for (int d = 0; d < 16; ++d) o[d] = 0.f;
    for (int kj = i + 1; kj <= i + 128; ++kj) { if (blk == 0 && kj < 128) continue; const int kr = band0 + kj;
        float s = 0.f; for (int d = 0; d < 64; ++d) s += ldbf(Q + (size_t)row * NQ + head * 64 + d) * ldbf(KV + (size_t)kr * NKV + kvh * 64 + d);
        s *= (1.0f / LOG2E);
        int n = pos[row] - pos[kr]; if (n < 0) n = 0; int bucket; if (n < 16) bucket = n; else { bucket = 16 + (int)(logf((float)n / 16.0f) / logf(8.0f) * 16.0f); if (bucket > 31) bucket = 31; }
        s += a.in[I_RELB][bucket * 8 + head]; m = fmaxf(m, s); }
    for (int kj = i + 1; kj <= i + 128; ++kj) { if (blk == 0 && kj < 128) continue; const int kr = band0 + kj;
        float s = 0.f; for (int d = 0; d < 64; ++d) s += ldbf(Q + (size_t)row * NQ + head * 64 + d) * ldbf(KV + (size_t)kr * NKV + kvh * 64 + d);
        s *= (1.0f / LOG2E);
        int n = pos[row] - pos[kr]; if (n < 0) n = 0; int bucket; if (n < 16) bucket = n; else { bucket = 16 + (int)(logf((float)n / 16.0f) / logf(8.0f) * 16.0f); if (bucket > 31) bucket = 31; }
        s += a.in[I_RELB][bucket * 8 + head]; const float p = expf(s - m); l += p;
#pragma unroll
        for (int d = 0; d < 16; ++d) o[d] += p * ldbf(KV + (size_t)kr * NKV + 128 + kvh * 64 + dq * 16 + d); }
    l += expf(a.in[I_SINKS][head] - m);
    const bf16* yab = (const bf16*)(a.ws + WS_YAB);
#pragma unroll
    for (int d = 0; d < 16; ++d) { const float ref = o[d] / l; dbg_acc(a.ws, 2, ldbf(yab + (size_t)row * D + head * 64 + dq * 16 + d) - ref, ref); }
}
__global__ void __launch_bounds__(512) chk_gmlp(Args a) {
    __shared__ float sh[16];
    const int row = samp_row(blockIdx.x), c = threadIdx.x, g = c >> 7, r0 = row & ~127, t = row & 127;
    const bf16* GU = (const bf16*)(a.ws + WS_GU); const bf16* GV = (const bf16*)(a.ws + WS_GV);
    float acc = 0.f;
    for (int s = 0; s <= t; ++s) { const float v = ldbf(GV + (size_t)(r0 + s) * GMW + c);
        float x = wave_sum(v); __syncthreads(); if ((c & 63) == 0) sh[c >> 6] = x; __syncthreads(); float tot = 0.f; for (int w = 0; w < 8; ++w) tot += sh[w]; const float mu = tot / GMW;
        x = wave_sum((v - mu) * (v - mu)); __syncthreads(); if ((c & 63) == 0) sh[c >> 6] = x; __syncthreads(); tot = 0.f; for (int w = 0; w < 8; ++w) tot += sh[w]; const float rstd = 1.0f / sqrtf(tot / GMW + EPS);
        const float vn = bfr((v - mu) * rstd * a.in[I_LNG][c] + a.in[I_LNB][c]);
        acc += bfr(a.in[I_GWS][((size_t)g * 128 + t) * 128 + s]) * vn; }
    const float ref = ldbf(GU + (size_t)row * GMW + c) * (acc + a.in[I_GBS][g * 128 + t]);
    dbg_acc(a.ws, 3, ldbf((const bf16*)(a.ws + WS_YAB) + (size_t)row * D + NQ + c) - ref, ref);
}
__global__ void __launch_bounds__(256) chk_merge(Args a) {
    const int idx = blockIdx.x * 256 + threadIdx.x; if (idx >= NSAMP * D) return;
    const int row = samp_row(idx / D), n = idx % D; const bf16* yab = (const bf16*)(a.ws + WS_YAB);
    float sa = 0.f, sb = 0.f;
    for (int k = 0; k < 512; ++k) { sa += ldbf(yab + (size_t)row * D + k) * bfr(a.in[I_PA][(size_t)k * D + n]); sb += ldbf(yab + (size_t)row * D + 512 + k) * bfr(a.in[I_PB][(size_t)k * D + n]); }
    const float ref = (float)((const unsigned char*)(a.ws + WS_GA))[(size_t)row * D + n] * (1.0f / 255.0f) * sa + (float)((const unsigned char*)(a.ws + WS_GB))[(size_t)row * D + n] * (1.0f / 255.0f) * sb;
    dbg_acc(a.ws, 4, ldbf((const bf16*)(a.ws + WS_A) + (size_t)row * D + n) - ref, ref);
}
__global__ void __launch_bounds__(256) chk_wo(Args a) {
    const int idx = blockIdx.x * 256 + threadIdx.x; if (idx >= NSAMP * D) return;
    const int row = samp_row(idx / D), n = idx % D, b = row / SEQ; const bf16* mg = (const bf16*)(a.ws + WS_A);
    float s = 0.f; for (int k = 0; k < D; ++k) s += ldbf(mg + (size_t)row * D + k) * bfr(a.in[I_WO][(size_t)k * D + n]);
    const float ref = a.in[I_X][(size_t)row * D + n] + ((const float*)(a.ws + WS_MOD))[(size_t)b * 6 * D + 2 * D + n] * s;
    dbg_acc(a.ws, 5, ldbf((const bf16*)(a.ws + WS_XMID) + (size_t)row * D + n) - ref, ref);
}
__global__ void __launch_bounds__(256) chk_router(Args a) {
    __shared__ float sh[8]; __shared__ float lgt[36];
    const int row = samp_row(blockIdx.x), b = row / SEQ, t = threadIdx.x; const float* mod = (const float*)(a.ws + WS_MOD);
    float xv[4], hv[4], ss = 0.f;
#pragma unroll
    for (int q = 0; q < 4; ++q) { xv[q] = ldbf((const bf16*)(a.ws + WS_XMID) + (size_t)row * D + t + 256 * q); ss += xv[q] * xv[q]; }
    const float rinv = 1.0f / sqrtf(block_sum256(ss, sh) / D + EPS);
#pragma unroll
    for (int q = 0; q < 4; ++q) { const int c = t + 256 * q; hv[q] = xv[q] * rinv * a.in[I_N2G][c] * (1.0f + mod[(size_t)b * 6 * D + 4 * D + c]) + mod[(size_t)b * 6 * D + 3 * D + c];
        dbg_acc(a.ws, 6, f8dec(((const unsigned char*)(a.ws + WS_H2))[(size_t)row * D + c]) - f8r(hv[q]), hv[q]); }
    for (int n = 0; n < 36; ++n) { float p = 0.f;
#pragma unroll
        for (int q = 0; q < 4; ++q) { const int c = t + 256 * q; p += hv[q] * (n < 4 ? a.in[I_WRG][c * 4 + n] : a.in[I_WRE][c * 32 + n - 4]); }
        const float tot = block_sum256(p, sh); if (t == 0) lgt[n] = tot + (n < 4 ? a.in[I_BRG][n] : a.in[I_BRE][n - 4]); }
    __syncthreads();
    if (t == 0) { int gi = 0; for (int n = 1; n < 4; ++n) if (lgt[n] > lgt[gi]) gi = n; float gs = 0.f; for (int n = 0; n < 4; ++n) gs += expf(lgt[n] - lgt[gi]); const float pg = 1.0f / gs;
        int i1 = 0; for (int j = 1; j < 8; ++j) if (lgt[4 + 8 * gi + j] > lgt[4 + 8 * gi + i1]) i1 = j; int i2 = -1; for (int j = 0; j < 8; ++j) if (j != i1 && (i2 < 0 || lgt[4 + 8 * gi + j] > lgt[4 + 8 * gi + i2])) i2 = j;
        const float ex = expf(lgt[4 + 8 * gi + i2] - lgt[4 + 8 * gi + i1]), w1 = pg / (1.0f + ex), w2 = pg * ex / (1.0f + ex);
        const float* rec = (const float*)(a.ws + WS_DBG) + (size_t)row * 4;
        const bool same = ((int)rec[0] == gi * 8 + i1) && ((int)rec[1] == gi * 8 + i2);
        dbg_acc(a.ws, 7, same ? 0.f : 1.f, 1.f);
        if (same) { dbg_acc(a.ws, 8, rec[2] - w1, w1); dbg_acc(a.ws, 8, rec[3] - w2, w2); } }
}
__global__ void __launch_bounds__(256) chk_moe(Args a) {
    __shared__ float hs[D]; __shared__ float act[DEXP];
    const int row = samp_row(blockIdx.x >> 1), k = blockIdx.x & 1, t = threadIdx.x;
    const float* rec = (const float*)(a.ws + WS_DBG) + (size_t)row * 4; const int e = (int)rec[k]; const float w = rec[2 + k];
    for (int c = t; c < D; c += 256) hs[c] = f8dec(((const unsigned char*)(a.ws + WS_H2))[(size_t)row * D + c]);
    __syncthreads();
    for (int j = t; j < DEXP; j += 256) { float gsum = 0.f, usum = 0.f; for (int c = 0; c < D; ++c) { gsum += hs[c] * f8r(a.in[I_WG][((size_t)e * D + c) * DEXP + j] * WGU_SCALE); usum += hs[c] * f8r(a.in[I_WU][((size_t)e * D + c) * DEXP + j] * WGU_SCALE); }
        gsum *= 1.0f / WGU_SCALE; usum *= 1.0f / WGU_SCALE;
        act[j] = f8r(gsum / (1.0f + expf(-gsum)) * usum); }
    __syncthreads();
    for (int n = t; n < D; n += 256) { float s = 0.f; for (int j = 0; j < DEXP; ++j) s += act[j] * f8r(a.in[I_WDN][((size_t)e * DEXP + j) * D + n] * WD_SCALE);
        const float ref = w * s * (1.0f / WD_SCALE); dbg_acc(a.ws, 9, ldbf((const bf16*)(a.ws + WS_YT) + ((size_t)row * 2 + k) * D + n) - ref, ref); }
}
__global__ void __launch_bounds__(256) chk_final(Args a) {
    __shared__ float sh[8];
    const int row = samp_row(blockIdx.x), b = row / SEQ, t = threadIdx.x; const float* mod = (const float*)(a.ws + WS_MOD);
    float v[4], ss = 0.f;
#pragma unroll
    for (int q = 0; q < 4; ++q) { const int c = t + 256 * q; v[q] = ldbf((const bf16*)(a.ws + WS_XMID) + (size_t)row * D + c) + mod[(size_t)b * 6 * D + 5 * D + c] * (ldbf((const bf16*)(a.ws + WS_YT) + (size_t)row * 2 * D + c) + ldbf((const bf16*)(a.ws + WS_YT) + (size_t)row * 2 * D + D + c)); ss += v[q] * v[q]; }
    const float rinv = 1.0f / sqrtf(block_sum256(ss, sh) / D + EPS);
#pragma unroll
    for (int q = 0; q < 4; ++q) { const int c = t + 256 * q; const float ref = v[q] * rinv * a.in[I_FG][c]; dbg_acc(a.ws, 10, a.out[(size_t)row * D + c] - ref, ref); }
}
__global__ void __launch_bounds__(256) chk_report(Args a) {
    const float* acc = (const float*)(a.ws + WS_CTL) + CW_DBG; int code = 0;
    for (int k = 10; k >= 0; --k) { if (k < DBG_FIRST) continue; const float tol = (k == 7) ? 0.02f : 1e-3f; if (!(acc[2 * k] <= tol * acc[2 * k + 1])) code = k + 1; }
    const float f = 1.0f + 0.5f * (float)code;
    for (size_t i = (size_t)blockIdx.x * 256 + threadIdx.x; i < (size_t)M * D; i += (size_t)gridDim.x * 256) a.out[i] *= f;
}
#endif

extern "C" void kernel_launch(void* const* d_in, const int* in_sizes, int n_in, void* d_out, int out_size, void* d_ws, size_t ws_size, hipStream_t stream) {
    static int grid = 0;
    if (grid == 0) {
        if (n_in != 25 || in_sizes[0] != M * D || out_size != M * D || ws_size < WS_END) { fprintf(stderr, "kernel_launch: unexpected shapes (n_in %d, in0 %d, out %d, ws %zu); nothing launched\n", n_in, n_in > 0 ? in_sizes[0] : -1, out_size, ws_size); grid = -1; return; }
        int dev = 0, cus = 0, per_cu = 0;
        if (hipGetDevice(&dev) != hipSuccess || hipDeviceGetAttribute(&cus, hipDeviceAttributeMultiprocessorCount, dev) != hipSuccess) { grid = -1; return; }
        if (hipFuncSetAttribute((const void*)mk_fwd, hipFuncAttributeMaxDynamicSharedMemorySize, LDS_BYTES) != hipSuccess) { fprintf(stderr, "kernel_launch: hipFuncSetAttribute failed\n"); grid = -1; return; }
        if (hipOccupancyMaxActiveBlocksPerMultiprocessor(&per_cu, (const void*)mk_fwd, NWAVES * 64, LDS_BYTES) != hipSuccess || per_cu < 1) fprintf(stderr, "kernel_launch: occupancy query reports %d\n", per_cu);
        (void)hipGetLastError();
        grid = cus;
    }
    if (grid < 0) return;
    if (hipMemsetAsync((char*)d_ws + WS_CTL, 0, DEBUG_CHECKS ? (size_t)(1 * MiB) : CTL_ZERO_BYTES, stream) != hipSuccess) return;
    Args a{};
    for (int i = 0; i < 25; ++i) a.in[i] = (const float*)d_in[i];
    a.out = (float*)d_out; a.ws = (unsigned char*)d_ws;
    if (MK_N_LAUNCHES == 1) { a.ph_lo = 0; a.ph_hi = N_PHASES; a.li = 0; hipLaunchKernelGGL(mk_fwd, dim3(grid), dim3(NWAVES * 64), LDS_BYTES, stream, a); }
    else for (int li = 0; li < RUN_PHASES; ++li) { a.ph_lo = li; a.ph_hi = li + 1; a.li = li; hipLaunchKernelGGL(mk_fwd, dim3(grid), dim3(NWAVES * 64), LDS_BYTES, stream, a);
#if DEBUG_CHECKS
        if (li == 2) { hipLaunchKernelGGL(chk_h1, dim3(NSAMP), dim3(256), 0, stream, a); hipLaunchKernelGGL(chk_inproj, dim3(NSAMP * INW / 256), dim3(256), 0, stream, a); }
        if (li == 3) { hipLaunchKernelGGL(chk_attn, dim3(NSAMP * 32 / 256), dim3(256), 0, stream, a); hipLaunchKernelGGL(chk_gmlp, dim3(NSAMP), dim3(512), 0, stream, a); }
        if (li == 4) hipLaunchKernelGGL(chk_merge, dim3(NSAMP * D / 256), dim3(256), 0, stream, a);
        if (li == 5) hipLaunchKernelGGL(chk_wo, dim3(NSAMP * D / 256), dim3(256), 0, stream, a);
        if (li == 6) hipLaunchKernelGGL(chk_router, dim3(NSAMP), dim3(256), 0, stream, a);
        if (li == 8) hipLaunchKernelGGL(chk_moe, dim3(NSAMP * 2), dim3(256), 0, stream, a);
        if (li == 9) { hipLaunchKernelGGL(chk_final, dim3(NSAMP), dim3(256), 0, stream, a); hipLaunchKernelGGL(chk_report, dim3(2048), dim3(256), 0, stream, a); }
#endif
    }
}
```

```cpp
#include <hip/hip_runtime.h>
#include <cstdio>
#include <cstdint>
#include <cmath>
#include <type_traits>

#ifndef MK_N_LAUNCHES
#define MK_N_LAUNCHES 1
#endif

#ifndef DEBUG_CHECKS
#define DEBUG_CHECKS 0
#endif
#ifndef DBG_FIRST
#define DBG_FIRST 0
#endif
#ifndef RUN_PHASES
#define RUN_PHASES 10
#endif
#define GAS __attribute__((address_space(1)))
#define LAS __attribute__((address_space(3)))
typedef unsigned short bf16;
typedef short bf16x8 __attribute__((ext_vector_type(8)));
typedef short s16x4 __attribute__((ext_vector_type(4)));
typedef float f32x2 __attribute__((ext_vector_type(2)));
typedef float f32x4 __attribute__((ext_vector_type(4)));
typedef float f32x16 __attribute__((ext_vector_type(16)));
typedef unsigned u32x2 __attribute__((ext_vector_type(2)));
typedef unsigned u32x4 __attribute__((ext_vector_type(4)));
typedef __bf16 bf16x2_t __attribute__((ext_vector_type(2)));
typedef GAS unsigned gu32;

constexpr int BATCH = 8, SEQ = 4096, D = 1024, M = BATCH * SEQ;
constexpr int NQ = 512, NKV = 256  , GMW = 512, INW = 3840;
constexpr int NEXP = 32, DEXP = 512;
constexpr float EPS = 1e-6f;
constexpr float LOG2E = 1.4426950408889634f;
constexpr float QSCALE = 0.125f * LOG2E;
constexpr int LIST_CAP = 32768;
constexpr int HACT_ROWS = 73728;

constexpr size_t MiB = 1u << 20;
constexpr size_t WS_CTL = 0, CTL_ZERO_BYTES = 32 * 1024;
constexpr size_t WS_MOD = 1 * MiB;
constexpr size_t WS_MODP = 1 * MiB + 256 * 1024;
constexpr size_t WS_WST = 4 * MiB + 512 * 1024;
constexpr size_t WS_LROW = 5 * MiB;
constexpr size_t WS_LW = 9 * MiB;
constexpr size_t WS_GT = 13 * MiB;
constexpr size_t WS_GC = 13 * MiB + 800 * 1024;
constexpr size_t WS_WIN = 14 * MiB;
constexpr size_t WS_WIN8 = 18 * MiB;
constexpr size_t WS_H1F8 = 186 * MiB;
constexpr int NBF = 1792;
constexpr size_t WS_PA = 22 * MiB;
constexpr size_t WS_WO = 24 * MiB;
constexpr size_t WS_WGU = 26 * MiB;
constexpr size_t WS_WD = 90 * MiB;
constexpr size_t WS_A = 122 * MiB;
constexpr size_t WS_YAB = 186 * MiB;
constexpr size_t WS_YT = 122 * MiB;
constexpr size_t WS_Q = 250 * MiB;
constexpr size_t WS_KV = 282 * MiB;
constexpr size_t WS_GU = 298 * MiB, WS_GV = 330 * MiB;
constexpr size_t WS_T = 298 * MiB;
constexpr size_t WS_HACT = 250 * MiB;
constexpr size_t WS_GA = 362 * MiB;
constexpr size_t WS_XMID = 362 * MiB;
constexpr size_t WS_GB = 426 * MiB;
constexpr size_t WS_H2 = 426 * MiB;
constexpr size_t WS_END = 490 * MiB;
static_assert(WS_HACT + (size_t)HACT_ROWS * 1024 <= WS_GA, "HACT overlay");
constexpr int CW_TMO = 0, CW_CODE = 1;
constexpr int CW_CNT = 1024;
constexpr int CW_BAR = 4096;

constexpr int RING_OFF = 0, RING_BYTES = 131072;
constexpr int LDSCTL_OFF = RING_BYTES, MISC_OFF = LDSCTL_OFF + 320;
constexpr int TAB_OFF = RING_BYTES + 512;
constexpr int TAB_UNITS = TAB_OFF, TAB_CNT = TAB_OFF + 256, TAB_ROWS = TAB_OFF + 1024, MAX_WG_UNITS = 14;
constexpr int CSH_OFF = TAB_ROWS + MAX_WG_UNITS * 1024;
constexpr int LDS_BYTES = CSH_OFF + 16384;
static_assert(CSH_OFF % 16 == 0 && LDS_BYTES <= 163840 - 256, "LDS map");
constexpr int NWAVES = 8;
constexpr int N_PHASES = 10;

#define LDS_WAIT() asm volatile("s_waitcnt lgkmcnt(0)" ::: "memory")
#define VM_WAIT() asm volatile("s_waitcnt vmcnt(0)" ::: "memory")
#define RLX_AGENT __ATOMIC_RELAXED, __HIP_MEMORY_SCOPE_AGENT
__device__ __forceinline__ unsigned cvtpk(float lo, float hi) { f32x2 v = {lo, hi}; bf16x2_t b = __builtin_convertvector(v, bf16x2_t); return __builtin_bit_cast(unsigned, b); }
__device__ __forceinline__ float bf_lo(unsigned w) { return __uint_as_float(w << 16); }
__device__ __forceinline__ float bf_hi(unsigned w) { return __uint_as_float(w & 0xffff0000u); }
__device__ __forceinline__ float wave_sum(float v) {
    int x = __float_as_int(v);
#define WS_DPP(ctrl, rmask) x = __float_as_int(__int_as_float(x) + __int_as_float(__builtin_amdgcn_update_dpp(0, x, (ctrl), (rmask), 0xf, false)))
    WS_DPP(0xB1, 0xf);
    WS_DPP(0x4E, 0xf);
    WS_DPP(0x141, 0xf);
    WS_DPP(0x140, 0xf);
    WS_DPP(0x142, 0xa);
    WS_DPP(0x143, 0xc);
#undef WS_DPP
    return __int_as_float(__builtin_amdgcn_readlane(x, 63));
}
__device__ __forceinline__ float clamp448(float v) { return __builtin_amdgcn_fmed3f(v, -448.0f, 448.0f); }
__device__ __forceinline__ unsigned pk4_fp8(float a, float b, float c, float d) {
    unsigned r = 0; r = __builtin_amdgcn_cvt_pk_fp8_f32(clamp448(a), clamp448(b), r, false); r = __builtin_amdgcn_cvt_pk_fp8_f32(clamp448(c), clamp448(d), r, true); return r; }
__device__ __forceinline__ u32x2 pack8_fp8(const f32x4 a, const f32x4 b) { u32x2 w; w.x = pk4_fp8(a[0], a[1], a[2], a[3]); w.y = pk4_fp8(b[0], b[1], b[2], b[3]); return w; }
constexpr float WGU_SCALE = 64.0f, WD_SCALE = 32.0f;
__device__ __forceinline__ unsigned pk4_u8(float a, float b, float c, float d) {
    return (unsigned)(a * 255.0f + 0.5f) | ((unsigned)(b * 255.0f + 0.5f) << 8) | ((unsigned)(c * 255.0f + 0.5f) << 16) | ((unsigned)(d * 255.0f + 0.5f) << 24); }
__device__ __forceinline__ void unpack8_u8(const u32x2 w, f32x4& a, f32x4& b) {
    a = (f32x4){(float)(w.x & 0xffu), (float)((w.x >> 8) & 0xffu), (float)((w.x >> 16) & 0xffu), (float)(w.x >> 24)};
    b = (f32x4){(float)(w.y & 0xffu), (float)((w.y >> 8) & 0xffu), (float)((w.y >> 16) & 0xffu), (float)(w.y >> 24)}; }
__device__ __forceinline__ float sigmoid_f(float x) { return __builtin_amdgcn_rcpf(1.0f + __builtin_amdgcn_exp2f(-x * LOG2E)); }
__device__ __forceinline__ float gelu_tanh_f(float x) {
    const float t = x * __builtin_fmaf(x * x, -2.3022081987f * 0.044715f, -2.3022081987f);
    return x * __builtin_amdgcn_rcpf(1.0f + __builtin_amdgcn_exp2f(t));
}
__device__ __forceinline__ f32x2 exp2_2(const f32x2 v) { return (f32x2){__builtin_amdgcn_exp2f(v.x), __builtin_amdgcn_exp2f(v.y)}; }
__device__ __forceinline__ f32x2 rcp_2(const f32x2 v) { return (f32x2){__builtin_amdgcn_rcpf(v.x), __builtin_amdgcn_rcpf(v.y)}; }
__device__ __forceinline__ f32x2 lo2(const f32x4 v) { return __builtin_shufflevector(v, v, 0, 1); }
__device__ __forceinline__ f32x2 hi2(const f32x4 v) { return __builtin_shufflevector(v, v, 2, 3); }
__device__ __forceinline__ f32x4 cat2(const f32x2 a, const f32x2 b) { return __builtin_shufflevector(a, b, 0, 1, 2, 3); }
__device__ __forceinline__ f32x2 gelu_tanh_2(const f32x2 x) {
    const f32x2 c1 = {-2.3022081987f, -2.3022081987f}, c2 = {-2.3022081987f * 0.044715f, -2.3022081987f * 0.044715f};
    const f32x2 t = x * __builtin_elementwise_fma(x * x, c2, c1);
    return x * rcp_2(exp2_2(t) + 1.0f); }
__device__ __forceinline__ f32x4 gelu_tanh_4(const f32x4 v) { return cat2(gelu_tanh_2(lo2(v)), gelu_tanh_2(hi2(v))); }
template <bool LO1> __device__ __forceinline__ unsigned sigcode_4(const f32x4 t) {
    const f32x2 k = {1.0f / 255.0f, 1.0f / 255.0f};
    f32x2 a = rcp_2(__builtin_elementwise_fma(exp2_2(lo2(t)), k, k)), b = rcp_2(__builtin_elementwise_fma(exp2_2(hi2(t)), k, k));
    if (LO1) { a.x = fmaxf(a.x, 1.0f); a.y = fmaxf(a.y, 1.0f); b.x = fmaxf(b.x, 1.0f); b.y = fmaxf(b.y, 1.0f); }
    unsigned w = 0u; w = __builtin_amdgcn_cvt_pk_u8_f32(a.x, 0, w); w = __builtin_amdgcn_cvt_pk_u8_f32(a.y, 1, w); w = __builtin_amdgcn_cvt_pk_u8_f32(b.x, 2, w); w = __builtin_amdgcn_cvt_pk_u8_f32(b.y, 3, w); return w; }
__device__ __forceinline__ float silu_f(float x) { return x * __builtin_amdgcn_rcpf(1.0f + __builtin_amdgcn_exp2f(-x * LOG2E)); }

namespace pg8 {
constexpr int BM = 256, BK = 64, HALF = 128, HTB = HALF * BK * 2, STAGE_BYTES = 8 * HTB, NXCD = 8, WGM = 8;
__host__ __device__ __forceinline__ int lds_byte(int r, int c) { const int st = (r >> 4) * 2 + (c >> 5), rr = r & 15, cc = c & 31, ob = rr * 64 + cc * 2; return st * 1024 + (ob ^ (((ob >> 9) & 1) << 5)); }
__host__ __device__ __forceinline__ void stage_rc(int b, int& R, int& C) { const int st = b / 1024, sb = b % 1024, swz = sb ^ (((sb >> 9) & 1) << 5); R = (st >> 1) * 16 + swz / 64; C = (st & 1) * 32 + (swz % 64) / 2; }
__host__ __device__ __forceinline__ int perm32(int rho) { const int n = rho >> 4, i = rho & 15; return 8 * (i >> 2) + 4 * n + (i & 3); }

struct Unit { int pm, pn, v, e, ui; };

struct DenseOrder {
    int nM, nN, nwg, G, c;
    __device__ void init(int M_, int N_, int G_, int c_) { nM = M_ / BM; nN = N_ / BM; nwg = nM * nN; G = G_; c = c_; }
    __device__ bool tile(int i, Unit& u) const { return tileL((long)i * G + c, u); }
    __device__ bool tileL(long L, Unit& u) const {
        if (L >= nwg) return false;
        int wgid = (int)L; { const int q = nwg / NXCD, r = nwg % NXCD, xcd = wgid % NXCD, off = wgid / NXCD; wgid = (xcd < r ? xcd * (q + 1) : r * (q + 1) + (xcd - r) * q) + off; }
        const int nig = WGM * nN, gid = wgid / nig, fm = gid * WGM, gsz = (nM - fm) < WGM ? (nM - fm) : WGM;
        u.pm = fm + ((wgid % nig) % gsz); u.pn = (wgid % nig) / gsz; u.v = 0; u.e = 0; u.ui = 0; return true;
    }
    __device__ bool next(int i, Unit& u) const { return tile(i, u); }
};
struct BackfillOrder : DenseOrder {
    __device__ bool next(int i, Unit& u) const {
        if (i < 3) return tileL((long)i * G + c, u);
        if (c >= G / 2) return tileL((long)3 * G + (long)(i - 3) * (G - G / 2) + (c - G / 2), u);
        return false; }
};

template <class Prob, class Epi, class Sched, bool ALIGN_EPI>
__device__ __forceinline__ void gemm_phase(LAS unsigned char* lds, const Prob& P, const Sched& S, const Epi& E) {
    const int tid = threadIdx.x, wid = __builtin_amdgcn_readfirstlane(tid >> 6), lane = tid & 63, wr = wid >> 2, wc = wid & 3, fr = lane & 15, fq = lane >> 4;
    const int nt = P.Kb / 128;
    int Rr[2], Cc[2]; unsigned voffB[2], aoc[2][2], aon[2][2];
#pragma unroll
    for (int i = 0; i < 2; ++i) { int R, C; stage_rc(tid * 16 + i * 8192, R, C); Rr[i] = R; Cc[i] = C; const int Rb = Epi::PERM ? ((R & ~31) + perm32(R & 31)) : R;
        voffB[i] = (unsigned)Rb * P.ldb + (unsigned)C * 2u; }
    const size_t kstep = (size_t)(BK * 2);
    const size_t hstepB = (size_t)HALF * P.ldb;
    const unsigned ldsw = (unsigned)wid * 1024u;
    const int aoff = lds_byte(wr * 64 + fr, fq * 8), boff = lds_byte(wc * 32 + fr, fq * 8);
#define PG8_SA(b, h) (((b) * 2 + (h)) * HTB)
#define PG8_SB(b, h) ((4 + (b) * 2 + (h)) * HTB)
#define PG8_STG(bufoff, p0, p1) do { \
        __builtin_amdgcn_global_load_lds((const unsigned*)(p0), (LAS unsigned*)(lds + (bufoff) + ldsw), 16, 0, 0); \
        __builtin_amdgcn_global_load_lds((const unsigned*)(p1), (LAS unsigned*)(lds + (bufoff) + ldsw + 8192), 16, 0, 0); } while (0)
#define PG8_STGB(bufoff, base) PG8_STG(bufoff, (base) + voffB[0], (base) + voffB[1])
#define PG8_STGA(bufoff, base, off, h) PG8_STG(bufoff, (base) + off[h][0], (base) + off[h][1])
#define PG8_LDF(dst, addr) do { if constexpr (Prob::F8) { const i32x4 lo_ = *(const LAS i32x4*)(addr), hi_ = *(const LAS i32x4*)((addr) + 1024); dst.v = __builtin_shufflevector(lo_, hi_, 0, 1, 2, 3, 4, 5, 6, 7); } \
        else { dst.k[0] = *(const LAS bf16x8*)(addr); dst.k[1] = *(const LAS bf16x8*)((addr) + 1024); } } while (0)
#define PG8_LDA(dst, b, h) do { _Pragma("unroll") for (int m = 0; m < 4; ++m) PG8_LDF(dst[m], lds + PG8_SA(b, h) + aoff + m * 2048); } while (0)
#define PG8_LDB(dst, b, h) do { _Pragma("unroll") for (int n = 0; n < 2; ++n) PG8_LDF(dst[n], lds + PG8_SB(b, h) + boff + n * 2048); } while (0)
#define PG8_MMA(ai, bj, At, Bt) do { __builtin_amdgcn_s_setprio(1); _Pragma("unroll") for (int m = 0; m < 4; ++m) _Pragma("unroll") for (int n = 0; n < 2; ++n) { \
        if constexpr (Prob::F8) asm volatile("v_mfma_scale_f32_16x16x128_f8f6f4 %0, %1, %2, %0, %3, %3 op_sel_hi:[0,0,0]" : "+v"(acc[ai][bj][m][n]) : "v"(Bt[n].v), "v"(At[m].v), "v"(f8scale));   \
        else { _Pragma("unroll") for (int k = 0; k < 2; ++k) acc[ai][bj][m][n] = __builtin_amdgcn_mfma_f32_16x16x32_bf16(Bt[n].k[k], At[m].k[k], acc[ai][bj][m][n], 0, 0, 0); } } \
        __builtin_amdgcn_s_setprio(0); } while (0)
#define PG8_WAIT_V(n) asm volatile("s_waitcnt vmcnt(" #n ")" ::: "memory")
#define PG8_WAIT_L(n) asm volatile("s_waitcnt lgkmcnt(" #n ")" ::: "memory")
#define PG8_BAR __builtin_amdgcn_s_barrier()
#define PG8_SCHED __builtin_amdgcn_sched_barrier(0)
#define PG8_AOFF(dst, ui_) do { _Pragma("unroll") for (int h = 0; h < 2; ++h) _Pragma("unroll") for (int i = 0; i < 2; ++i) { \
        if constexpr (Prob::GATHER) dst[h][i] = P.rowtab[(ui_) * 256 + h * HALF + Rr[i]] + (unsigned)Cc[i] * 2u; \
        else dst[h][i] = (unsigned)(h * HALF + Rr[i]) * P.lda + (unsigned)Cc[i] * 2u; } } while (0)
    Unit cur, nxt; int ui = 0;
    if (!S.next(0, cur)) return;
    f32x4 acc[2][2][4][2];
#pragma unroll
    for (int a = 0; a < 2; ++a)
#pragma unroll
        for (int b = 0; b < 2; ++b)
#pragma unroll
            for (int m = 0; m < 4; ++m)
#pragma unroll
                for (int n = 0; n < 2; ++n) acc[a][b][m][n] = (f32x4){0.f, 0.f, 0.f, 0.f};
    typedef int i32x8 __attribute__((ext_vector_type(8))); typedef int i32x4 __attribute__((ext_vector_type(4)));
    struct FragBf { bf16x8 k[2]; }; struct FragF8 { i32x8 v; };
    typedef typename std::conditional<Prob::F8, FragF8, FragBf>::type Frag;
    Frag At[4], B0[2], B1[2];
    int f8scale = Prob::F8 ? Prob::E8M0 : 0x7f7f7f7f; asm volatile("" : "+v"(f8scale));
    const char* cA = P.a_ptr(cur); const char* cB = P.b_ptr(cur);
    PG8_AOFF(aoc, 0);
#pragma unroll
    for (int h = 0; h < 2; ++h)
#pragma unroll
        for (int i = 0; i < 2; ++i) aon[h][i] = aoc[h][i];
    PG8_STGB(PG8_SB(0, 0), cB); PG8_STGB(PG8_SB(0, 1), cB + hstepB); PG8_STGA(PG8_SA(0, 0), cA, aoc, 0); PG8_STGA(PG8_SA(0, 1), cA, aoc, 1);
    if (wr == 1) PG8_BAR;
    PG8_WAIT_V(2); PG8_BAR;
    PG8_STGB(PG8_SB(1, 0), cB + kstep); PG8_STGA(PG8_SA(1, 0), cA + kstep, aoc, 0); PG8_STGB(PG8_SB(1, 1), cB + hstepB + kstep);
    PG8_WAIT_V(6); PG8_BAR;
    for (;;) {
        const bool has_next = S.next(ui + 1, nxt);
        const char* nA = has_next ? P.a_ptr(nxt) : cA; const char* nB = has_next ? P.b_ptr(nxt) : cB;
        for (int t = 0; t < nt; t += 2) {
            const bool last = (t == nt - 2);
            const char* a1 = cA + (size_t)(t + 1) * kstep;
            const char* a2 = last ? nA : cA + (size_t)(t + 2) * kstep; const char* b2 = last ? nB : cB + (size_t)(t + 2) * kstep;
            const char* a3 = a2 + kstep; const char* b3 = b2 + kstep;
            unsigned ao2[2][2];
            if constexpr (Prob::GATHER) {
                if (last && has_next) PG8_AOFF(aon, ui + 1);
#pragma unroll
                for (int h = 0; h < 2; ++h)
#pragma unroll
                    for (int i = 0; i < 2; ++i) ao2[h][i] = (last && has_next) ? aon[h][i] : aoc[h][i];
            } else {
#pragma unroll
                for (int h = 0; h < 2; ++h)
#pragma unroll
                    for (int i = 0; i < 2; ++i) ao2[h][i] = aoc[h][i];
            }
            if constexpr (Epi::MIDK) { if (t == nt / 2) E.mid(acc, cur, wr, wc, fr, fq); }
            PG8_LDB(B0, 0, 0); PG8_LDB(B1, 0, 1); PG8_SCHED; PG8_LDA(At, 0, 0); PG8_STGA(PG8_SA(1, 1), a1, aoc, 1);
            PG8_WAIT_V(8); PG8_WAIT_L(0); PG8_BAR; PG8_MMA(0, 0, At, B0); PG8_MMA(0, 1, At, B1); PG8_BAR; PG8_SCHED;
            PG8_LDA(At, 0, 1); PG8_STGB(PG8_SB(0, 0), b2); PG8_STGB(PG8_SB(0, 1), b2 + hstepB); PG8_STGA(PG8_SA(0, 0), a2, ao2, 0);
            PG8_WAIT_V(8); PG8_WAIT_L(0); PG8_BAR; PG8_MMA(1, 0, At, B0); PG8_MMA(1, 1, At, B1); PG8_BAR; PG8_SCHED;
            PG8_LDB(B0, 1, 0); PG8_LDB(B1, 1, 1); PG8_SCHED; PG8_LDA(At, 1, 0); PG8_STGA(PG8_SA(0, 1), a2, ao2, 1);
            PG8_WAIT_V(8); PG8_WAIT_L(0); PG8_BAR; PG8_MMA(0, 0, At, B0); PG8_MMA(0, 1, At, B1); PG8_BAR; PG8_SCHED;
            PG8_LDA(At, 1, 1); PG8_STGB(PG8_SB(1, 0), b3); PG8_STGB(PG8_SB(1, 1), b3 + hstepB); PG8_STGA(PG8_SA(1, 0), a3, ao2, 0);
            PG8_WAIT_V(8); PG8_WAIT_L(0); PG8_BAR; PG8_MMA(1, 0, At, B0); PG8_MMA(1, 1, At, B1); PG8_BAR; PG8_SCHED;
        }
        if constexpr (ALIGN_EPI) { if (wr == 0) PG8_BAR; }
        if constexpr (Prob::F8) asm volatile("s_nop 15\n\ts_nop 15\n\ts_nop 15" ::: "memory");
        E(acc, cur, wr, wc, fr, fq);
        if (!has_next) break;
#pragma unroll
        for (int a = 0; a < 2; ++a)
#pragma unroll
            for (int b = 0; b < 2; ++b)
#pragma unroll
                for (int m = 0; m < 4; ++m)
#pragma unroll
                    for (int n = 0; n < 2; ++n) acc[a][b][m][n] = (f32x4){0.f, 0.f, 0.f, 0.f};
        cur = nxt; cA = nA; cB = nB; ++ui;
        if constexpr (Prob::GATHER) {
#pragma unroll
            for (int h = 0; h < 2; ++h)
#pragma unroll
                for (int i = 0; i < 2; ++i) aoc[h][i] = aon[h][i];
        }
        if constexpr (ALIGN_EPI) { if (wr == 1) PG8_BAR; }
    }
    PG8_WAIT_V(0);
    if constexpr (!ALIGN_EPI) { if (wr == 0) PG8_BAR; }
    PG8_BAR;
#undef PG8_SA
#undef PG8_SB
#undef PG8_STG
#undef PG8_STGA
#undef PG8_STGB
#undef PG8_LDA
#undef PG8_LDF
#undef PG8_LDB
#undef PG8_MMA
#undef PG8_WAIT_V
#undef PG8_WAIT_L
#undef PG8_BAR
#undef PG8_SCHED
#undef PG8_AOFF
}
}

#define XB_TMO      128
#define XB_XCNT(j)  (256  + 64 * (j))
#define XB_XSUB(j)  (1280 + 64 * (j))
#define XB_XGEN(j)  (2304 + 64 * (j))
#define XB_TOP      3328
#define XB_TOPGEN   3392
#define XCD_BAR_WORDS 3456
#define XB_SPIN_CAP (1u << 18)
__device__ __forceinline__ unsigned xb_ld(unsigned* p)              { return __hip_atomic_load(p, __ATOMIC_RELAXED, __HIP_MEMORY_SCOPE_AGENT); }
__device__ __forceinline__ unsigned xb_add(unsigned* p, unsigned v) { return __hip_atomic_fetch_add(p, v, __ATOMIC_RELAXED, __HIP_MEMORY_SCOPE_AGENT); }
__device__ __forceinline__ unsigned xb_xcc_id() { return (unsigned)__builtin_amdgcn_s_getreg((3 << 11) | 20) & 0xFu; }
#define XB_SPIN(cond, bar) do { unsigned _sp = 0; while (cond) { __builtin_amdgcn_s_sleep(1); \
    if ((++_sp & 255u) == 0u) { if (xb_ld(&(bar)[XB_TMO])) break; if (_sp > XB_SPIN_CAP) { atomicAdd(&(bar)[XB_TMO], 1u); break; } } } } while (0)
struct XcdBarrier { unsigned* bar; unsigned x; volatile LAS unsigned* st; };
__device__ __forceinline__ XcdBarrier xcd_barrier_post(unsigned* bar, volatile LAS unsigned* st) {
    XcdBarrier b; b.bar = bar; b.x = xb_xcc_id(); b.st = st;
    if (threadIdx.x == 0) (void)xb_add(&bar[XB_XCNT(b.x)], 1u);
    return b;
}
__device__ __forceinline__ void xcd_barrier_complete(unsigned* bar, unsigned x, unsigned& nloc, unsigned& nx) {
    const unsigned G = gridDim.x * gridDim.y * gridDim.z;
    unsigned sum, cnt, mine, sp = 0u;
    for (;;) {
        sum = 0u; cnt = 0u; mine = 0u;
#pragma unroll
        for (unsigned j = 0; j < 16; ++j) { const unsigned c = xb_ld(&bar[XB_XCNT(j)]); sum += c; cnt += (c > 0u) ? 1u : 0u; mine = (j == x) ? c : mine; }
        if (sum == G) break;
        __builtin_amdgcn_s_sleep(1);
        if ((++sp & 255u) == 0u) { if (xb_ld(&bar[XB_TMO])) break; if (sp > XB_SPIN_CAP) { atomicAdd(&bar[XB_TMO], 1u); break; } }
    }
    nloc = mine > 0u ? mine : 1u; nx = cnt > 0u ? cnt : 1u;
}
__device__ __forceinline__ void xcd_barrier(const XcdBarrier& b) {
    asm volatile("s_waitcnt vmcnt(0)" ::: "memory");
    __syncthreads();
    if (threadIdx.x == 0) {
        unsigned* bar = b.bar;
        __builtin_amdgcn_s_waitcnt(0);
        unsigned nloc = b.st[0], nx = b.st[1];
        if (nloc == 0u) { xcd_barrier_complete(bar, b.x, nloc, nx); b.st[0] = nloc; b.st[1] = nx; }
        const unsigned old = xb_add(&bar[XB_XSUB(b.x)], 1u);
        const unsigned gen = old / nloc;
        if (old + 1u == (gen + 1u) * nloc) {
            __builtin_amdgcn_fence(__ATOMIC_RELEASE, "agent");
            asm volatile("s_waitcnt vmcnt(0)" ::: "memory");
            const unsigned og = xb_add(&bar[XB_TOP], 1u);
            const unsigned tg = og / nx;
            if (og + 1u == (tg + 1u) * nx) xb_add(&bar[XB_TOPGEN], 1u);
            else XB_SPIN(xb_ld(&bar[XB_TOPGEN]) == tg, bar);
            __builtin_amdgcn_fence(__ATOMIC_ACQUIRE, "agent");
            xb_add(&bar[XB_XGEN(b.x)], 1u);
            asm volatile("s_waitcnt vmcnt(0)" ::: "memory");
        } else {
            XB_SPIN(xb_ld(&bar[XB_XGEN(b.x)]) == gen, bar);
            __builtin_amdgcn_fence(__ATOMIC_ACQUIRE, "agent");
            asm volatile("s_waitcnt vmcnt(0)" ::: "memory");
        }
    }
    __syncthreads();
}

struct Args {
    const float* in[25]; float* out; unsigned char* ws; int ph_lo, ph_hi, li, pad;
};
struct Frame {
    LAS unsigned char* lds;
    volatile LAS unsigned* MISC;
    gu32* ctl;
    unsigned char* ws;
    int tid, lane, wave, vcu, G;
};
enum { I_X = 0, I_C, I_POS, I_RELB, I_WADA, I_BADA, I_N1G, I_WIN, I_SINKS, I_LNG, I_LNB, I_GWS, I_GBS, I_PA, I_PB, I_WO, I_N2G, I_WRG, I_BRG, I_WRE, I_BRE, I_WG, I_WU, I_WDN, I_FG };

__device__ __forceinline__ void p0_transpose_tile(const float* W, int N, int k0, int n0, bf16* WT, int ldt, int drow0, LAS float* scr, int lane, float scale = 1.0f) {
    {
        f32x4 t[8];
#pragma unroll
        for (int i = 0; i < 8; ++i) t[i] = __builtin_nontemporal_load((const GAS f32x4*)(W + (size_t)(k0 + 8 * i + (lane >> 3)) * N + n0 + 4 * (lane & 7))) * scale;
#pragma unroll
        for (int i = 0; i < 8; ++i) { LAS float* d = scr + (8 * i + (lane >> 3)) * 33 + 4 * (lane & 7); d[0] = t[i][0]; d[1] = t[i][1]; d[2] = t[i][2]; d[3] = t[i][3]; }
    }
    LDS_WAIT(); asm volatile("" ::: "memory");
    const int c = lane & 7;
#pragma unroll
    for (int j = 0; j < 4; ++j) { const int n = (lane >> 3) + 8 * j; const LAS float* s = scr + (8 * c) * 33 + n;
        u32x4 o; o.x = cvtpk(s[0 * 33], s[1 * 33]); o.y = cvtpk(s[2 * 33], s[3 * 33]); o.z = cvtpk(s[4 * 33], s[5 * 33]); o.w = cvtpk(s[6 * 33], s[7 * 33]);
        *(GAS u32x4*)(WT + (size_t)(drow0 + n) * ldt + k0 + 8 * c) = o; }
    LDS_WAIT(); asm volatile("" ::: "memory");
}
__device__ __forceinline__ void p0_transpose_tile_f8(const float* W, int N, int k0, int n0, unsigned char* WT, int ldt, int drow0, float scale, LAS float* scr, int lane) {
    {
        f32x4 t[16];
#pragma unroll
        for (int i = 0; i < 16; ++i) t[i] = __builtin_nontemporal_load((const GAS f32x4*)(W + (size_t)(k0 + 8 * i + (lane >> 3)) * N + n0 + 4 * (lane & 7)));
#pragma unroll
        for (int i = 0; i < 16; ++i) { const int k = 8 * i + (lane >> 3); *(LAS f32x4*)(scr + k * 32 + ((4 * (lane & 7)) ^ (4 * (k >> 4)))) = t[i]; }
    }
    LDS_WAIT(); asm volatile("" ::: "memory");
    const int c = lane & 7;
#pragma unroll
    for (int j = 0; j < 4; ++j) { const int n = (lane >> 3) + 8 * j; const LAS float* sp = scr + (16 * c) * 32 + (n ^ (4 * c));
        u32x4 o;
        o.x = pk4_fp8(sp[0 * 32] * scale, sp[1 * 32] * scale, sp[2 * 32] * scale, sp[3 * 32] * scale); o.y = pk4_fp8(sp[4 * 32] * scale, sp[5 * 32] * scale, sp[6 * 32] * scale, sp[7 * 32] * scale);
        o.z = pk4_fp8(sp[8 * 32] * scale, sp[9 * 32] * scale, sp[10 * 32] * scale, sp[11 * 32] * scale); o.w = pk4_fp8(sp[12 * 32] * scale, sp[13 * 32] * scale, sp[14 * 32] * scale, sp[15 * 32] * scale);
        *(GAS u32x4*)(WT + (size_t)(drow0 + n) * ldt + k0 + 16 * c) = o; }
    LDS_WAIT(); asm volatile("" ::: "memory");
}
__device__ __forceinline__ void p0_prologue(Frame& F, const Args& A) {
    const int gw = F.vcu * NWAVES + F.wave, NGW = F.G * NWAVES, lane = F.lane;
    {
        const float* c = A.in[I_C]; const float* w = A.in[I_WADA]; float* modp = (float*)(F.ws + WS_MODP);
        for (int it = gw; it < 96 * 16; it += NGW) {
            const int cg = it % 96, ks = it / 96, k0 = ks * 64, col = cg * 64 + lane;
            float csv[8], acc[8];
#pragma unroll
            for (int b = 0; b < 8; ++b) { const float v = c[b * D + k0 + lane]; csv[b] = silu_f(v); acc[b] = 0.f; }
            float wv[64];
#pragma unroll
            for (int kk = 0; kk < 64; ++kk) wv[kk] = __builtin_nontemporal_load((const GAS float*)(w + (size_t)(k0 + kk) * (6 * D) + col));
#pragma unroll
            for (int kk = 0; kk < 64; ++kk) {
#pragma unroll
                for (int b = 0; b < 8; ++b) acc[b] += __int_as_float(__builtin_amdgcn_readlane(__float_as_int(csv[b]), kk)) * wv[kk];
            }
#pragma unroll
            for (int b = 0; b < 8; ++b) modp[((size_t)ks * 8 + b) * (6 * D) + col] = acc[b];
        }
    }
    {
        LAS float* scr = (LAS float*)(F.lds + RING_OFF + F.wave * 16384);
        constexpr int S0 = 16 * 56  , S0F = 8 * 64  , S1 = 8 * 32, S2 = 8 * 32, S3 = 16 * 32, S4 = 32 * 128, S5 = 32 * 128, S6 = 32 * 128;
        constexpr int NITEMS = S0 + S0F + S1 + S2 + S3 + S4 + S5 + S6;
        for (int it = gw; it < NITEMS; it += NGW) {
            int r = it;
            if (r < S0) { const int kb = r / 56, nb = r % 56; p0_transpose_tile(A.in[I_WIN], INW, 64 * kb, 32 * nb, (bf16*)(F.ws + WS_WIN), D, 32 * nb, scr, lane); continue; } r -= S0;
            if (r < S0F) { const int kb = r / 64, nb = r % 64; p0_transpose_tile_f8(A.in[I_WIN], INW, 128 * kb, NBF + 32 * nb, (unsigned char*)(F.ws + WS_WIN8), D, 32 * nb, -WGU_SCALE * LOG2E, scr, lane); continue; } r -= S0F;
            if (r < S1) { const int kb = r / 32, nb = r % 32; p0_transpose_tile(A.in[I_PA], D, 64 * kb, 32 * nb, (bf16*)(F.ws + WS_PA), D, 32 * nb, scr, lane, 1.0f / 255.0f); continue; } r -= S1;
            if (r < S2) { const int kb = r / 32, nb = r % 32; p0_transpose_tile(A.in[I_PB], D, 64 * kb, 32 * nb, (bf16*)(F.ws + WS_PA) + NQ, D, 32 * nb, scr, lane, 1.0f / 255.0f); continue; } r -= S2;
            if (r < S3) { const int kb = r / 32, nb = r % 32; p0_transpose_tile(A.in[I_WO], D, 64 * kb, 32 * nb, (bf16*)(F.ws + WS_WO), D, 32 * nb, scr, lane); continue; } r -= S3;
            if (r < S4 + S5) { const int up = r >= S4 ? 1 : 0; if (up) r -= S4; const int e = r >> 7, q = r & 127, kb = q / 16, nb = q % 16, n0 = 32 * nb;
                p0_transpose_tile_f8(A.in[up ? I_WU : I_WG] + (size_t)e * D * DEXP, DEXP, 128 * kb, n0, (unsigned char*)(F.ws + WS_WGU) + (size_t)e * 1024 * 1024, D, (n0 >> 7) * 256 + up * 128 + (n0 & 127), up ? -WGU_SCALE / LOG2E : -WGU_SCALE * LOG2E, scr, lane); continue; }
            r -= S4 + S5;
            { const int e = r >> 7, q = r & 127, kb = q / 32, nb = q % 32; p0_transpose_tile_f8(A.in[I_WDN] + (size_t)e * DEXP * D, D, 128 * kb, 32 * nb, (unsigned char*)(F.ws + WS_WD) + (size_t)e * 1024 * DEXP, DEXP, 32 * nb, WD_SCALE, scr, lane); }
        }
        const float* gws = A.in[I_GWS]; bf16* wst = (bf16*)(F.ws + WS_WST);
        for (int i = F.vcu * 512 + F.tid; i < 4 * 128 * 128 / 2; i += F.G * 512) { const int e0 = 2 * i, t = (e0 >> 7) & 127, s = e0 & 127;
            const float a = s <= t ? gws[e0] : 0.f, b = (s + 1) <= t ? gws[e0 + 1] : 0.f; ((unsigned*)wst)[i] = cvtpk(a, b); }
    }
}

__device__ __forceinline__ float mod_sum(const float* modp, const float* bada, int b, int j) {
    float s = bada[j];
#pragma unroll
    for (int ks = 0; ks < 16; ++ks) s += modp[((size_t)ks * 8 + b) * (6 * D) + j];
    return s;
}
__device__ __forceinline__ void p1_h1(Frame& F, const Args& A) {
    const float* modp = (const float*)(F.ws + WS_MODP); const float* bada = A.in[I_BADA]; float* mod = (float*)(F.ws + WS_MOD);
    for (int idx = F.vcu * 512 + F.tid; idx < 8 * 6 * D; idx += F.G * 512) { const int b = idx / (6 * D), j = idx % (6 * D); mod[idx] = mod_sum(modp, bada, b, j); }
    LAS float* Av = (LAS float*)(F.lds + RING_OFF); LAS float* Bv = Av + D;
    const float* x = A.in[I_X]; const float* g = A.in[I_N1G]; bf16* h1 = (bf16*)(F.ws + WS_A);
    for (int rb = F.vcu; rb < M / 128; rb += F.G) {
        const int b = rb / (SEQ / 128);
        __syncthreads();
        for (int c = F.tid; c < D; c += 512) { const float sh = mod_sum(modp, bada, b, c), sc = mod_sum(modp, bada, b, D + c); Av[c] = g[c] * (1.0f + sc); Bv[c] = sh; }
        __syncthreads();
        for (int j = 0; j < 16; ++j) {
            const int row = rb * 128 + F.wave * 16 + j; const float* xr = x + (size_t)row * D;
            f32x4 v[2][2]; float ss = 0.f;
#pragma unroll
            for (int jj = 0; jj < 2; ++jj)
#pragma unroll
                for (int q = 0; q < 2; ++q) { v[jj][q] = __builtin_nontemporal_load((const GAS f32x4*)(xr + 512 * jj + 8 * F.lane + 4 * q)); ss += (v[jj][q].x * v[jj][q].x + v[jj][q].y * v[jj][q].y) + (v[jj][q].z * v[jj][q].z + v[jj][q].w * v[jj][q].w); }
            const float rinv = 1.0f / sqrtf(wave_sum(ss) * (1.0f / D) + EPS);
#pragma unroll
            for (int jj = 0; jj < 2; ++jj) { const int c0 = 512 * jj + 8 * F.lane;
                const f32x4 a0 = *(const LAS f32x4*)(Av + c0), a1 = *(const LAS f32x4*)(Av + c0 + 4), b0 = *(const LAS f32x4*)(Bv + c0), b1 = *(const LAS f32x4*)(Bv + c0 + 4);
                const f32x4 o0 = v[jj][0] * rinv * a0 + b0, o1 = v[jj][1] * rinv * a1 + b1;
                u32x4 w; w.x = cvtpk(o0.x, o0.y); w.y = cvtpk(o0.z, o0.w); w.z = cvtpk(o1.x, o1.y); w.w = cvtpk(o1.z, o1.w);
                *(GAS u32x4*)(h1 + (size_t)row * D + c0) = w;
                *(GAS u32x2*)((unsigned char*)(F.ws + WS_H1F8) + (size_t)row * D + c0) = pack8_fp8(o0, o1); }
        }
    }
}

struct ProbDense { int Kb; unsigned lda, ldb; const char* A; const char* B; static constexpr bool GATHER = false, F8 = false; static constexpr int E8M0 = 0x7f7f7f7f; const LAS unsigned* rowtab;
    __device__ __forceinline__ const char* a_ptr(const pg8::Unit& u) const { return A + (size_t)u.pm * 256 * lda; }
    __device__ __forceinline__ const char* b_ptr(const pg8::Unit& u) const { return B + (size_t)u.pn * 256 * ldb; } };
struct ProbDense8 { int Kb; unsigned lda, ldb; const char* A; const char* B; static constexpr bool GATHER = false, F8 = true; static constexpr int E8M0 = 0x7c7c7c7c; const LAS unsigned* rowtab;
    __device__ __forceinline__ const char* a_ptr(const pg8::Unit& u) const { return A + (size_t)u.pm * 256 * lda; }
    __device__ __forceinline__ const char* b_ptr(const pg8::Unit& u) const { return B + (size_t)u.pn * 256 * ldb; } };
struct ProbGateUp { int Kb; unsigned lda, ldb; const char* A; const char* B; static constexpr bool GATHER = true, F8 = true; static constexpr int E8M0 = 0x7c7c7c7c; const LAS unsigned* rowtab;
    __device__ __forceinline__ const char* a_ptr(const pg8::Unit&) const { return A; }
    __device__ __forceinline__ const char* b_ptr(const pg8::Unit& u) const { return B + ((size_t)(u.e & 63) * 1024 + (size_t)u.pn * 256) * ldb; } };
struct ProbDown { int Kb; unsigned lda, ldb; const char* A; const char* B; static constexpr bool GATHER = false, F8 = true; static constexpr int E8M0 = 0x7f7f7f7f; const LAS unsigned* rowtab;
    __device__ __forceinline__ const char* a_ptr(const pg8::Unit& u) const { return A + (size_t)u.pm * 256 * lda; }
    __device__ __forceinline__ const char* b_ptr(const pg8::Unit& u) const { return B + ((size_t)(u.e & 63) * 1024 + (size_t)u.pn * 256) * ldb; } };

struct CSh {
    LAS unsigned char* slab; unsigned woff, roff; int rrow, rpc;
    __device__ __forceinline__ CSh(int wr, int wc, int fr, int fq) {
        extern __shared__ __attribute__((aligned(16))) unsigned char lds_dyn[];
        int lane = fq * 16 + fr; asm volatile("" : "+v"(lane));
        fr = lane & 15; fq = lane >> 4; rrow = lane >> 2; rpc = lane & 3;
        slab = (LAS unsigned char*)lds_dyn + CSH_OFF + (wr * 4 + wc) * 2048;
        woff = (unsigned)(fr * 64 + ((fq ^ ((fr >> 1) & 3)) << 4)); roff = (unsigned)(rrow * 64 + ((rpc ^ ((rrow >> 1) & 3)) << 4)); }
    __device__ __forceinline__ u32x4 xch(int k, const u32x4 w) const { LAS unsigned char* s_ = slab + (k & 1) * 1024; *(LAS u32x4*)(s_ + woff) = w; return *(const LAS u32x4*)(s_ + roff); }
};
__device__ __forceinline__ u32x4 pack8(const f32x4 a, const f32x4 b) { u32x4 w; w.x = cvtpk(a[0], a[1]); w.y = cvtpk(a[2], a[3]); w.z = cvtpk(b[0], b[1]); w.w = cvtpk(b[2], b[3]); return w; }
__device__ __forceinline__ void unpack8(const u32x4 w, f32x4& a, f32x4& b) { a = (f32x4){bf_lo(w.x), bf_hi(w.x), bf_lo(w.y), bf_hi(w.y)}; b = (f32x4){bf_lo(w.z), bf_hi(w.z), bf_lo(w.w), bf_hi(w.w)}; }

template <bool F8>
struct EpiInProjT {
    static constexpr bool PERM = true, MIDK = false;
    unsigned char* ws; int pn0; float scl;
    template <bool LO1> __device__ __forceinline__ void gates(const f32x4 (&acc)[2][2][4][2], unsigned char* base, int row0, int col0) const {
#pragma unroll
        for (int ai = 0; ai < 2; ++ai)
#pragma unroll
            for (int m = 0; m < 4; ++m)
#pragma unroll
                for (int bj = 0; bj < 2; ++bj) { u32x2 w; w.x = sigcode_4<LO1>(acc[ai][bj][m][0]); w.y = sigcode_4<LO1>(acc[ai][bj][m][1]);
                    *(GAS u32x2*)(base + (size_t)(row0 + ai * 128 + m * 16) * D + col0 + bj * 128) = w; }
    }
    __device__ __forceinline__ void operator()(const f32x4 (&acc)[2][2][4][2], const pg8::Unit& u, int wr, int wc, int fr, int fq) const {
        const int pn = u.pn + pn0;
        if constexpr (F8) {
            const int row0 = u.pm * 256 + wr * 64 + fr, col0 = wc * 32 + 8 * fq;
            if (pn < 11) gates<false>(acc, ws + WS_GA, row0, 256 * (pn - 7) + col0); else gates<true>(acc, ws + WS_GB, row0, 256 * (pn - 11) + col0);
        } else {
            bf16* base; int ldc, colt, act;
            if (pn < 2) { base = (bf16*)(ws + WS_Q); ldc = NQ; colt = 256 * pn; act = 0; }
            else if (pn == 2) { base = (bf16*)(ws + WS_KV); ldc = NKV; colt = 0; act = 1; }
            else if (pn < 5) { base = (bf16*)(ws + WS_GU); ldc = GMW; colt = 256 * (pn - 3); act = 2; }
            else { base = (bf16*)(ws + WS_GV); ldc = GMW; colt = 256 * (pn - 5); act = 2; }
            const CSh cs(wr, wc, fr, fq); int kk = 0;
#pragma unroll
            for (int ai = 0; ai < 2; ++ai)
#pragma unroll
                for (int m = 0; m < 4; ++m) { bf16* rowp = base + (size_t)(u.pm * 256 + wr * 64 + cs.rrow + ai * 128 + m * 16) * ldc + colt + wc * 32 + 8 * cs.rpc;
#pragma unroll
                    for (int bj = 0; bj < 2; ++bj) { f32x4 v0 = acc[ai][bj][m][0], v1 = acc[ai][bj][m][1];
                        if (act == 0) { v0 = v0 * QSCALE; v1 = v1 * QSCALE; }
                        else if (act == 2) { v0 = gelu_tanh_4(v0); v1 = gelu_tanh_4(v1); }
                        *(GAS u32x4*)(rowp + bj * 128) = cs.xch(kk++, pack8(v0, v1)); } }
        }
    }
};
struct EpiMerge {
    static constexpr bool PERM = true, MIDK = true;
    const unsigned char* GA; const unsigned char* GB; bf16* MG;
    __device__ __forceinline__ void mid(f32x4 (&acc)[2][2][4][2], const pg8::Unit& u, int wr, int wc, int fr_, int fq) const {
        int fr = fr_; asm volatile("" : "+v"(fr));
        const int row0 = u.pm * 256 + wr * 64 + fr, col0 = u.pn * 256 + wc * 32 + 8 * fq;
#pragma unroll
        for (int ai = 0; ai < 2; ++ai) {
            u32x2 ga[4][2], gb[4][2];
#pragma unroll
            for (int m = 0; m < 4; ++m)
#pragma unroll
                for (int bj = 0; bj < 2; ++bj) { const size_t off = (size_t)(row0 + ai * 128 + m * 16) * D + col0 + bj * 128; ga[m][bj] = *(const GAS u32x2*)(GA + off); gb[m][bj] = *(const GAS u32x2*)(GB + off); }
#pragma unroll
            for (int m = 0; m < 4; ++m)
#pragma unroll
                for (int bj = 0; bj < 2; ++bj) { f32x4 a0, a1, b0, b1; unpack8_u8(ga[m][bj], a0, a1); unpack8_u8(gb[m][bj], b0, b1);
#pragma unroll
                    for (int q = 0; q < 4; ++q) { acc[ai][bj][m][0][q] *= a0[q] * __builtin_amdgcn_rcpf(b0[q]); acc[ai][bj][m][1][q] *= a1[q] * __builtin_amdgcn_rcpf(b1[q]); } }
            asm volatile("" ::: "memory");
        }
    }
    __device__ __forceinline__ void operator()(const f32x4 (&acc)[2][2][4][2], const pg8::Unit& u, int wr, int wc, int fr, int fq) const {
        const int row0 = u.pm * 256 + wr * 64 + fr, col0 = u.pn * 256 + wc * 32 + 8 * fq;
        u32x2 gb[2][4][2];
#pragma unroll
        for (int ai = 0; ai < 2; ++ai)
#pragma unroll
            for (int m = 0; m < 4; ++m)
#pragma unroll
                for (int bj = 0; bj < 2; ++bj) gb[ai][m][bj] = *(const GAS u32x2*)(GB + (size_t)(row0 + ai * 128 + m * 16) * D + col0 + bj * 128);
        const CSh cs(wr, wc, fr, fq); int kk = 0;
#pragma unroll
        for (int ai = 0; ai < 2; ++ai)
#pragma unroll
            for (int m = 0; m < 4; ++m) { const size_t off = (size_t)(u.pm * 256 + wr * 64 + cs.rrow + ai * 128 + m * 16) * D + u.pn * 256 + wc * 32 + 8 * cs.rpc;
#pragma unroll
                for (int bj = 0; bj < 2; ++bj) { f32x4 b0, b1; unpack8_u8(gb[ai][m][bj], b0, b1);
                    *(GAS u32x4*)(MG + off + bj * 128) = cs.xch(kk++, pack8(acc[ai][bj][m][0] * b0, acc[ai][bj][m][1] * b1)); } }
    }
};
struct EpiWo {
    static constexpr bool PERM = true, MIDK = false;
    const float* x; const float* mod; bf16* XM;
    __device__ __forceinline__ void operator()(const f32x4 (&acc)[2][2][4][2], const pg8::Unit& u, int wr, int wc, int fr, int fq) const {
        const int row0 = u.pm * 256 + wr * 64 + fr, col0 = u.pn * 256 + wc * 32 + 8 * fq, b = u.pm >> 4;
        const CSh cs(wr, wc, fr, fq); int kk = 0;
        f32x4 g[2][2];
#pragma unroll
        for (int bj = 0; bj < 2; ++bj)
#pragma unroll
            for (int n = 0; n < 2; ++n) g[bj][n] = *(const GAS f32x4*)(mod + (size_t)b * 6 * D + 2 * D + col0 + bj * 128 + 4 * n);
#pragma unroll
        for (int ai = 0; ai < 2; ++ai) {
            f32x4 xv[4][2][2];
#pragma unroll
            for (int m = 0; m < 4; ++m)
#pragma unroll
                for (int bj = 0; bj < 2; ++bj)
#pragma unroll
                    for (int n = 0; n < 2; ++n) xv[m][bj][n] = __builtin_nontemporal_load((const GAS f32x4*)(x + (size_t)(row0 + ai * 128 + m * 16) * D + col0 + bj * 128 + 4 * n));
#pragma unroll
            for (int m = 0; m < 4; ++m) { const size_t off = (size_t)(u.pm * 256 + wr * 64 + cs.rrow + ai * 128 + m * 16) * D + u.pn * 256 + wc * 32 + 8 * cs.rpc;
#pragma unroll
                for (int bj = 0; bj < 2; ++bj) *(GAS u32x4*)(XM + off + bj * 128) = cs.xch(kk++, pack8(xv[m][bj][0] + g[bj][0] * acc[ai][bj][m][0], xv[m][bj][1] + g[bj][1] * acc[ai][bj][m][1])); }
            asm volatile("" ::: "memory");
        }
    }
};
struct EpiGateUp {
    static constexpr bool PERM = true, MIDK = false;
    unsigned char* H;
    __device__ __forceinline__ void operator()(const f32x4 (&acc)[2][2][4][2], const pg8::Unit& u, int wr, int wc, int fr, int fq) const {
        const int row0 = u.pm * 256 + wr * 64 + fr, col0 = u.pn * 128 + wc * 32 + 8 * fq;
#pragma unroll
        for (int ai = 0; ai < 2; ++ai)
#pragma unroll
            for (int m = 0; m < 4; ++m) { f32x4 v0, v1;
#pragma unroll
                for (int h = 0; h < 2; ++h) {
                    const f32x2 g0 = h ? hi2(acc[ai][0][m][0]) : lo2(acc[ai][0][m][0]), u0 = h ? hi2(acc[ai][1][m][0]) : lo2(acc[ai][1][m][0]);
                    const f32x2 g1 = h ? hi2(acc[ai][0][m][1]) : lo2(acc[ai][0][m][1]), u1 = h ? hi2(acc[ai][1][m][1]) : lo2(acc[ai][1][m][1]);
                    const f32x2 r0 = (g0 * u0) * rcp_2(exp2_2(g0) + 1.0f), r1 = (g1 * u1) * rcp_2(exp2_2(g1) + 1.0f);
                    v0[2 * h] = r0.x; v0[2 * h + 1] = r0.y; v1[2 * h] = r1.x; v1[2 * h + 1] = r1.y; }
                *(GAS u32x2*)(H + (size_t)(row0 + ai * 128 + m * 16) * DEXP + col0) = pack8_fp8(v0, v1); }
    }
};
struct EpiDown {
    static constexpr bool PERM = true, MIDK = false;
    const unsigned* lrow; const float* lw; bf16* YT; const LAS unsigned* tab;
    __device__ __forceinline__ void operator()(const f32x4 (&acc)[2][2][4][2], const pg8::Unit& u, int wr, int wc, int fr, int fq) const {
        const int col0 = u.pn * 256 + wc * 32 + 8 * fq, lt0 = u.pn  ; (void)lt0;
        const int e = u.e & 63, cnt = u.e >> 6;
        const CSh cs(wr, wc, fr, fq); int kk = 0; (void)col0;
#pragma unroll
        for (int ai = 0; ai < 2; ++ai)
#pragma unroll
            for (int m = 0; m < 4; ++m) { const int rb = ai * 128 + wr * 64 + m * 16, r = rb + fr, rs = rb + cs.rrow, li = u.v + rs;
                const float wq = u.ui < 7 ? __uint_as_float(tab[2 * (u.ui * 256 + r) + 1]) : lw[(size_t)e * LIST_CAP + (u.v + r < cnt ? u.v + r : 0)] * (1.0f / WD_SCALE);
                const unsigned ent = u.ui < 7 ? tab[2 * (u.ui * 256 + rs)] : lrow[(size_t)e * LIST_CAP + (li < cnt ? li : 0)];
                bf16* dst = YT + (size_t)ent * D + u.pn * 256 + wc * 32 + 8 * cs.rpc;
#pragma unroll
                for (int bj = 0; bj < 2; ++bj) { const u32x4 t = cs.xch(kk++, pack8(acc[ai][bj][m][0] * wq, acc[ai][bj][m][1] * wq));
                    if (li < cnt) *(GAS u32x4*)(dst + bj * 128) = t; } }
    }
};
struct MoeOrder {
    const LAS int* utab; int n;
    __device__ __forceinline__ bool next(int i, pg8::Unit& u) const { if (i >= n) return false;
        u.pm = __builtin_amdgcn_readfirstlane(utab[4 * i]); u.pn = __builtin_amdgcn_readfirstlane(utab[4 * i + 1]); u.v = __builtin_amdgcn_readfirstlane(utab[4 * i + 2]); u.e = __builtin_amdgcn_readfirstlane(utab[4 * i + 3]); u.ui = i; return true; }
};
__device__ __forceinline__ int moe_tables(Frame& F, bool rows) {
    LAS int* utab = (LAS int*)(F.lds + TAB_UNITS); LAS int* cnts = (LAS int*)(F.lds + TAB_CNT); LAS int* nun = cnts + 72;
    LAS unsigned* rowtab = (LAS unsigned*)(F.lds + TAB_ROWS);
    __syncthreads();
    if (rows || MK_N_LAUNCHES != 1) {
        if (F.tid < 64) {
            const int lane = F.tid, c = lane < 32 ? (int)__hip_atomic_load(F.ctl + CW_CNT + 64 * lane, RLX_AGENT) : 0, tiles = (c + 255) >> 8;
            int x = tiles;
#pragma unroll
            for (int o = 1; o < 32; o <<= 1) { const int y = __shfl_up(x, o); if (lane >= o) x += y; }
            const int excl = x - tiles, total = __shfl(x, 31) * 4;
            int n = 0;
            for (int i = 0; i < MAX_WG_UNITS; ++i) { const int L = i * F.G + F.vcu; if (L >= total) break;
                const int rt = L >> 2, pn = L & 3;
                const unsigned long long m = __ballot(lane < 32 && excl <= rt && rt < excl + tiles);
                const int e = m ? __builtin_ctzll(m) : 0, ce = __shfl(c, e), lt = rt - __shfl(excl, e);
                if (lane == 0) { utab[4 * i] = rt; utab[4 * i + 1] = pn; utab[4 * i + 2] = lt * 256; utab[4 * i + 3] = e | (ce << 6); }
                ++n; }
            if (lane == 0) nun[0] = n;
        }
        __syncthreads();
    }
    const int n = nun[0];
    if (rows) {
        const unsigned* lrow = (const unsigned*)(F.ws + WS_LROW);
        for (int q = F.tid; q < n * 256; q += 512) { const int i = q >> 8, r = q & 255, e = utab[4 * i + 3] & 63, cnt = utab[4 * i + 3] >> 6, li = utab[4 * i + 2] + r;
            const unsigned tok = li < cnt ? (lrow[(size_t)e * LIST_CAP + li] >> 1) : 0u; rowtab[q] = tok * (unsigned)D; }
    } else {
        const unsigned* lrow = (const unsigned*)(F.ws + WS_LROW); const float* lw = (const float*)(F.ws + WS_LW);
        for (int q = F.tid; q < n * 256 && q < 7 * 256; q += 512) { const int i = q >> 8, r = q & 255, e = utab[4 * i + 3] & 63, cnt = utab[4 * i + 3] >> 6, li = utab[4 * i + 2] + r, lc = li < cnt ? li : 0;
            rowtab[2 * q] = lrow[(size_t)e * LIST_CAP + lc]; rowtab[2 * q + 1] = __float_as_uint(lw[(size_t)e * LIST_CAP + lc] * (1.0f / WD_SCALE)); }
    }
    __syncthreads();
    return n;
}

constexpr int KCH = 4112;
constexpr int AT_K = 0, AT_V = 8 * KCH  , AT_POS = AT_V + 32768, AT_TAB = AT_POS + 1024  , AT_TABT = AT_TAB + 4 * 132 * 4  ,
              AT_OST = 72704  , AT_END = AT_OST + 8 * 4096;
static_assert(AT_TABT + 4 * 200 * 4 <= AT_OST, "attention LDS");
static_assert(AT_END <= RING_BYTES, "attention LDS");
__device__ __forceinline__ int crow(int r, int hi) { return (r & 3) + 8 * (r >> 2) + 4 * hi; }
__device__ __forceinline__ s16x4 vtr(const LAS unsigned char* p) { typedef short v4i16_t __attribute__((ext_vector_type(4))); return __builtin_bit_cast(s16x4, __builtin_amdgcn_ds_read_tr16_b64_v4i16((LAS v4i16_t*)p)); }
__device__ __forceinline__ bf16x8 mk8(const s16x4 lo, const s16x4 hi) { return (bf16x8){lo[0], lo[1], lo[2], lo[3], hi[0], hi[1], hi[2], hi[3]}; }

__device__ __forceinline__ void attn_unit(Frame& F, const Args& A, int b, int blk, int kvh) {
    int tid = F.tid; asm volatile("" : "+v"(tid));
    const int lane = tid & 63, wid = F.wave, r32 = lane & 31, hi = lane >> 5;
    LAS unsigned char* L = F.lds + RING_OFF;
    const bf16* Q = (const bf16*)(F.ws + WS_Q); const bf16* KV = (const bf16*)(F.ws + WS_KV); bf16* YAB = (bf16*)(F.ws + WS_YAB);
    const int r0 = b * SEQ + blk * 128, rp = blk > 0 ? r0 - 128 : r0;
    __syncthreads();
#pragma unroll
    for (int j = 0; j < 4; ++j) { const int p = tid + 512 * j, key = p >> 3, c = p & 7; const int grow = key < 128 ? rp + key : r0 + key - 128;
        const u32x4 kk = *(const GAS u32x4*)(KV + (size_t)grow * NKV + kvh * 64 + c * 8);
        const u32x4 vv = *(const GAS u32x4*)(KV + (size_t)grow * NKV + 128 + kvh * 64 + c * 8);
        *(LAS u32x4*)(L + AT_K + c * KCH + key * 16) = kk;
        *(LAS u32x4*)(L + AT_V + ((key >> 4) * 2 + (c >> 2)) * 1024 + (key & 15) * 64 + (c & 3) * 16) = vv; }
    if (tid < 256) { const int grow = tid < 128 ? rp + tid : r0 + tid - 128; ((LAS int*)(L + AT_POS))[tid] = ((const int*)A.in[I_POS])[grow]; }
    if (tid < 200) { int n = tid - 36; n = n < 0 ? 0 : (n > 128 ? 128 : n); int bucket;
        if (n < 16) bucket = n; else { const int lg = (int)(logf((float)n / 16.0f) / logf(8.0f) * 16.0f); bucket = 16 + lg; if (bucket > 31) bucket = 31; }
#pragma unroll
        for (int g = 0; g < 4; ++g) { const float v = A.in[I_RELB][bucket * 8 + kvh * 4 + g] * LOG2E; ((LAS float*)(L + AT_TABT))[g * 200 + tid] = v; if (tid >= 36 && tid <= 164) ((LAS float*)(L + AT_TAB))[g * 132 + tid - 36] = v; } }
    __syncthreads();
    const int toep = __syncthreads_and(tid >= 255 || (blk == 0 && tid < 128) || ((const LAS int*)(L + AT_POS))[tid + 1] - ((const LAS int*)(L + AT_POS))[tid] == 1);
    const int g = wid & 3, qh = wid >> 2, head = kvh * 4 + g;
    const float sink2 = A.in[I_SINKS][head] * LOG2E;
    const LAS float* tab = (const LAS float*)(L + AT_TAB) + g * 132;
    const LAS int* posl = (const LAS int*)(L + AT_POS);
#pragma unroll 1
    for (int s = 0; s < 2; ++s) {
        const int i0 = 64 * qh + 32 * s, T0 = i0 >> 5;
        bf16x8 qr[4];
#pragma unroll
        for (int ks = 0; ks < 4; ++ks) qr[ks] = *(const GAS bf16x8*)(Q + (size_t)(r0 + i0 + r32) * NQ + head * 64 + ks * 16 + hi * 8);
        const int pq = posl[128 + i0 + r32];
        f32x16 p[5];
#pragma unroll
        for (int j = 0; j < 5; ++j) {
            f32x16 a = {};
#pragma unroll
            for (int ks = 0; ks < 4; ++ks) { const bf16x8 kf = *(const LAS bf16x8*)(L + AT_K + (2 * ks + hi) * KCH + (32 * (T0 + j) + r32) * 16);
                a = __builtin_amdgcn_mfma_f32_32x32x16_bf16(kf, qr[ks], a, 0, 0, 0); }
            p[j] = a;
        }
        float mx = sink2;
        if (toep) {
            const LAS float* tb = (const LAS float*)(L + AT_TABT) + g * 200 + (r32 - 4 * hi + 4);
#pragma unroll
            for (int j = 0; j < 5; ++j) {
                const bool tile_dead = (blk == 0) && (T0 + j < 4);
#pragma unroll
                for (int r = 0; r < 16; ++r) { const int kl = (r & 3) + 8 * (r >> 2) + 4 * hi;
                    float sv = p[j][r] + tb[160 - 32 * j - (r & 3) - 8 * (r >> 2)];
                    bool ok = !tile_dead;
                    if (j == 0) ok = ok && (kl > r32);
                    if (j == 4) ok = ok && (kl <= r32);
                    sv = ok ? sv : -1e30f;
                    p[j][r] = sv; mx = fmaxf(mx, sv); }
            }
        } else {
#pragma unroll
        for (int j = 0; j < 5; ++j) {
            const bool tile_dead = (blk == 0) && (T0 + j < 4);
#pragma unroll
            for (int rq = 0; rq < 4; ++rq) {
                const int k0 = 32 * (T0 + j) + 8 * rq + 4 * hi;
                typedef int i32x4 __attribute__((ext_vector_type(4))); const i32x4 pk = *(const LAS i32x4*)(posl + k0);
#pragma unroll
                for (int q = 0; q < 4; ++q) { const int r = 4 * rq + q, kl = 8 * rq + 4 * hi + q;
                    const int pkv = pk[q];
                    int n = pq - pkv; n = n < 0 ? 0 : (n > 128 ? 128 : n);
                    float sv = p[j][r] + tab[n];
                    bool ok = !tile_dead;
                    if (j == 0) ok = ok && (kl > r32);
                    if (j == 4) ok = ok && (kl <= r32);
                    sv = ok ? sv : -1e30f;
                    p[j][r] = sv; mx = fmaxf(mx, sv); }
            }
        }
        }
        mx = fmaxf(mx, __shfl_xor(mx, 32));
        float l = 0.f;
#pragma unroll
        for (int j = 0; j < 5; ++j)
#pragma unroll
            for (int r = 0; r < 16; ++r) { const float e = __builtin_amdgcn_exp2f(p[j][r] - mx); p[j][r] = e; l += e; }
        l += __shfl_xor(l, 32);
        l += __builtin_amdgcn_exp2f(sink2 - mx);
        const float rl = 1.0f / l;
        f32x16 o[2]; o[0] = (f32x16){}; o[1] = (f32x16){};
        const int vlane = (4 * hi + ((lane & 15) >> 2)) * 64 + ((lane >> 4) & 1) * 32 + (lane & 3) * 8;
#pragma unroll
        for (int j = 0; j < 5; ++j)
#pragma unroll
            for (int s2 = 0; s2 < 2; ++s2) {
                u32x4 pw; pw.x = cvtpk(p[j][8 * s2 + 0] * rl, p[j][8 * s2 + 1] * rl); pw.y = cvtpk(p[j][8 * s2 + 2] * rl, p[j][8 * s2 + 3] * rl);
                pw.z = cvtpk(p[j][8 * s2 + 4] * rl, p[j][8 * s2 + 5] * rl); pw.w = cvtpk(p[j][8 * s2 + 6] * rl, p[j][8 * s2 + 7] * rl);
                const bf16x8 pa = __builtin_bit_cast(bf16x8, pw);
                const int kg = 2 * (T0 + j) + s2;
#pragma unroll
                for (int d0 = 0; d0 < 2; ++d0) { const LAS unsigned char* vp = L + AT_V + (kg * 2 + d0) * 1024 + vlane;
                    const bf16x8 vf = mk8(vtr(vp), vtr(vp + 512));
                    o[d0] = __builtin_amdgcn_mfma_f32_32x32x16_bf16(pa, vf, o[d0], 0, 0, 0); }
            }
        {
            LAS bf16* stg = (LAS bf16*)(L + AT_OST + wid * 4096);
#pragma unroll
            for (int d0 = 0; d0 < 2; ++d0)
#pragma unroll
                for (int r = 0; r < 16; ++r) stg[crow(r, hi) * 64 + 32 * d0 + r32] = (bf16)(cvtpk(o[d0][r], 0.f) & 0xffffu);
#pragma unroll
            for (int i = 0; i < 4; ++i) { const int pc = lane + 64 * i, row = pc >> 3, ch = pc & 7;
                const u32x4 v = *(const LAS u32x4*)(stg + row * 64 + ch * 8);
                *(GAS u32x4*)(YAB + (size_t)(r0 + i0 + row) * D + head * 64 + ch * 8) = v; }
        }
    }
}

__device__ __forceinline__ void gmlp_unit(Frame& F, const Args& A, int b, int ch) {
    int tid = F.tid; asm volatile("" : "+v"(tid));
    const int lane = tid & 63, wid = F.wave, r32 = lane & 31, hi = lane >> 5;
    LAS unsigned char* L = F.lds + RING_OFF;
    const bf16* GU = (const bf16*)(F.ws + WS_GU); const bf16* GV = (const bf16*)(F.ws + WS_GV); bf16* YAB = (bf16*)(F.ws + WS_YAB);
    const bf16* WST = (const bf16*)(F.ws + WS_WST);
    const int r0 = b * SEQ + ch * 128;
    const int g = wid >> 1, chalf = wid & 1;
    bf16x8 wfl[20];
#pragma unroll
    for (int tt = 0; tt < 4; ++tt)
#pragma unroll
        for (int ks = 0; ks < 8; ++ks) if (ks <= 2 * tt + 1) wfl[tt * (tt + 1) + ks] = *(const GAS bf16x8*)(WST + ((size_t)g * 128 + 32 * tt + r32) * 128 + 16 * ks + 8 * hi);
    float bin[4]; u32x4 gun[4];
#pragma unroll
    for (int i = 0; i < 4; ++i) { const int pc = lane + 64 * i; bin[i] = A.in[I_GBS][g * 128 + (pc >> 3)]; gun[i] = *(const GAS u32x4*)(GU + (size_t)(r0 + (pc >> 3)) * GMW + g * 128 + 64 * chalf + 8 * (pc & 7)); }
    __syncthreads();
    {
        const float* lg = A.in[I_LNG]; const float* lb = A.in[I_LNB];
        const f32x4 g0 = *(const GAS f32x4*)(lg + 8 * lane), g1 = *(const GAS f32x4*)(lg + 8 * lane + 4), b0 = *(const GAS f32x4*)(lb + 8 * lane), b1 = *(const GAS f32x4*)(lb + 8 * lane + 4);
        const int grp = lane >> 4, cb = (lane & 15) >> 2;
        u32x4 gvr[16];
#pragma unroll
        for (int j = 0; j < 16; ++j) gvr[j] = *(const GAS u32x4*)(GV + (size_t)(r0 + 16 * wid + j) * GMW + 8 * lane);
#pragma unroll
        for (int j = 0; j < 16; ++j) {
            f32x4 v0, v1; unpack8(gvr[j], v0, v1);
            const float mu = wave_sum((v0[0] + v0[1]) + (v0[2] + v0[3]) + (v1[0] + v1[1]) + (v1[2] + v1[3])) * (1.0f / GMW);
            v0 = v0 - mu; v1 = v1 - mu;
            const float var = wave_sum((v0[0] * v0[0] + v0[1] * v0[1]) + (v0[2] * v0[2] + v0[3] * v0[3]) + (v1[0] * v1[0] + v1[1] * v1[1]) + (v1[2] * v1[2] + v1[3] * v1[3])) * (1.0f / GMW);
            const float rstd = __builtin_amdgcn_rsqf(var + EPS);
            *(LAS u32x4*)(L + grp * 32768 + (wid * 4 + cb) * 1024 + j * 64 + (lane & 3) * 16) = pack8(v0 * rstd * g0 + b0, v1 * rstd * g1 + b1); }
    }
    __syncthreads();
    const int vlane = (8 * hi + ((lane & 15) >> 2)) * 64 + ((lane >> 4) & 1) * 32 + (lane & 3) * 8;
    bf16x8 bfr[2][8];
#pragma unroll
    for (int ct = 0; ct < 2; ++ct)
#pragma unroll
        for (int ks = 0; ks < 8; ++ks) { const LAS unsigned char* vp = L + g * 32768 + (ks * 4 + 2 * chalf + ct) * 1024 + vlane; bfr[ct][ks] = mk8(vtr(vp), vtr(vp + 256)); }
    __syncthreads();
    LAS float* stg = (LAS float*)(L + wid * (32 * 68 * 4));
#pragma unroll
    for (int tt = 0; tt < 4; ++tt) {
        f32x16 acc[2]; acc[0] = (f32x16){}; acc[1] = (f32x16){};
#pragma unroll
        for (int ks = 0; ks < 8; ++ks) if (ks <= 2 * tt + 1) {
            acc[0] = __builtin_amdgcn_mfma_f32_32x32x16_bf16(wfl[tt * (tt + 1) + ks], bfr[0][ks], acc[0], 0, 0, 0);
            acc[1] = __builtin_amdgcn_mfma_f32_32x32x16_bf16(wfl[tt * (tt + 1) + ks], bfr[1][ks], acc[1], 0, 0, 0); }
#pragma unroll
        for (int ct = 0; ct < 2; ++ct)
#pragma unroll
            for (int r = 0; r < 16; ++r) stg[crow(r, hi) * 68 + 32 * ct + r32] = acc[ct][r];
        u32x4 gu[4]; float bi[4];
#pragma unroll
        for (int i = 0; i < 4; ++i) { gu[i] = gun[i]; bi[i] = bin[i]; }
        if (tt < 3) {
#pragma unroll
            for (int i = 0; i < 4; ++i) { const int pc = lane + 64 * i; bin[i] = A.in[I_GBS][g * 128 + 32 * (tt + 1) + (pc >> 3)];
                gun[i] = *(const GAS u32x4*)(GU + (size_t)(r0 + 32 * (tt + 1) + (pc >> 3)) * GMW + g * 128 + 64 * chalf + 8 * (pc & 7)); } }
#pragma unroll
        for (int i = 0; i < 4; ++i) { const int pc = lane + 64 * i, row = pc >> 3, chn = pc & 7, t = 32 * tt + row, c = g * 128 + 64 * chalf + 8 * chn;
            const f32x4 s0 = *(const LAS f32x4*)(stg + row * 68 + 8 * chn), s1 = *(const LAS f32x4*)(stg + row * 68 + 8 * chn + 4);
            const float bb = bi[i]; f32x4 u0, u1; unpack8(gu[i], u0, u1);
            *(GAS u32x4*)(YAB + (size_t)(r0 + t) * D + NQ + c) = pack8(u0 * (s0 + bb), u1 * (s1 + bb)); }
    }
}

__device__ __forceinline__ void router_images(Frame& F, const Args& A) {
    const float* mod = (const float*)(F.ws + WS_MOD); bf16* GT = (bf16*)(F.ws + WS_GT); float* GC = (float*)(F.ws + WS_GC);
    LAS float* red = (LAS float*)(F.lds + RING_OFF);
    for (int it = F.vcu; it < 8 * 48; it += F.G) { const int b = it / 48, n = it % 48; float part = 0.f;
#pragma unroll
        for (int cc = 0; cc < 2; ++cc) { const int c = F.tid + 512 * cc;
            const float sh = mod[(size_t)b * 6 * D + 3 * D + c], sc = mod[(size_t)b * 6 * D + 4 * D + c], a2 = A.in[I_N2G][c] * (1.0f + sc);
            const float w = n < 4 ? A.in[I_WRG][(size_t)c * 4 + n] : (n < 36 ? A.in[I_WRE][(size_t)c * 32 + (n - 4)] : 0.f);
            GT[((size_t)b * 48 + n) * D + c] = (bf16)(cvtpk(a2 * w, 0.f) & 0xffffu); part += sh * w; }
        part = wave_sum(part);
        __syncthreads(); if (F.lane == 0) red[F.wave] = part; __syncthreads();
        if (F.tid == 0) { float s = n < 4 ? A.in[I_BRG][n] : (n < 36 ? A.in[I_BRE][n - 4] : 0.f);
#pragma unroll
            for (int w = 0; w < 8; ++w) s += red[w];
            GC[b * 48 + n] = s; }
    }
}

constexpr int GT_STRIDE = 2064;
constexpr int R6_GT = 0, R6_A2 = 48 * GT_STRIDE  , R6_B2 = R6_A2 + 4096, R6_CONST = R6_B2 + 4096, R6_LCNT = R6_CONST + 256, R6_LBASE = R6_LCNT + 128, R6_RED = R6_LBASE + 128, R6_LOG = R6_RED + 8 * 40 * 4, R6_END = R6_LOG + 8 * 16 * 40 * 4;
static_assert(R6_END <= RING_BYTES, "router LDS");
__device__ __forceinline__ void p6_router(Frame& F, const Args& A) {
    const int wid = F.wave;
    LAS unsigned char* L = F.lds + RING_OFF;
    const float* mod = (const float*)(F.ws + WS_MOD);
    const bf16* XM = (const bf16*)(F.ws + WS_XMID); unsigned char* H2 = (unsigned char*)(F.ws + WS_H2);
    unsigned* lrow = (unsigned*)(F.ws + WS_LROW); float* lw = (float*)(F.ws + WS_LW);
    LAS float* A2 = (LAS float*)(L + R6_A2); LAS float* B2 = (LAS float*)(L + R6_B2); LAS float* cst = (LAS float*)(L + R6_CONST);
    LAS int* lcnt = (LAS int*)(L + R6_LCNT); LAS int* lbase = (LAS int*)(L + R6_LBASE); LAS float* red = (LAS float*)(L + R6_RED);
    LAS float* lg = (LAS float*)(L + R6_LOG) + wid * 16 * 40;
    for (int rb = F.vcu; rb < M / 128; rb += F.G) {
        const int b = rb / (SEQ / 128);
        int tid = F.tid; asm volatile("" : "+v"(tid)); const int lane = tid & 63;
        const int rloc = lane & 15, kq = lane >> 4, row = rb * 128 + wid * 16 + rloc;
        u32x4 xk[32];
#pragma unroll
        for (int ks = 0; ks < 32; ++ks) xk[ks] = *(const GAS u32x4*)(XM + (size_t)row * D + 32 * ks + 8 * kq);
        asm volatile("" ::: "memory");
        __syncthreads();
        {
            const bf16* GTb = (const bf16*)(F.ws + WS_GT) + (size_t)b * 48 * D;
            u32x4 gt[12];
#pragma unroll
            for (int i = 0; i < 12; ++i) gt[i] = *(const GAS u32x4*)(GTb + (size_t)(tid + 512 * i) * 8);
#pragma unroll
            for (int cc = 0; cc < 2; ++cc) { const int c = tid + 512 * cc; A2[c] = A.in[I_N2G][c] * (1.0f + mod[(size_t)b * 6 * D + 4 * D + c]); B2[c] = mod[(size_t)b * 6 * D + 3 * D + c]; }
            if (tid < 48) cst[tid] = ((const float*)(F.ws + WS_GC))[b * 48 + tid];
            if (tid < 32) lcnt[tid] = 0;
#pragma unroll
            for (int i = 0; i < 12; ++i) { const int pc = tid + 512 * i, n = pc >> 7, ch = pc & 127; *(LAS u32x4*)(L + R6_GT + n * GT_STRIDE + ch * 16) = gt[i]; }
        }
        __syncthreads();
        float ss = 0.f;
#pragma unroll
        for (int ks = 0; ks < 32; ++ks) { f32x4 a, c; unpack8(xk[ks], a, c); ss += (a[0] * a[0] + a[1] * a[1]) + (a[2] * a[2] + a[3] * a[3]) + (c[0] * c[0] + c[1] * c[1]) + (c[2] * c[2] + c[3] * c[3]); }
        ss += __shfl_xor(ss, 16); ss += __shfl_xor(ss, 32);
        const float rinv = 1.0f / sqrtf(ss * (1.0f / D) + EPS);
        f32x4 acc[3]; acc[0] = (f32x4){0.f, 0.f, 0.f, 0.f}; acc[1] = acc[0]; acc[2] = acc[0];
#pragma unroll
        for (int ks = 0; ks < 32; ++ks) { const bf16x8 af = __builtin_bit_cast(bf16x8, xk[ks]);
#pragma unroll
            for (int nt = 0; nt < 3; ++nt) { const bf16x8 bfg = *(const LAS bf16x8*)(L + R6_GT + (16 * nt + rloc) * GT_STRIDE + (32 * ks + 8 * kq) * 2);
                acc[nt] = __builtin_amdgcn_mfma_f32_16x16x32_bf16(af, bfg, acc[nt], 0, 0, 0); }
            if ((ks & 3) == 3) asm volatile("" ::: "memory"); }
#pragma unroll
        for (int nt = 0; nt < 3; ++nt) { const int n = 16 * nt + rloc; if (n < 36) {
#pragma unroll
            for (int q = 0; q < 4; ++q) lg[(4 * kq + q) * 40 + n] = acc[nt][q]; } }
#pragma unroll
        for (int ks = 0; ks < 32; ++ks) asm volatile("" : "+v"(xk[ks]));
#pragma unroll
        for (int ks = 0; ks < 32; ++ks) { const int c0 = 32 * ks + 8 * kq; f32x4 a, c; unpack8(xk[ks], a, c);
            const f32x4 a0 = *(const LAS f32x4*)(A2 + c0), a1 = *(const LAS f32x4*)(A2 + c0 + 4), b0 = *(const LAS f32x4*)(B2 + c0), b1 = *(const LAS f32x4*)(B2 + c0 + 4);
            *(GAS u32x2*)(H2 + (size_t)row * D + c0) = pack8_fp8(a * rinv * a0 + b0, c * rinv * a1 + b1);
            if ((ks & 3) == 3) asm volatile("" ::: "memory"); }
        LDS_WAIT(); asm volatile("" ::: "memory");
        int e1 = 0, e2 = 0, lp1 = 0, lp2 = 0; float w1 = 0.f, w2 = 0.f;
        if (lane < 16) {
            const LAS float* lr = lg + lane * 40;
            float l0[4]; int gi = 0;
#pragma unroll
            for (int n = 0; n < 4; ++n) l0[n] = lr[n] * rinv + cst[n];
            float gm = l0[0];
#pragma unroll
            for (int n = 1; n < 4; ++n) if (l0[n] > gm) { gm = l0[n]; gi = n; }
            float gs = 0.f;
#pragma unroll
            for (int n = 0; n < 4; ++n) gs += __expf(l0[n] - gm);
            const float pg = 1.0f / gs;
            float le[8];
#pragma unroll
            for (int j = 0; j < 8; ++j) le[j] = lr[4 + 8 * gi + j] * rinv + cst[4 + 8 * gi + j];
            int i1 = 0; float m1 = le[0];
#pragma unroll
            for (int j = 1; j < 8; ++j) if (le[j] > m1) { m1 = le[j]; i1 = j; }
            int i2 = -1; float m2 = -INFINITY;
#pragma unroll
            for (int j = 0; j < 8; ++j) if (j != i1 && le[j] > m2) { m2 = le[j]; i2 = j; }
            const float ex = __expf(m2 - m1); const float t1 = 1.0f / (1.0f + ex);
            w1 = pg * t1; w2 = pg * (ex * t1);
            if (i2 < 0) i2 = (i1 + 1) & 7;
            e1 = gi * 8 + i1; e2 = gi * 8 + i2;
            lp1 = atomicAdd((int*)&lcnt[e1], 1); lp2 = atomicAdd((int*)&lcnt[e2], 1);
        }
        __syncthreads();
        if (tid < 32) { const int c = lcnt[tid]; lbase[tid] = c > 0 ? (int)__hip_atomic_fetch_add(F.ctl + CW_CNT + 64 * tid, (unsigned)c, RLX_AGENT) : 0; }
        __syncthreads();
        if (lane < 16) {
            const int p1 = lbase[e1] + lp1, p2 = lbase[e2] + lp2;
            lrow[(size_t)e1 * LIST_CAP + p1] = (unsigned)row * 2u; lw[(size_t)e1 * LIST_CAP + p1] = w1;
            lrow[(size_t)e2 * LIST_CAP + p2] = (unsigned)row * 2u + 1u; lw[(size_t)e2 * LIST_CAP + p2] = w2;
#if DEBUG_CHECKS
            { float* rec = (float*)(F.ws + 490 * MiB) + (size_t)row * 4; rec[0] = (float)e1; rec[1] = (float)e2; rec[2] = w1; rec[3] = w2; }
#endif
        }
    }
}

__device__ __forceinline__ void p9_final(Frame& F, const Args& A) {
    const int lane = F.lane, wid = F.wave;
    const float* mod = (const float*)(F.ws + WS_MOD); const bf16* XM = (const bf16*)(F.ws + WS_XMID); const bf16* YT = (const bf16*)(F.ws + WS_YT);
    for (int rb = F.vcu; rb < M / 128; rb += F.G) {
        const int b = rb / (SEQ / 128);
        f32x4 g2[2][2], fg[2][2];
#pragma unroll
        for (int jj = 0; jj < 2; ++jj)
#pragma unroll
            for (int q = 0; q < 2; ++q) { const int c = 512 * jj + 8 * lane + 4 * q; g2[jj][q] = *(const GAS f32x4*)(mod + (size_t)b * 6 * D + 5 * D + c); fg[jj][q] = *(const GAS f32x4*)(A.in[I_FG] + c); }
#pragma unroll 1
        for (int j0 = 0; j0 < 16; j0 += 4) {
            u32x4 xm[4][2], y0[4][2], y1[4][2];
#pragma unroll
            for (int jr = 0; jr < 4; ++jr) { const int row = rb * 128 + wid * 16 + j0 + jr;
#pragma unroll
                for (int jj = 0; jj < 2; ++jj) { const int c = 512 * jj + 8 * lane;
                    xm[jr][jj] = __builtin_nontemporal_load((const GAS u32x4*)(XM + (size_t)row * D + c));
                    y0[jr][jj] = __builtin_nontemporal_load((const GAS u32x4*)(YT + (size_t)row * 2 * D + c));
                    y1[jr][jj] = __builtin_nontemporal_load((const GAS u32x4*)(YT + (size_t)row * 2 * D + D + c)); } }
#pragma unroll
            for (int jr = 0; jr < 4; ++jr) { const int row = rb * 128 + wid * 16 + j0 + jr;
                f32x4 v[2][2]; float ss = 0.f;
#pragma unroll
                for (int jj = 0; jj < 2; ++jj) { f32x4 x0, x1, a0, a1, z0, z1;
                    unpack8(xm[jr][jj], x0, x1); unpack8(y0[jr][jj], a0, a1); unpack8(y1[jr][jj], z0, z1);
                    v[jj][0] = x0 + g2[jj][0] * (a0 + z0); v[jj][1] = x1 + g2[jj][1] * (a1 + z1);
#pragma unroll
                    for (int q = 0; q < 2; ++q) ss += (v[jj][q][0] * v[jj][q][0] + v[jj][q][1] * v[jj][q][1]) + (v[jj][q][2] * v[jj][q][2] + v[jj][q][3] * v[jj][q][3]); }
                const float rinv = 1.0f / sqrtf(wave_sum(ss) * (1.0f / D) + EPS);
#pragma unroll
                for (int jj = 0; jj < 2; ++jj)
#pragma unroll
                    for (int q = 0; q < 2; ++q) __builtin_nontemporal_store(v[jj][q] * rinv * fg[jj][q], (GAS f32x4*)(A.out + (size_t)row * D + 512 * jj + 8 * lane + 4 * q)); }
        }
    }
}

__global__ void __launch_bounds__(NWAVES * 64, 2) mk_fwd(Args args) {
    extern __shared__ __attribute__((aligned(16))) unsigned char lds[];
    Frame F;
    F.lds = (LAS unsigned char*)lds;
    F.MISC = (volatile LAS unsigned*)(F.lds + MISC_OFF);
    F.tid = threadIdx.x; F.lane = F.tid & 63; F.wave = __builtin_amdgcn_readfirstlane(F.tid >> 6);
    F.G = gridDim.x; { const int bx = blockIdx.x; F.vcu = (F.G % 8 == 0) ? (bx % 8) * (F.G / 8) + bx / 8 : bx; }
    F.ws = args.ws; F.ctl = (gu32*)(args.ws + WS_CTL);
    for (int u = F.tid; u < (TAB_OFF - LDSCTL_OFF) / 4; u += NWAVES * 64) ((LAS unsigned*)(F.lds + LDSCTL_OFF))[u] = 0u;
    __syncthreads();
    XcdBarrier bar; bar.bar = (unsigned*)(F.ctl + CW_BAR); bar.x = 0; bar.st = nullptr;
    if (MK_N_LAUNCHES == 1) bar = xcd_barrier_post((unsigned*)(F.ctl + CW_BAR), F.MISC + 8);
#define GRID_BAR() do { if (MK_N_LAUNCHES == 1) xcd_barrier(bar); } while (0)
    const int lo = args.ph_lo, hi = args.ph_hi;
#ifdef ONLY_PHASE
#define IN(k) ((k) == ONLY_PHASE && lo <= (k) && (k) < hi)
#else
#define IN(k) (lo <= (k) && (k) < hi)
#endif
#define BOTH(k) (IN(k) && IN((k) + 1))

    if (IN(0)) { p0_prologue(F, args); if (BOTH(0)) GRID_BAR(); }
    if (IN(1)) { p1_h1(F, args); if (BOTH(1)) GRID_BAR(); }
    if (IN(2)) {
        const bool fp8_first = (blockIdx.x & 1) != 0;
#define P2_BF16() do { ProbDense P{D * 2, D * 2u, D * 2u, (const char*)(F.ws + WS_A), (const char*)(F.ws + WS_WIN), nullptr}; \
            pg8::DenseOrder S; S.init(M, NBF, F.G, (int)blockIdx.x); EpiInProjT<false> E{F.ws, 0, 1.0f}; \
            pg8::gemm_phase<ProbDense, EpiInProjT<false>, pg8::DenseOrder, true>(F.lds + RING_OFF, P, S, E); } while (0)
#define P2_FP8() do { ProbDense8 P{D, (unsigned)D, (unsigned)D, (const char*)(F.ws + WS_H1F8), (const char*)(F.ws + WS_WIN8), nullptr}; \
            pg8::BackfillOrder S; S.init(M, INW - NBF, F.G, (int)blockIdx.x); EpiInProjT<true> E{F.ws, NBF / 256, 1.0f}; \
            pg8::gemm_phase<ProbDense8, EpiInProjT<true>, pg8::BackfillOrder, true>(F.lds + RING_OFF, P, S, E); } while (0)
        if (fp8_first) { P2_FP8(); P2_BF16(); } else { P2_BF16(); P2_FP8(); }
#undef P2_BF16
#undef P2_FP8
        if (BOTH(2)) GRID_BAR();
    }
    if (IN(3)) {
        router_images(F, args);
        for (int ub = F.vcu; ub < M / 128; ub += F.G) { const int b = ub / (SEQ / 128), blk = ub % (SEQ / 128);

#ifndef NO_ATTN
#pragma unroll 1
            for (int kvh = 0; kvh < 2; ++kvh) attn_unit(F, args, b, blk, kvh);
            asm volatile("" ::: "memory");
#endif
#ifndef NO_GMLP
            gmlp_unit(F, args, b, blk);
#endif
        }
        __syncthreads();
        if (BOTH(3)) GRID_BAR();
    }
    if (IN(4)) {
        ProbDense P{D * 2, D * 2u, D * 2u, (const char*)(F.ws + WS_YAB), (const char*)(F.ws + WS_PA), nullptr};
        pg8::DenseOrder S; S.init(M, D, F.G, (int)blockIdx.x);
        EpiMerge E{(const unsigned char*)(F.ws + WS_GA), (const unsigned char*)(F.ws + WS_GB), (bf16*)(F.ws + WS_A)};
        pg8::gemm_phase<ProbDense, EpiMerge, pg8::DenseOrder, true>(F.lds + RING_OFF, P, S, E);
        if (BOTH(4)) GRID_BAR();
    }
    if (IN(5)) {
        ProbDense P{D * 2, D * 2u, D * 2u, (const char*)(F.ws + WS_A), (const char*)(F.ws + WS_WO), nullptr};
        pg8::DenseOrder S; S.init(M, D, F.G, (int)blockIdx.x);
        EpiWo E{args.in[I_X], (const float*)(F.ws + WS_MOD), (bf16*)(F.ws + WS_XMID)};
        pg8::gemm_phase<ProbDense, EpiWo, pg8::DenseOrder, true>(F.lds + RING_OFF, P, S, E);
        if (BOTH(5)) GRID_BAR();
    }
    if (IN(6)) { p6_router(F, args); __syncthreads(); if (BOTH(6)) GRID_BAR(); }
    if (IN(7)) {
        const int n = moe_tables(F, true);
        ProbGateUp P{D, (unsigned)D, (unsigned)D, (const char*)(F.ws + WS_H2), (const char*)(F.ws + WS_WGU), (const LAS unsigned*)(F.lds + TAB_ROWS)};
        MoeOrder S{(const LAS int*)(F.lds + TAB_UNITS), n};
        EpiGateUp E{(unsigned char*)(F.ws + WS_HACT)};
        pg8::gemm_phase<ProbGateUp, EpiGateUp, MoeOrder, true>(F.lds + RING_OFF, P, S, E);
        if (BOTH(7)) GRID_BAR();
    }
    if (IN(8)) {
        const int n = moe_tables(F, false);
        ProbDown P{DEXP, (unsigned)DEXP, (unsigned)DEXP, (const char*)(F.ws + WS_HACT), (const char*)(F.ws + WS_WD), nullptr};
        MoeOrder S{(const LAS int*)(F.lds + TAB_UNITS), n};
        EpiDown E{(const unsigned*)(F.ws + WS_LROW), (const float*)(F.ws + WS_LW), (bf16*)(F.ws + WS_YT), (const LAS unsigned*)(F.lds + TAB_ROWS)};
        pg8::gemm_phase<ProbDown, EpiDown, MoeOrder, true>(F.lds + RING_OFF, P, S, E);
        if (BOTH(8)) GRID_BAR();
    }
    if (IN(9)) { p9_final(F, args); }
#undef IN
#undef BOTH
}


#if DEBUG_CHECKS
constexpr size_t WS_DBG = 490 * MiB;
constexpr int CW_DBG = 200000;
constexpr int NSAMP = 512;
__device__ __forceinline__ int samp_row(int i) { return 64 * i + ((i * 7) & 63); }
__device__ __forceinline__ float bfr(float v) { return bf_lo(cvtpk(v, 0.f) & 0xffffu); }
__device__ __forceinline__ float ldbf(const bf16* p) { return __uint_as_float((unsigned)(*p) << 16); }
__device__ __forceinline__ float f8dec(unsigned char b) { return __builtin_amdgcn_cvt_f32_fp8((int)b, 0); }
__device__ __forceinline__ float f8r(float v) { return f8dec((unsigned char)(pk4_fp8(v, 0.f, 0.f, 0.f) & 0xffu)); }
__device__ __forceinline__ void dbg_acc(unsigned char* ws, int k, float err, float ref) { float* a = (float*)(ws + WS_CTL) + CW_DBG; atomicAdd(a + 2 * k, err * err); atomicAdd(a + 2 * k + 1, ref * ref); }
__device__ __forceinline__ float block_sum256(float v, float* sh) {
    v = wave_sum(v); __syncthreads(); if ((threadIdx.x & 63) == 0) sh[threadIdx.x >> 6] = v; __syncthreads(); const float r = sh[0] + sh[1] + sh[2] + sh[3]; __syncthreads(); return r; }
__global__ void __launch_bounds__(256) chk_h1(Args a) {
    __shared__ float sh[8];
    const int row = samp_row(blockIdx.x), b = row / SEQ, t = threadIdx.x;
    float sc[4], shf[4];
#pragma unroll
    for (int q = 0; q < 4; ++q) { sc[q] = a.in[I_BADA][D + t + 256 * q]; shf[q] = a.in[I_BADA][t + 256 * q]; }
    for (int k = 0; k < D; ++k) { const float cv = a.in[I_C][b * D + k]; const float cs = cv / (1.0f + expf(-cv));
#pragma unroll
        for (int q = 0; q < 4; ++q) { sc[q] += cs * a.in[I_WADA][(size_t)k * 6 * D + D + t + 256 * q]; shf[q] += cs * a.in[I_WADA][(size_t)k * 6 * D + t + 256 * q]; } }
    float ss = 0.f; float xv[4];
#pragma unroll
    for (int q = 0; q < 4; ++q) { xv[q] = a.in[I_X][(size_t)row * D + t + 256 * q]; ss += xv[q] * xv[q]; }
    const float rinv = 1.0f / sqrtf(block_sum256(ss, sh) / D + EPS);
    const bf16* h1 = (const bf16*)(a.ws + WS_A);
#pragma unroll
    for (int q = 0; q < 4; ++q) { const int c = t + 256 * q; const float ref = xv[q] * rinv * a.in[I_N1G][c] * (1.0f + sc[q]) + shf[q]; dbg_acc(a.ws, 0, ldbf(h1 + (size_t)row * D + c) - ref, ref); }
}
__global__ void __launch_bounds__(256) chk_inproj(Args a) {
    const int idx = blockIdx.x * 256 + threadIdx.x; if (idx >= NSAMP * INW) return;
    const int row = samp_row(idx / INW), n = idx % INW;
    const bf16* h1 = (const bf16*)(a.ws + WS_A); float s = 0.f;
    if (n < NBF) { for (int k = 0; k < D; ++k) s += ldbf(h1 + (size_t)row * D + k) * bfr(a.in[I_WIN][(size_t)k * INW + n]); }
    else { for (int k = 0; k < D; ++k) s += f8dec(((const unsigned char*)(a.ws + WS_H1F8))[(size_t)row * D + k]) * f8r(a.in[I_WIN][(size_t)k * INW + n] * WGU_SCALE); s *= 1.0f / WGU_SCALE; }
    float ref, got;
    if (n < 512) { ref = s * QSCALE; got = ldbf((const bf16*)(a.ws + WS_Q) + (size_t)row * NQ + n); }
    else if (n < 768) { ref = s; got = ldbf((const bf16*)(a.ws + WS_KV) + (size_t)row * NKV + n - 512); }
    else if (n < 1280) { ref = 0.5f * s * (1.0f + tanhf(0.7978845608f * (s + 0.044715f * s * s * s))); got = ldbf((const bf16*)(a.ws + WS_GU) + (size_t)row * GMW + n - 768); }
    else if (n < 1792) { ref = 0.5f * s * (1.0f + tanhf(0.7978845608f * (s + 0.044715f * s * s * s))); got = ldbf((const bf16*)(a.ws + WS_GV) + (size_t)row * GMW + n - 1280); }
    else if (n < 2816) { ref = 1.0f / (1.0f + expf(-s)); got = (float)((const unsigned char*)(a.ws + WS_GA))[(size_t)row * D + n - 1792] * (1.0f / 255.0f); }
    else { ref = fmaxf(1.0f / (1.0f + expf(-s)), 1.0f / 255.0f); got = (float)((const unsigned char*)(a.ws + WS_GB))[(size_t)row * D + n - 2816] * (1.0f / 255.0f); }
    dbg_acc(a.ws, 1, got - ref, ref);
}
__global__ void __launch_bounds__(256) chk_attn(Args a) {
    const int idx = blockIdx.x * 256 + threadIdx.x; if (idx >= NSAMP * 8 * 4) return;
    const int row = samp_row(idx / 32), head = (idx >> 2) & 7, dq = idx & 3, b = row / SEQ, tpos = row % SEQ, blk = tpos / 128, kvh = head >> 2;
    const bf16* Q = (const bf16*)(a.ws + WS_Q); const bf16* KV = (const bf16*)(a.ws + WS_KV); const int* pos = (const int*)a.in[I_POS];
    const int band0 = b * SEQ + blk * 128 - 128;
    const int i = tpos % 128;
    float m = a.in[I_SINKS][head], l = 0.f; float o[16];
#pragma unroll
    for (int d = 0; d < 16; ++d) o[d] = 0.f;
    for (int kj = i + 1; kj <= i + 128; ++kj) { if (blk == 0 && kj < 128) continue; const int kr = band0 + kj;
        float s = 0.f; for (int d = 0; d < 64; ++d) s += ldbf(Q + (size_t)row * NQ + head * 64 + d) * ldbf(KV + (size_t)kr * NKV + kvh * 64 + d);
        s *= (1.0f / LOG2E);
        int n = pos[row] - pos[kr]; if (n < 0) n = 0; int bucket; if (n < 16) bucket = n; else { bucket = 16 + (int)(logf((float)n / 16.0f) / logf(8.0f) * 16.0f); if (bucket > 31) bucket = 31; }
        s += a.in[I_RELB][bucket * 8 + head]; m = fmaxf(m, s); }
    for (int kj = i + 1; kj <= i + 128; ++kj) { if (blk == 0 && kj < 128) continue; const int kr = band0 + kj;
        float s = 0.f; for (int d = 0; d < 64; ++d) s += ldbf(Q + (size_t)row * NQ + head * 64 + d) * ldbf(KV + (size_t)kr * NKV + kvh * 64 + d);
        s *= (1.0f / LOG2E);
        int n = pos[row] - pos[kr]; if (n < 0) n = 0; int bucket; if (n < 16) bucket = n; else { bucket = 16 + (int)(logf((float)n / 16.0f) / logf(8.0f) * 16.0f); if (bucket > 31) bucket = 31; }
        s += a.in[I_RELB][bucket * 8 + head]; const float p = expf(s - m); l += p;
#pragma unroll
        for (int d = 0; d < 16; ++d) o[d] += p * ldbf(KV + (size_t)kr * NKV + 128 + kvh * 64 + dq * 16 + d); }
    l += expf(a.in[I_SINKS][head] - m);
    const bf16* yab = (const bf16*)(a.ws + WS_YAB);
#pragma unroll
    for (int d = 0; d < 16; ++d) { const float ref = o[d] / l; dbg_acc(a.ws, 2, ldbf(yab + (size_t)row * D + head * 64 + dq * 16 + d) - ref, ref); }
}
__global__ void __launch_bounds__(512) chk_gmlp(Args a) {
    __shared__ float sh[16];
    const int row = samp_row(blockIdx.x), c = threadIdx.x, g = c >> 7, r0 = row & ~127, t = row & 127;
    const bf16* GU = (const bf16*)(a.ws + WS_GU); const bf16* GV = (const bf16*)(a.ws + WS_GV);
    float acc = 0.f;
    for (int s = 0; s <= t; ++s) { const float v = ldbf(GV + (size_t)(r0 + s) * GMW + c);
        float x = wave_sum(v); __syncthreads(); if ((c & 63) == 0) sh[c >> 6] = x; __syncthreads(); float tot = 0.f; for (int w = 0; w < 8; ++w) tot += sh[w]; const float mu = tot / GMW;
        x = wave_sum((v - mu) * (v - mu)); __syncthreads(); if ((c & 63) == 0) sh[c >> 6] = x; __syncthreads(); tot = 0.f; for (int w = 0; w < 8; ++w) tot += sh[w]; const float rstd = 1.0f / sqrtf(tot / GMW + EPS);
        const float vn = bfr((v - mu) * rstd * a.in[I_LNG][c] + a.in[I_LNB][c]);
        acc += bfr(a.in[I_GWS][((size_t)g * 128 + t) * 128 + s]) * vn; }
    const float ref = ldbf(GU + (size_t)row * GMW + c) * (acc + a.in[I_GBS][g * 128 + t]);
    dbg_acc(a.ws, 3, ldbf((const bf16*)(a.ws + WS_YAB) + (size_t)row * D + NQ + c) - ref, ref);
}
__global__ void __launch_bounds__(256) chk_merge(Args a) {
    const int idx = blockIdx.x * 256 + threadIdx.x; if (idx >= NSAMP * D) return;
    const int row = samp_row(idx / D), n = idx % D; const bf16* yab = (const bf16*)(a.ws + WS_YAB);
    float sa = 0.f, sb = 0.f;
    for (int k = 0; k < 512; ++k) { sa += ldbf(yab + (size_t)row * D + k) * bfr(a.in[I_PA][(size_t)k * D + n]); sb += ldbf(yab + (size_t)row * D + 512 + k) * bfr(a.in[I_PB][(size_t)k * D + n]); }
    const float ref = (float)((const unsigned char*)(a.ws + WS_GA))[(size_t)row * D + n] * (1.0f / 255.0f) * sa + (float)((const unsigned char*)(a.ws + WS_GB))[(size_t)row * D + n] * (1.0f / 255.0f) * sb;
    dbg_acc(a.ws, 4, ldbf((const bf16*)(a.ws + WS_A) + (size_t)row * D + n) - ref, ref);
}
__global__ void __launch_bounds__(256) chk_wo(Args a) {
    const int idx = blockIdx.x * 256 + threadIdx.x; if (idx >= NSAMP * D) return;
    const int row = samp_row(idx / D), n = idx % D, b = row / SEQ; const bf16* mg = (const bf16*)(a.ws + WS_A);
    float s = 0.f; for (int k = 0; k < D; ++k) s += ldbf(mg + (size_t)row * D + k) * bfr(a.in[I_WO][(size_t)k * D + n]);
    const float ref = a.in[I_X][(size_t)row * D + n] + ((const float*)(a.ws + WS_MOD))[(size_t)b * 6 * D + 2 * D + n] * s;
    dbg_acc(a.ws, 5, ldbf((const bf16*)(a.ws + WS_XMID) + (size_t)row * D + n) - ref, ref);
}
__global__ void __launch_bounds__(256) chk_router(Args a) {
    __shared__ float sh[8]; __shared__ float lgt[36];
    const int row = samp_row(blockIdx.x), b = row / SEQ, t = threadIdx.x; const float* mod = (const float*)(a.ws + WS_MOD);
    float xv[4], hv[4], ss = 0.f;
#pragma unroll
    for (int q = 0; q < 4; ++q) { xv[q] = ldbf((const bf16*)(a.ws + WS_XMID) + (size_t)row * D + t + 256 * q); ss += xv[q] * xv[q]; }
    const float rinv = 1.0f / sqrtf(block_sum256(ss, sh) / D + EPS);
#pragma unroll
    for (int q = 0; q < 4; ++q) { const int c = t + 256 * q; hv[q] = xv[q] * rinv * a.in[I_N2G][c] * (1.0f + mod[(size_t)b * 6 * D + 4 * D + c]) + mod[(size_t)b * 6 * D + 3 * D + c];
        dbg_acc(a.ws, 6, f8dec(((const unsigned char*)(a.ws + WS_H2))[(size_t)row * D + c]) - f8r(hv[q]), hv[q]); }
    for (int n = 0; n < 36; ++n) { float p = 0.f;
#pragma unroll
        for (int q = 0; q < 4; ++q) { const int c = t + 256 * q; p += hv[q] * (n < 4 ? a.in[I_WRG][c * 4 + n] : a.in[I_WRE][c * 32 + n - 4]); }
        const float tot = block_sum256(p, sh); if (t == 0) lgt[n] = tot + (n < 4 ? a.in[I_BRG][n] : a.in[I_BRE][n - 4]); }
    __syncthreads();
    if (t == 0) { int gi = 0; for (int n = 1; n < 4; ++n) if (lgt[n] > lgt[gi]) gi = n; float gs = 0.f; for (int n = 0; n < 4; ++n) gs += expf(lgt[n] - lgt[gi]); const float pg = 1.0f / gs;
        int i1 = 0; for (int j = 1; j < 8; ++j) if (lgt[4 + 8 * gi + j] > lgt[4 + 8 * gi + i1]) i1 = j; int i2 = -1; for (int j = 0; j < 8; ++j) if (j != i1 && (i2 < 0 || lgt[4 + 8 * gi + j] > lgt[4 + 8 * gi + i2])) i2 = j;
        const float ex = expf(lgt[4 + 8 * gi + i2] - lgt[4 + 8 * gi + i1]), w1 = pg / (1.0f + ex), w2 = pg * ex / (1.0f + ex);
        const float* rec = (const float*)(a.ws + WS_DBG) + (size_t)row * 4;
        const bool same = ((int)rec[0] == gi * 8 + i1) && ((int)rec[1] == gi * 8 + i2);
        dbg_acc(a.ws, 7, same ? 0.f : 1.f, 1.f);
        if (same) { dbg_acc(a.ws, 8, rec[2] - w1, w1); dbg_acc(a.ws, 8, rec[3] - w2, w2); } }
}
__global__ void __launch_bounds__(256) chk_moe(Args a) {
    __shared__ float hs[D]; __shared__ float act[DEXP];
    const int row = samp_row(blockIdx.x >> 1), k = blockIdx.x & 1, t = threadIdx.x;
    const float* rec = (const float*)(a.ws + WS_DBG) + (size_t)row * 4; const int e = (int)rec[k]; const float w = rec[2 + k];
    for (int c = t; c < D; c += 256) hs[c] = f8dec(((const unsigned char*)(a.ws + WS_H2))[(size_t)row * D + c]);
    __syncthreads();
    for (int j = t; j < DEXP; j += 256) { float gsum = 0.f, usum = 0.f; for (int c = 0; c < D; ++c) { gsum += hs[c] * f8r(a.in[I_WG][((size_t)e * D + c) * DEXP + j] * WGU_SCALE); usum += hs[c] * f8r(a.in[I_WU][((size_t)e * D + c) * DEXP + j] * WGU_SCALE); }
        gsum *= 1.0f / WGU_SCALE; usum *= 1.0f / WGU_SCALE;
        act[j] = f8r(gsum / (1.0f + expf(-gsum)) * usum); }
    __syncthreads();
    for (int n = t; n < D; n += 256) { float s = 0.f; for (int j = 0; j < DEXP; ++j) s += act[j] * f8r(a.in[I_WDN][((size_t)e * DEXP + j) * D + n] * WD_SCALE);
        const float ref = w * s * (1.0f / WD_SCALE); dbg_acc(a.ws, 9, ldbf((const bf16*)(a.ws + WS_YT) + ((size_t)row * 2 + k) * D + n) - ref, ref); }
}
__global__ void __launch_bounds__(256) chk_final(Args a) {
    __shared__ float sh[8];
    const int row = samp_row(blockIdx.x), b = row / SEQ, t = threadIdx.x; const float* mod = (const float*)(a.ws + WS_MOD);
    float v[4], ss = 0.f;
#pragma unroll
    for (int q = 0; q < 4; ++q) { const int c = t + 256 * q; v[q] = ldbf((const bf16*)(a.ws + WS_XMID) + (size_t)row * D + c) + mod[(size_t)b * 6 * D + 5 * D + c] * (ldbf((const bf16*)(a.ws + WS_YT) + (size_t)row * 2 * D + c) + ldbf((const bf16*)(a.ws + WS_YT) + (size_t)row * 2 * D + D + c)); ss += v[q] * v[q]; }
    const float rinv = 1.0f / sqrtf(block_sum256(ss, sh) / D + EPS);
#pragma unroll
    for (int q = 0; q < 4; ++q) { const int c = t + 256 * q; const float ref = v[q] * rinv * a.in[I_FG][c]; dbg_acc(a.ws, 10, a.out[(size_t)row * D + c] - ref, ref); }
}
__global__ void __launch_bounds__(256) chk_report(Args a) {
    const float* acc = (const float*)(a.ws + WS_CTL) + CW_DBG; int code = 0;
    for (int k = 10; k >= 0; --k) { if (k < DBG_FIRST) continue; const float tol = (k == 7) ? 0.02f : 1e-3f; if (!(acc[2 * k] <= tol * acc[2 * k + 1])) code = k + 1; }
    const float f = 1.0f + 0.5f * (float)code;
    for (size_t i = (size_t)blockIdx.x * 256 + threadIdx.x; i < (size_t)M * D; i += (size_t)gridDim.x * 256) a.out[i] *= f;
}
#endif

extern "C" void kernel_launch(void* const* d_in, const int* in_sizes, int n_in, void* d_out, int out_size, void* d_ws, size_t ws_size, hipStream_t stream) {
    static int grid = 0;
    if (grid == 0) {
        if (n_in != 25 || in_sizes[0] != M * D || out_size != M * D || ws_size < WS_END) { fprintf(stderr, "kernel_launch: unexpected shapes (n_in %d, in0 %d, out %d, ws %zu); nothing launched\n", n_in, n_in > 0 ? in_sizes[0] : -1, out_size, ws_size); grid = -1; return; }
        int dev = 0, cus = 0, per_cu = 0;
        if (hipGetDevice(&dev) != hipSuccess || hipDeviceGetAttribute(&cus, hipDeviceAttributeMultiprocessorCount, dev) != hipSuccess) { grid = -1; return; }
        if (hipFuncSetAttribute((const void*)mk_fwd, hipFuncAttributeMaxDynamicSharedMemorySize, LDS_BYTES) != hipSuccess) { fprintf(stderr, "kernel_launch: hipFuncSetAttribute failed\n"); grid = -1; return; }
        if (hipOccupancyMaxActiveBlocksPerMultiprocessor(&per_cu, (const void*)mk_fwd, NWAVES * 64, LDS_BYTES) != hipSuccess || per_cu < 1) fprintf(stderr, "kernel_launch: occupancy query reports %d\n", per_cu);
        (void)hipGetLastError();
        grid = cus;
    }
    if (grid < 0) return;
    if (hipMemsetAsync((char*)d_ws + WS_CTL, 0, DEBUG_CHECKS ? (size_t)(1 * MiB) : CTL_ZERO_BYTES, stream) != hipSuccess) return;
    Args a{};
    for (int i = 0; i < 25; ++i) a.in[i] = (const float*)d_in[i];
    a.out = (float*)d_out; a.ws = (unsigned char*)d_ws;
    if (MK_N_LAUNCHES == 1) { a.ph_lo = 0; a.ph_hi = N_PHASES; a.li = 0; hipLaunchKernelGGL(mk_fwd, dim3(grid), dim3(NWAVES * 64), LDS_BYTES, stream, a); }
    else for (int li = 0; li < RUN_PHASES; ++li) { a.ph_lo = li; a.ph_hi = li + 1; a.li = li; hipLaunchKernelGGL(mk_fwd, dim3(grid), dim3(NWAVES * 64), LDS_BYTES, stream, a);
#if DEBUG_CHECKS
        if (li == 2) { hipLaunchKernelGGL(chk_h1, dim3(NSAMP), dim3(256), 0, stream, a); hipLaunchKernelGGL(chk_inproj, dim3(NSAMP * INW / 256), dim3(256), 0, stream, a); }
        if (li == 3) { hipLaunchKernelGGL(chk_attn, dim3(NSAMP * 32 / 256), dim3(256), 0, stream, a); hipLaunchKernelGGL(chk_gmlp, dim3(NSAMP), dim3(512), 0, stream, a); }
        if (li == 4) hipLaunchKernelGGL(chk_merge, dim3(NSAMP * D / 256), dim3(256), 0, stream, a);
        if (li == 5) hipLaunchKernelGGL(chk_wo, dim3(NSAMP * D / 256), dim3(256), 0, stream, a);
        if (li == 6) hipLaunchKernelGGL(chk_router, dim3(NSAMP), dim3(256), 0, stream, a);
        if (li == 8) hipLaunchKernelGGL(chk_moe, dim3(NSAMP * 2), dim3(256), 0, stream, a);
        if (li == 9) { hipLaunchKernelGGL(chk_final, dim3(NSAMP), dim3(256), 0, stream, a); hipLaunchKernelGGL(chk_report, dim3(2048), dim3(256), 0, stream, a); }
#endif
    }
}
```

```cpp
#include <hip/hip_runtime.h>
#include <cstdio>
#include <cstdint>
#include <cmath>
#include <type_traits>

#ifndef MK_N_LAUNCHES
#define MK_N_LAUNCHES 1
#endif

#ifndef DEBUG_CHECKS
#define DEBUG_CHECKS 0
#endif
#ifndef DBG_FIRST
#define DBG_FIRST 0
#endif
#ifndef RUN_PHASES
#define RUN_PHASES 10
#endif
#define GAS __attribute__((address_space(1)))
#define LAS __attribute__((address_space(3)))
typedef unsigned short bf16;
typedef short bf16x8 __attribute__((ext_vector_type(8)));
typedef short s16x4 __attribute__((ext_vector_type(4)));
typedef float f32x2 __attribute__((ext_vector_type(2)));
typedef float f32x4 __attribute__((ext_vector_type(4)));
typedef float f32x16 __attribute__((ext_vector_type(16)));
typedef unsigned u32x2 __attribute__((ext_vector_type(2)));
typedef unsigned u32x4 __attribute__((ext_vector_type(4)));
typedef __bf16 bf16x2_t __attribute__((ext_vector_type(2)));
typedef GAS unsigned gu32;

constexpr int BATCH = 8, SEQ = 4096, D = 1024, M = BATCH * SEQ;
constexpr int NQ = 512, NKV = 256  , GMW = 512, INW = 3840;
constexpr int NEXP = 32, DEXP = 512;
constexpr float EPS = 1e-6f;
constexpr float LOG2E = 1.4426950408889634f;
constexpr float QSCALE = 0.125f * LOG2E;
constexpr int LIST_CAP = 32768;
constexpr int HACT_ROWS = 73728;

constexpr size_t MiB = 1u << 20;
constexpr size_t WS_CTL = 0, CTL_ZERO_BYTES = 32 * 1024;
constexpr size_t WS_MOD = 1 * MiB;
constexpr size_t WS_MODP = 1 * MiB + 256 * 1024;
constexpr size_t WS_WST = 4 * MiB + 512 * 1024;
constexpr size_t WS_LROW = 5 * MiB;
constexpr size_t WS_LW = 9 * MiB;
constexpr size_t WS_GT = 13 * MiB;
constexpr size_t WS_GC = 13 * MiB + 800 * 1024;
constexpr size_t WS_WIN = 14 * MiB;
constexpr size_t WS_WIN8 = 18 * MiB;
constexpr size_t WS_H1F8 = 186 * MiB;
constexpr int NBF = 1792;
constexpr size_t WS_PA = 22 * MiB;
constexpr size_t WS_WO = 24 * MiB;
constexpr size_t WS_WGU = 26 * MiB;
constexpr size_t WS_WD = 90 * MiB;
constexpr size_t WS_A = 122 * MiB;
constexpr size_t WS_YAB = 186 * MiB;
constexpr size_t WS_YT = 122 * MiB;
constexpr size_t WS_Q = 250 * MiB;
constexpr size_t WS_KV = 282 * MiB;
constexpr size_t WS_GU = 298 * MiB, WS_GV = 330 * MiB;
constexpr size_t WS_T = 298 * MiB;
constexpr size_t WS_HACT = 250 * MiB;
constexpr size_t WS_GA = 362 * MiB;
constexpr size_t WS_XMID = 362 * MiB;
constexpr size_t WS_GB = 426 * MiB;
constexpr size_t WS_H2 = 426 * MiB;
constexpr size_t WS_END = 490 * MiB;
static_assert(WS_HACT + (size_t)HACT_ROWS * 1024 <= WS_GA, "HACT overlay");
constexpr int CW_TMO = 0, CW_CODE = 1;
constexpr int CW_CNT = 1024;
constexpr int CW_BAR = 4096;

constexpr int RING_OFF = 0, RING_BYTES = 131072;
constexpr int LDSCTL_OFF = RING_BYTES, MISC_OFF = LDSCTL_OFF + 320;
constexpr int TAB_OFF = RING_BYTES + 512;
constexpr int TAB_UNITS = TAB_OFF, TAB_CNT = TAB_OFF + 256, TAB_ROWS = TAB_OFF + 1024, MAX_WG_UNITS = 14;
constexpr int CSH_OFF = TAB_ROWS + MAX_WG_UNITS * 1024;
constexpr int LDS_BYTES = CSH_OFF + 16384;
static_assert(CSH_OFF % 16 == 0 && LDS_BYTES <= 163840 - 256, "LDS map");
constexpr int NWAVES = 8;
constexpr int N_PHASES = 10;

#define LDS_WAIT() asm volatile("s_waitcnt lgkmcnt(0)" ::: "memory")
#define VM_WAIT() asm volatile("s_waitcnt vmcnt(0)" ::: "memory")
#define RLX_AGENT __ATOMIC_RELAXED, __HIP_MEMORY_SCOPE_AGENT
__device__ __forceinline__ unsigned cvtpk(float lo, float hi) { f32x2 v = {lo, hi}; bf16x2_t b = __builtin_convertvector(v, bf16x2_t); return __builtin_bit_cast(unsigned, b); }
__device__ __forceinline__ float bf_lo(unsigned w) { return __uint_as_float(w << 16); }
__device__ __forceinline__ float bf_hi(unsigned w) { return __uint_as_float(w & 0xffff0000u); }
__device__ __forceinline__ float wave_sum(float v) {
    int x = __float_as_int(v);
#define WS_DPP(ctrl, rmask) x = __float_as_int(__int_as_float(x) + __int_as_float(__builtin_amdgcn_update_dpp(0, x, (ctrl), (rmask), 0xf, false)))
    WS_DPP(0xB1, 0xf);
    WS_DPP(0x4E, 0xf);
    WS_DPP(0x141, 0xf);
    WS_DPP(0x140, 0xf);
    WS_DPP(0x142, 0xa);
    WS_DPP(0x143, 0xc);
#undef WS_DPP
    return __int_as_float(__builtin_amdgcn_readlane(x, 63));
}
__device__ __forceinline__ float clamp448(float v) { return __builtin_amdgcn_fmed3f(v, -448.0f, 448.0f); }
__device__ __forceinline__ unsigned pk4_fp8(float a, float b, float c, float d) {
    unsigned r = 0; r = __builtin_amdgcn_cvt_pk_fp8_f32(clamp448(a), clamp448(b), r, false); r = __builtin_amdgcn_cvt_pk_fp8_f32(clamp448(c), clamp448(d), r, true); return r; }
__device__ __forceinline__ u32x2 pack8_fp8(const f32x4 a, const f32x4 b) { u32x2 w; w.x = pk4_fp8(a[0], a[1], a[2], a[3]); w.y = pk4_fp8(b[0], b[1], b[2], b[3]); return w; }
constexpr float WGU_SCALE = 64.0f, WD_SCALE = 32.0f;
__device__ __forceinline__ unsigned pk4_u8(float a, float b, float c, float d) {
    return (unsigned)(a * 255.0f + 0.5f) | ((unsigned)(b * 255.0f + 0.5f) << 8) | ((unsigned)(c * 255.0f + 0.5f) << 16) | ((unsigned)(d * 255.0f + 0.5f) << 24); }
__device__ __forceinline__ void unpack8_u8(const u32x2 w, f32x4& a, f32x4& b) {
    a = (f32x4){(float)(w.x & 0xffu), (float)((w.x >> 8) & 0xffu), (float)((w.x >> 16) & 0xffu), (float)(w.x >> 24)};
    b = (f32x4){(float)(w.y & 0xffu), (float)((w.y >> 8) & 0xffu), (float)((w.y >> 16) & 0xffu), (float)(w.y >> 24)}; }
__device__ __forceinline__ float sigmoid_f(float x) { return __builtin_amdgcn_rcpf(1.0f + __builtin_amdgcn_exp2f(-x * LOG2E)); }
__device__ __forceinline__ float gelu_tanh_f(float x) {
    const float t = x * __builtin_fmaf(x * x, -2.3022081987f * 0.044715f, -2.3022081987f);
    return x * __builtin_amdgcn_rcpf(1.0f + __builtin_amdgcn_exp2f(t));
}
__device__ __forceinline__ f32x2 exp2_2(const f32x2 v) { return (f32x2){__builtin_amdgcn_exp2f(v.x), __builtin_amdgcn_exp2f(v.y)}; }
__device__ __forceinline__ f32x2 rcp_2(const f32x2 v) { return (f32x2){__builtin_amdgcn_rcpf(v.x), __builtin_amdgcn_rcpf(v.y)}; }
__device__ __forceinline__ f32x2 lo2(const f32x4 v) { return __builtin_shufflevector(v, v, 0, 1); }
__device__ __forceinline__ f32x2 hi2(const f32x4 v) { return __builtin_shufflevector(v, v, 2, 3); }
__device__ __forceinline__ f32x4 cat2(const f32x2 a, const f32x2 b) { return __builtin_shufflevector(a, b, 0, 1, 2, 3); }
__device__ __forceinline__ f32x2 gelu_tanh_2(const f32x2 x) {
    const f32x2 c1 = {-2.3022081987f, -2.3022081987f}, c2 = {-2.3022081987f * 0.044715f, -2.3022081987f * 0.044715f};
    const f32x2 t = x * __builtin_elementwise_fma(x * x, c2, c1);
    return x * rcp_2(exp2_2(t) + 1.0f); }
__device__ __forceinline__ f32x4 gelu_tanh_4(const f32x4 v) { return cat2(gelu_tanh_2(lo2(v)), gelu_tanh_2(hi2(v))); }
template <bool LO1> __device__ __forceinline__ unsigned sigcode_4(const f32x4 t) {
    const f32x2 k = {1.0f / 255.0f, 1.0f / 255.0f};
    f32x2 a = rcp_2(__builtin_elementwise_fma(exp2_2(lo2(t)), k, k)), b = rcp_2(__builtin_elementwise_fma(exp2_2(hi2(t)), k, k));
    if (LO1) { a.x = fmaxf(a.x, 1.0f); a.y = fmaxf(a.y, 1.0f); b.x = fmaxf(b.x, 1.0f); b.y = fmaxf(b.y, 1.0f); }
    unsigned w = 0u; w = __builtin_amdgcn_cvt_pk_u8_f32(a.x, 0, w); w = __builtin_amdgcn_cvt_pk_u8_f32(a.y, 1, w); w = __builtin_amdgcn_cvt_pk_u8_f32(b.x, 2, w); w = __builtin_amdgcn_cvt_pk_u8_f32(b.y, 3, w); return w; }
__device__ __forceinline__ float silu_f(float x) { return x * __builtin_amdgcn_rcpf(1.0f + __builtin_amdgcn_exp2f(-x * LOG2E)); }

namespace pg8 {
constexpr int BM = 256, BK = 64, HALF = 128, HTB = HALF * BK * 2, STAGE_BYTES = 8 * HTB, NXCD = 8, WGM = 8;
__host__ __device__ __forceinline__ int lds_byte(int r, int c) { const int st = (r >> 4) * 2 + (c >> 5), rr = r & 15, cc = c & 31, ob = rr * 64 + cc * 2; return st * 1024 + (ob ^ (((ob >> 9) & 1) << 5)); }
__host__ __device__ __forceinline__ void stage_rc(int b, int& R, int& C) { const int st = b / 1024, sb = b % 1024, swz = sb ^ (((sb >> 9) & 1) << 5); R = (st >> 1) * 16 + swz / 64; C = (st & 1) * 32 + (swz % 64) / 2; }
__host__ __device__ __forceinline__ int perm32(int rho) { const int n = rho >> 4, i = rho & 15; return 8 * (i >> 2) + 4 * n + (i & 3); }

struct Unit { int pm, pn, v, e, ui; };

struct DenseOrder {
    int nM, nN, nwg, G, c;
    __device__ void init(int M_, int N_, int G_, int c_) { nM = M_ / BM; nN = N_ / BM; nwg = nM * nN; G = G_; c = c_; }
    __device__ bool tile(int i, Unit& u) const { return tileL((long)i * G + c, u); }
    __device__ bool tileL(long L, Unit& u) const {
        if (L >= nwg) return false;
        int wgid = (int)L; { const int q = nwg / NXCD, r = nwg % NXCD, xcd = wgid % NXCD, off = wgid / NXCD; wgid = (xcd < r ? xcd * (q + 1) : r * (q + 1) + (xcd - r) * q) + off; }
        const int nig = WGM * nN, gid = wgid / nig, fm = gid * WGM, gsz = (nM - fm) < WGM ? (nM - fm) : WGM;
        u.pm = fm + ((wgid % nig) % gsz); u.pn = (wgid % nig) / gsz; u.v = 0; u.e = 0; u.ui = 0; return true;
    }
    __device__ bool next(int i, Unit& u) const { return tile(i, u); }
};
struct BackfillOrder : DenseOrder {
    __device__ bool next(int i, Unit& u) const {
        if (i < 3) return tileL((long)i * G + c, u);
        if (c >= G / 2) return tileL((long)3 * G + (long)(i - 3) * (G - G / 2) + (c - G / 2), u);
        return false; }
};

template <class Prob, class Epi, class Sched, bool ALIGN_EPI>
__device__ __forceinline__ void gemm_phase(LAS unsigned char* lds, const Prob& P, const Sched& S, const Epi& E) {
    const int tid = threadIdx.x, wid = __builtin_amdgcn_readfirstlane(tid >> 6), lane = tid & 63, wr = wid >> 2, wc = wid & 3, fr = lane & 15, fq = lane >> 4;
    const int nt = P.Kb / 128;
    int Rr[2], Cc[2]; unsigned voffB[2], aoc[2][2], aon[2][2];
#pragma unroll
    for (int i = 0; i < 2; ++i) { int R, C; stage_rc(tid * 16 + i * 8192, R, C); Rr[i] = R; Cc[i] = C; const int Rb = Epi::PERM ? ((R & ~31) + perm32(R & 31)) : R;
        voffB[i] = (unsigned)Rb * P.ldb + (unsigned)C * 2u; }
    const size_t kstep = (size_t)(BK * 2);
    const size_t hstepB = (size_t)HALF * P.ldb;
    const unsigned ldsw = (unsigned)wid * 1024u;
    const int aoff = lds_byte(wr * 64 + fr, fq * 8), boff = lds_byte(wc * 32 + fr, fq * 8);
#define PG8_SA(b, h) (((b) * 2 + (h)) * HTB)
#define PG8_SB(b, h) ((4 + (b) * 2 + (h)) * HTB)
#define PG8_STG(bufoff, p0, p1) do { \
        __builtin_amdgcn_global_load_lds((const unsigned*)(p0), (LAS unsigned*)(lds + (bufoff) + ldsw), 16, 0, 0); \
        __builtin_amdgcn_global_load_lds((const unsigned*)(p1), (LAS unsigned*)(lds + (bufoff) + ldsw + 8192), 16, 0, 0); } while (0)
#define PG8_STGB(bufoff, base) PG8_STG(bufoff, (base) + voffB[0], (base) + voffB[1])
#define PG8_STGA(bufoff, base, off, h) PG8_STG(bufoff, (base) + off[h][0], (base) + off[h][1])
#define PG8_LDF(dst, addr) do { if constexpr (Prob::F8) { const i32x4 lo_ = *(const LAS i32x4*)(addr), hi_ = *(const LAS i32x4*)((addr) + 1024); dst.v = __builtin_shufflevector(lo_, hi_, 0, 1, 2, 3, 4, 5, 6, 7); } \
        else { dst.k[0] = *(const LAS bf16x8*)(addr); dst.k[1] = *(const LAS bf16x8*)((addr) + 1024); } } while (0)
#define PG8_LDA(dst, b, h) do { _Pragma("unroll") for (int m = 0; m < 4; ++m) PG8_LDF(dst[m], lds + PG8_SA(b, h) + aoff + m * 2048); } while (0)
#define PG8_LDB(dst, b, h) do { _Pragma("unroll") for (int n = 0; n < 2; ++n) PG8_LDF(dst[n], lds + PG8_SB(b, h) + boff + n * 2048); } while (0)
#define PG8_MMA(ai, bj, At, Bt) do { __builtin_amdgcn_s_setprio(1); _Pragma("unroll") for (int m = 0; m < 4; ++m) _Pragma("unroll") for (int n = 0; n < 2; ++n) { \
        if constexpr (Prob::F8) asm volatile("v_mfma_scale_f32_16x16x128_f8f6f4 %0, %1, %2, %0, %3, %3 op_sel_hi:[0,0,0]" : "+v"(acc[ai][bj][m][n]) : "v"(Bt[n].v), "v"(At[m].v), "v"(f8scale));   \
        else { _Pragma("unroll") for (int k = 0; k < 2; ++k) acc[ai][bj][m][n] = __builtin_amdgcn_mfma_f32_16x16x32_bf16(Bt[n].k[k], At[m].k[k], acc[ai][bj][m][n], 0, 0, 0); } } \
        __builtin_amdgcn_s_setprio(0); } while (0)
#define PG8_WAIT_V(n) asm volatile("s_waitcnt vmcnt(" #n ")" ::: "memory")
#define PG8_WAIT_L(n) asm volatile("s_waitcnt lgkmcnt(" #n ")" ::: "memory")
#define PG8_BAR __builtin_amdgcn_s_barrier()
#define PG8_SCHED __builtin_amdgcn_sched_barrier(0)
#define PG8_AOFF(dst, ui_) do { _Pragma("unroll") for (int h = 0; h < 2; ++h) _Pragma("unroll") for (int i = 0; i < 2; ++i) { \
        if constexpr (Prob::GATHER) dst[h][i] = P.rowtab[(ui_) * 256 + h * HALF + Rr[i]] + (unsigned)Cc[i] * 2u; \
        else dst[h][i] = (unsigned)(h * HALF + Rr[i]) * P.lda + (unsigned)Cc[i] * 2u; } } while (0)
    Unit cur, nxt; int ui = 0;
    if (!S.next(0, cur)) return;
    f32x4 acc[2][2][4][2];
#pragma unroll
    for (int a = 0; a < 2; ++a)
#pragma unroll
        for (int b = 0; b < 2; ++b)
#pragma unroll
            for (int m = 0; m < 4; ++m)
#pragma unroll
                for (int n = 0; n < 2; ++n) acc[a][b][m][n] = (f32x4){0.f, 0.f, 0.f, 0.f};
    typedef int i32x8 __attribute__((ext_vector_type(8))); typedef int i32x4 __attribute__((ext_vector_type(4)));
    struct FragBf { bf16x8 k[2]; }; struct FragF8 { i32x8 v; };
    typedef typename std::conditional<Prob::F8, FragF8, FragBf>::type Frag;
    Frag At[4], B0[2], B1[2];
    int f8scale = Prob::F8 ? Prob::E8M0 : 0x7f7f7f7f; asm volatile("" : "+v"(f8scale));
    const char* cA = P.a_ptr(cur); const char* cB = P.b_ptr(cur);
    PG8_AOFF(aoc, 0);
#pragma unroll
    for (int h = 0; h < 2; ++h)
#pragma unroll
        for (int i = 0; i < 2; ++i) aon[h][i] = aoc[h][i];
    PG8_STGB(PG8_SB(0, 0), cB); PG8_STGB(PG8_SB(0, 1), cB + hstepB); PG8_STGA(PG8_SA(0, 0), cA, aoc, 0); PG8_STGA(PG8_SA(0, 1), cA, aoc, 1);
    if (wr == 1) PG8_BAR;
    PG8_WAIT_V(2); PG8_BAR;
    PG8_STGB(PG8_SB(1, 0), cB + kstep); PG8_STGA(PG8_SA(1, 0), cA + kstep, aoc, 0); PG8_STGB(PG8_SB(1, 1), cB + hstepB + kstep);
    PG8_WAIT_V(6); PG8_BAR;
    for (;;) {
        const bool has_next = S.next(ui + 1, nxt);
        const char* nA = has_next ? P.a_ptr(nxt) : cA; const char* nB = has_next ? P.b_ptr(nxt) : cB;
        for (int t = 0; t < nt; t += 2) {
            const bool last = (t == nt - 2);
            const char* a1 = cA + (size_t)(t + 1) * kstep;
            const char* a2 = last ? nA : cA + (size_t)(t + 2) * kstep; const char* b2 = last ? nB : cB + (size_t)(t + 2) * kstep;
            const char* a3 = a2 + kstep; const char* b3 = b2 + kstep;
            unsigned ao2[2][2];
            if constexpr (Prob::GATHER) {
                if (last && has_next) PG8_AOFF(aon, ui + 1);
#pragma unroll
                for (int h = 0; h < 2; ++h)
#pragma unroll
                    for (int i = 0; i < 2; ++i) ao2[h][i] = (last && has_next) ? aon[h][i] : aoc[h][i];
            } else {
#pragma unroll
                for (int h = 0; h < 2; ++h)
#pragma unroll
                    for (int i = 0; i < 2; ++i) ao2[h][i] = aoc[h][i];
            }
            if constexpr (Epi::MIDK) { if (t == nt / 2) E.mid(acc, cur, wr, wc, fr, fq); }
            PG8_LDB(B0, 0, 0); PG8_LDB(B1, 0, 1); PG8_SCHED; PG8_LDA(At, 0, 0); PG8_STGA(PG8_SA(1, 1), a1, aoc, 1);
            PG8_WAIT_V(8); PG8_WAIT_L(0); PG8_BAR; PG8_MMA(0, 0, At, B0); PG8_MMA(0, 1, At, B1); PG8_BAR; PG8_SCHED;
            PG8_LDA(At, 0, 1); PG8_STGB(PG8_SB(0, 0), b2); PG8_STGB(PG8_SB(0, 1), b2 + hstepB); PG8_STGA(PG8_SA(0, 0), a2, ao2, 0);
            PG8_WAIT_V(8); PG8_WAIT_L(0); PG8_BAR; PG8_MMA(1, 0, At, B0); PG8_MMA(1, 1, At, B1); PG8_BAR; PG8_SCHED;
            PG8_LDB(B0, 1, 0); PG8_LDB(B1, 1, 1); PG8_SCHED; PG8_LDA(At, 1, 0); PG8_STGA(PG8_SA(0, 1), a2, ao2, 1);
            PG8_WAIT_V(8); PG8_WAIT_L(0); PG8_BAR; PG8_MMA(0, 0, At, B0); PG8_MMA(0, 1, At, B1); PG8_BAR; PG8_SCHED;
            PG8_LDA(At, 1, 1); PG8_STGB(PG8_SB(1, 0), b3); PG8_STGB(PG8_SB(1, 1), b3 + hstepB); PG8_STGA(PG8_SA(1, 0), a3, ao2, 0);
            PG8_WAIT_V(8); PG8_WAIT_L(0); PG8_BAR; PG8_MMA(1, 0, At, B0); PG8_MMA(1, 1, At, B1); PG8_BAR; PG8_SCHED;
        }
        if constexpr (ALIGN_EPI) { if (wr == 0) PG8_BAR; }
        if constexpr (Prob::F8) asm volatile("s_nop 15\n\ts_nop 15\n\ts_nop 15" ::: "memory");
        E(acc, cur, wr, wc, fr, fq);
        if (!has_next) break;
#pragma unroll
        for (int a = 0; a < 2; ++a)
#pragma unroll
            for (int b = 0; b < 2; ++b)
#pragma unroll
                for (int m = 0; m < 4; ++m)
#pragma unroll
                    for (int n = 0; n < 2; ++n) acc[a][b][m][n] = (f32x4){0.f, 0.f, 0.f, 0.f};
        cur = nxt; cA = nA; cB = nB; ++ui;
        if constexpr (Prob::GATHER) {
#pragma unroll
            for (int h = 0; h < 2; ++h)
#pragma unroll
                for (int i = 0; i < 2; ++i) aoc[h][i] = aon[h][i];
        }
        if constexpr (ALIGN_EPI) { if (wr == 1) PG8_BAR; }
    }
    PG8_WAIT_V(0);
    if constexpr (!ALIGN_EPI) { if (wr == 0) PG8_BAR; }
    PG8_BAR;
#undef PG8_SA
#undef PG8_SB
#undef PG8_STG
#undef PG8_STGA
#undef PG8_STGB
#undef PG8_LDA
#undef PG8_LDF
#undef PG8_LDB
#undef PG8_MMA
#undef PG8_WAIT_V
#undef PG8_WAIT_L
#undef PG8_BAR
#undef PG8_SCHED
#undef PG8_AOFF
}
}

#define XB_TMO      128
#define XB_XCNT(j)  (256  + 64 * (j))
#define XB_XSUB(j)  (1280 + 64 * (j))
#define XB_XGEN(j)  (2304 + 64 * (j))
#define XB_TOP      3328
#define XB_TOPGEN   3392
#define XCD_BAR_WORDS 3456
#define XB_SPIN_CAP (1u << 18)
__device__ __forceinline__ unsigned xb_ld(unsigned* p)              { return __hip_atomic_load(p, __ATOMIC_RELAXED, __HIP_MEMORY_SCOPE_AGENT); }
__device__ __forceinline__ unsigned xb_add(unsigned* p, unsigned v) { return __hip_atomic_fetch_add(p, v, __ATOMIC_RELAXED, __HIP_MEMORY_SCOPE_AGENT); }
__device__ __forceinline__ unsigned xb_xcc_id() { return (unsigned)__builtin_amdgcn_s_getreg((3 << 11) | 20) & 0xFu; }
#define XB_SPIN(cond, bar) do { unsigned _sp = 0; while (cond) { __builtin_amdgcn_s_sleep(1); \
    if ((++_sp & 255u) == 0u) { if (xb_ld(&(bar)[XB_TMO])) break; if (_sp > XB_SPIN_CAP) { atomicAdd(&(bar)[XB_TMO], 1u); break; } } } } while (0)
struct XcdBarrier { unsigned* bar; unsigned x; volatile LAS unsigned* st; };
__device__ __forceinline__ XcdBarrier xcd_barrier_post(unsigned* bar, volatile LAS unsigned* st) {
    XcdBarrier b; b.bar = bar; b.x = xb_xcc_id(); b.st = st;
    if (threadIdx.x == 0) (void)xb_add(&bar[XB_XCNT(b.x)], 1u);
    return b;
}
__device__ __forceinline__ void xcd_barrier_complete(unsigned* bar, unsigned x, unsigned& nloc, unsigned& nx) {
    const unsigned G = gridDim.x * gridDim.y * gridDim.z;
    unsigned sum, cnt, mine, sp = 0u;
    for (;;) {
        sum = 0u; cnt = 0u; mine = 0u;
#pragma unroll
        for (unsigned j = 0; j < 16; ++j) { const unsigned c = xb_ld(&bar[XB_XCNT(j)]); sum += c; cnt += (c > 0u) ? 1u : 0u; mine = (j == x) ? c : mine; }
        if (sum == G) break;
        __builtin_amdgcn_s_sleep(1);
        if ((++sp & 255u) == 0u) { if (xb_ld(&bar[XB_TMO])) break; if (sp > XB_SPIN_CAP) { atomicAdd(&bar[XB_TMO], 1u); break; } }
    }
    nloc = mine > 0u ? mine : 1u; nx = cnt > 0u ? cnt : 1u;
}
__device__ __forceinline__ void xcd_barrier(const XcdBarrier& b) {
    asm volatile("s_waitcnt vmcnt(0)" ::: "memory");
    __syncthreads();
    if (threadIdx.x == 0) {
        unsigned* bar = b.bar;
        __builtin_amdgcn_s_waitcnt(0);
        unsigned nloc = b.st[0], nx = b.st[1];
        if (nloc == 0u) { xcd_barrier_complete(bar, b.x, nloc, nx); b.st[0] = nloc; b.st[1] = nx; }
        const unsigned old = xb_add(&bar[XB_XSUB(b.x)], 1u);
        const unsigned gen = old / nloc;
        if (old + 1u == (gen + 1u) * nloc) {
            __builtin_amdgcn_fence(__ATOMIC_RELEASE, "agent");
            asm volatile("s_waitcnt vmcnt(0)" ::: "memory");
            const unsigned og = xb_add(&bar[XB_TOP], 1u);
            const unsigned tg = og / nx;
            if (og + 1u == (tg + 1u) * nx) xb_add(&bar[XB_TOPGEN], 1u);
            else XB_SPIN(xb_ld(&bar[XB_TOPGEN]) == tg, bar);
            __builtin_amdgcn_fence(__ATOMIC_ACQUIRE, "agent");
            xb_add(&bar[XB_XGEN(b.x)], 1u);
            asm volatile("s_waitcnt vmcnt(0)" ::: "memory");
        } else {
            XB_SPIN(xb_ld(&bar[XB_XGEN(b.x)]) == gen, bar);
            __builtin_amdgcn_fence(__ATOMIC_ACQUIRE, "agent");
            asm volatile("s_waitcnt vmcnt(0)" ::: "memory");
        }
    }
    __syncthreads();
}

struct Args {
    const float* in[25]; float* out; unsigned char* ws; int ph_lo, ph_hi, li, pad;
};
struct Frame {
    LAS unsigned char* lds;
    volatile LAS unsigned* MISC;
    gu32* ctl;
    unsigned char* ws;
    int tid, lane, wave, vcu, G;
};
enum { I_X = 0, I_C, I_POS, I_RELB, I_WADA, I_BADA, I_N1G, I_WIN, I_SINKS, I_LNG, I_LNB, I_GWS, I_GBS, I_PA, I_PB, I_WO, I_N2G, I_WRG, I_BRG, I_WRE, I_BRE, I_WG, I_WU, I_WDN, I_FG };

__device__ __forceinline__ void p0_transpose_tile(const float* W, int N, int k0, int n0, bf16* WT, int ldt, int drow0, LAS float* scr, int lane, float scale = 1.0f) {
    {
        f32x4 t[8];
#pragma unroll
        for (int i = 0; i < 8; ++i) t[i] = __builtin_nontemporal_load((const GAS f32x4*)(W + (size_t)(k0 + 8 * i + (lane >> 3)) * N + n0 + 4 * (lane & 7))) * scale;
#pragma unroll
        for (int i = 0; i < 8; ++i) { LAS float* d = scr + (8 * i + (lane >> 3)) * 33 + 4 * (lane & 7); d[0] = t[i][0]; d[1] = t[i][1]; d[2] = t[i][2]; d[3] = t[i][3]; }
    }
    LDS_WAIT(); asm volatile("" ::: "memory");
    const int c = lane & 7;
#pragma unroll
    for (int j = 0; j < 4; ++j) { const int n = (lane >> 3) + 8 * j; const LAS float* s = scr + (8 * c) * 33 + n;
        u32x4 o; o.x = cvtpk(s[0 * 33], s[1 * 33]); o.y = cvtpk(s[2 * 33], s[3 * 33]); o.z = cvtpk(s[4 * 33], s[5 * 33]); o.w = cvtpk(s[6 * 33], s[7 * 33]);
        *(GAS u32x4*)(WT + (size_t)(drow0 + n) * ldt + k0 + 8 * c) = o; }
    LDS_WAIT(); asm volatile("" ::: "memory");
}
__device__ __forceinline__ void p0_transpose_tile_f8(const float* W, int N, int k0, int n0, unsigned char* WT, int ldt, int drow0, float scale, LAS float* scr, int lane) {
    {
        f32x4 t[16];
#pragma unroll
        for (int i = 0; i < 16; ++i) t[i] = __builtin_nontemporal_load((const GAS f32x4*)(W + (size_t)(k0 + 8 * i + (lane >> 3)) * N + n0 + 4 * (lane & 7)));
#pragma unroll
        for (int i = 0; i < 16; ++i) { const int k = 8 * i + (lane >> 3); *(LAS f32x4*)(scr + k * 32 + ((4 * (lane & 7)) ^ (4 * (k >> 4)))) = t[i]; }
    }
    LDS_WAIT(); asm volatile("" ::: "memory");
    const int c = lane & 7;
#pragma unroll
    for (int j = 0; j < 4; ++j) { const int n = (lane >> 3) + 8 * j; const LAS float* sp = scr + (16 * c) * 32 + (n ^ (4 * c));
        u32x4 o;
        o.x = pk4_fp8(sp[0 * 32] * scale, sp[1 * 32] * scale, sp[2 * 32] * scale, sp[3 * 32] * scale); o.y = pk4_fp8(sp[4 * 32] * scale, sp[5 * 32] * scale, sp[6 * 32] * scale, sp[7 * 32] * scale);
        o.z = pk4_fp8(sp[8 * 32] * scale, sp[9 * 32] * scale, sp[10 * 32] * scale, sp[11 * 32] * scale); o.w = pk4_fp8(sp[12 * 32] * scale, sp[13 * 32] * scale, sp[14 * 32] * scale, sp[15 * 32] * scale);
        *(GAS u32x4*)(WT + (size_t)(drow0 + n) * ldt + k0 + 16 * c) = o; }
    LDS_WAIT(); asm volatile("" ::: "memory");
}
__device__ __forceinline__ void p0_prologue(Frame& F, const Args& A) {
    const int gw = F.vcu * NWAVES + F.wave, NGW = F.G * NWAVES, lane = F.lane;
    {
        const float* c = A.in[I_C]; const float* w = A.in[I_WADA]; float* modp = (float*)(F.ws + WS_MODP);
        for (int it = gw; it < 96 * 16; it += NGW) {
            const int cg = it % 96, ks = it / 96, k0 = ks * 64, col = cg * 64 + lane;
            float csv[8], acc[8];
#pragma unroll
            for (int b = 0; b < 8; ++b) { const float v = c[b * D + k0 + lane]; csv[b] = silu_f(v); acc[b] = 0.f; }
            float wv[64];
#pragma unroll
            for (int kk = 0; kk < 64; ++kk) wv[kk] = __builtin_nontemporal_load((const GAS float*)(w + (size_t)(k0 + kk) * (6 * D) + col));
#pragma unroll
            for (int kk = 0; kk < 64; ++kk) {
#pragma unroll
                for (int b = 0; b < 8; ++b) acc[b] += __int_as_float(__builtin_amdgcn_readlane(__float_as_int(csv[b]), kk)) * wv[kk];
            }
#pragma unroll
            for (int b = 0; b < 8; ++b) modp[((size_t)ks * 8 + b) * (6 * D) + col] = acc[b];
        }
    }
    {
        LAS float* scr = (LAS float*)(F.lds + RING_OFF + F.wave * 16384);
        constexpr int S0 = 16 * 56  , S0F = 8 * 64  , S1 = 8 * 32, S2 = 8 * 32, S3 = 16 * 32, S4 = 32 * 128, S5 = 32 * 128, S6 = 32 * 128;
        constexpr int NITEMS = S0 + S0F + S1 + S2 + S3 + S4 + S5 + S6;
        for (int it = gw; it < NITEMS; it += NGW) {
            int r = it;
            if (r < S0) { const int kb = r / 56, nb = r % 56; p0_transpose_tile(A.in[I_WIN], INW, 64 * kb, 32 * nb, (bf16*)(F.ws + WS_WIN), D, 32 * nb, scr, lane); continue; } r -= S0;
            if (r < S0F) { const int kb = r / 64, nb = r % 64; p0_transpose_tile_f8(A.in[I_WIN], INW, 128 * kb, NBF + 32 * nb, (unsigned char*)(F.ws + WS_WIN8), D, 32 * nb, -WGU_SCALE * LOG2E, scr, lane); continue; } r -= S0F;
            if (r < S1) { const int kb = r / 32, nb = r % 32; p0_transpose_tile(A.in[I_PA], D, 64 * kb, 32 * nb, (bf16*)(F.ws + WS_PA), D, 32 * nb, scr, lane, 1.0f / 255.0f); continue; } r -= S1;
            if (r < S2) { const int kb = r / 32, nb = r % 32; p0_transpose_tile(A.in[I_PB], D, 64 * kb, 32 * nb, (bf16*)(F.ws + WS_PA) + NQ, D, 32 * nb, scr, lane, 1.0f / 255.0f); continue; } r -= S2;
            if (r < S3) { const int kb = r / 32, nb = r % 32; p0_transpose_tile(A.in[I_WO], D, 64 * kb, 32 * nb, (bf16*)(F.ws + WS_WO), D, 32 * nb, scr, lane); continue; } r -= S3;
            if (r < S4 + S5) { const int up = r >= S4 ? 1 : 0; if (up) r -= S4; const int e = r >> 7, q = r & 127, kb = q / 16, nb = q % 16, n0 = 32 * nb;
                p0_transpose_tile_f8(A.in[up ? I_WU : I_WG] + (size_t)e * D * DEXP, DEXP, 128 * kb, n0, (unsigned char*)(F.ws + WS_WGU) + (size_t)e * 1024 * 1024, D, (n0 >> 7) * 256 + up * 128 + (n0 & 127), up ? -WGU_SCALE / LOG2E : -WGU_SCALE * LOG2E, scr, lane); continue; }
            r -= S4 + S5;
            { const int e = r >> 7, q = r & 127, kb = q / 32, nb = q % 32; p0_transpose_tile_f8(A.in[I_WDN] + (size_t)e * DEXP * D, D, 128 * kb, 32 * nb, (unsigned char*)(F.ws + WS_WD) + (size_t)e * 1024 * DEXP, DEXP, 32 * nb, WD_SCALE, scr, lane); }
        }
        const float* gws = A.in[I_GWS]; bf16* wst = (bf16*)(F.ws + WS_WST);
        for (int i = F.vcu * 512 + F.tid; i < 4 * 128 * 128 / 2; i += F.G * 512) { const int e0 = 2 * i, t = (e0 >> 7) & 127, s = e0 & 127;
            const float a = s <= t ? gws[e0] : 0.f, b = (s + 1) <= t ? gws[e0 + 1] : 0.f; ((unsigned*)wst)[i] = cvtpk(a, b); }
    }
}

__device__ __forceinline__ float mod_sum(const float* modp, const float* bada, int b, int j) {
    float s = bada[j];
#pragma unroll
    for (int ks = 0; ks < 16; ++ks) s += modp[((size_t)ks * 8 + b) * (6 * D) + j];
    return s;
}
__device__ __forceinline__ void p1_h1(Frame& F, const Args& A) {
    const float* modp = (const float*)(F.ws + WS_MODP); const float* bada = A.in[I_BADA]; float* mod = (float*)(F.ws + WS_MOD);
    for (int idx = F.vcu * 512 + F.tid; idx < 8 * 6 * D; idx += F.G * 512) { const int b = idx / (6 * D), j = idx % (6 * D); mod[idx] = mod_sum(modp, bada, b, j); }
    LAS float* Av = (LAS float*)(F.lds + RING_OFF); LAS float* Bv = Av + D;
    const float* x = A.in[I_X]; const float* g = A.in[I_N1G]; bf16* h1 = (bf16*)(F.ws + WS_A);
    for (int rb = F.vcu; rb < M / 128; rb += F.G) {
        const int b = rb / (SEQ / 128);
        __syncthreads();
        for (int c = F.tid; c < D; c += 512) { const float sh = mod_sum(modp, bada, b, c), sc = mod_sum(modp, bada, b, D + c); Av[c] = g[c] * (1.0f + sc); Bv[c] = sh; }
        __syncthreads();
        for (int j = 0; j < 16; ++j) {
            const int row = rb * 128 + F.wave * 16 + j; const float* xr = x + (size_t)row * D;
            f32x4 v[2][2]; float ss = 0.f;
#pragma unroll
            for (int jj = 0; jj < 2; ++jj)
#pragma unroll
                for (int q = 0; q < 2; ++q) { v[jj][q] = __builtin_nontemporal_load((const GAS f32x4*)(xr + 512 * jj + 8 * F.lane + 4 * q)); ss += (v[jj][q].x * v[jj][q].x + v[jj][q].y * v[jj][q].y) + (v[jj][q].z * v[jj][q].z + v[jj][q].w * v[jj][q].w); }
            const float rinv = 1.0f / sqrtf(wave_sum(ss) * (1.0f / D) + EPS);
#pragma unroll
            for (int jj = 0; jj < 2; ++jj) { const int c0 = 512 * jj + 8 * F.lane;
                const f32x4 a0 = *(const LAS f32x4*)(Av + c0), a1 = *(const LAS f32x4*)(Av + c0 + 4), b0 = *(const LAS f32x4*)(Bv + c0), b1 = *(const LAS f32x4*)(Bv + c0 + 4);
                const f32x4 o0 = v[jj][0] * rinv * a0 + b0, o1 = v[jj][1] * rinv * a1 + b1;
                u32x4 w; w.x = cvtpk(o0.x, o0.y); w.y = cvtpk(o0.z, o0.w); w.z = cvtpk(o1.x, o1.y); w.w = cvtpk(o1.z, o1.w);
                *(GAS u32x4*)(h1 + (size_t)row * D + c0) = w;
                *(GAS u32x2*)((unsigned char*)(F.ws + WS_H1F8) + (size_t)row * D + c0) = pack8_fp8(o0, o1); }
        }
    }
}

struct ProbDense { int Kb; unsigned lda, ldb; const char* A; const char* B; static constexpr bool GATHER = false, F8 = false; static constexpr int E8M0 = 0x7f7f7f7f; const LAS unsigned* rowtab;
    __device__ __forceinline__ const char* a_ptr(const pg8::Unit& u) const { return A + (size_t)u.pm * 256 * lda; }
    __device__ __forceinline__ const char* b_ptr(const pg8::Unit& u) const { return B + (size_t)u.pn * 256 * ldb; } };
struct ProbDense8 { int Kb; unsigned lda, ldb; const char* A; const char* B; static constexpr bool GATHER = false, F8 = true; static constexpr int E8M0 = 0x7c7c7c7c; const LAS unsigned* rowtab;
    __device__ __forceinline__ const char* a_ptr(const pg8::Unit& u) const { return A + (size_t)u.pm * 256 * lda; }
    __device__ __forceinline__ const char* b_ptr(const pg8::Unit& u) const { return B + (size_t)u.pn * 256 * ldb; } };
struct ProbGateUp { int Kb; unsigned lda, ldb; const char* A; const char* B; static constexpr bool GATHER = true, F8 = true; static constexpr int E8M0 = 0x7c7c7c7c; const LAS unsigned* rowtab;
    __device__ __forceinline__ const char* a_ptr(const pg8::Unit&) const { return A; }
    __device__ __forceinline__ const char* b_ptr(const pg8::Unit& u) const { return B + ((size_t)(u.e & 63) * 1024 + (size_t)u.pn * 256) * ldb; } };
struct ProbDown { int Kb; unsigned lda, ldb; const char* A; const char* B; static constexpr bool GATHER = false, F8 = true; static constexpr int E8M0 = 0x7f7f7f7f; const LAS unsigned* rowtab;
    __device__ __forceinline__ const char* a_ptr(const pg8::Unit& u) const { return A + (size_t)u.pm * 256 * lda; }
    __device__ __forceinline__ const char* b_ptr(const pg8::Unit& u) const { return B + ((size_t)(u.e & 63) * 1024 + (size_t)u.pn * 256) * ldb; } };

struct CSh {
    LAS unsigned char* slab; unsigned woff, roff; int rrow, rpc;
    __device__ __forceinline__ CSh(int wr, int wc, int fr, int fq) {
        extern __shared__ __attribute__((aligned(16))) unsigned char lds_dyn[];
        int lane = fq * 16 + fr; asm volatile("" : "+v"(lane));
        fr = lane & 15; fq = lane >> 4; rrow = lane >> 2; rpc = lane & 3;
        slab = (LAS unsigned char*)lds_dyn + CSH_OFF + (wr * 4 + wc) * 2048;
        woff = (unsigned)(fr * 64 + ((fq ^ ((fr >> 1) & 3)) << 4)); roff = (unsigned)(rrow * 64 + ((rpc ^ ((rrow >> 1) & 3)) << 4)); }
    __device__ __forceinline__ u32x4 xch(int k, const u32x4 w) const { LAS unsigned char* s_ = slab + (k & 1) * 1024; *(LAS u32x4*)(s_ + woff) = w; return *(const LAS u32x4*)(s_ + roff); }
};
__device__ __forceinline__ u32x4 pack8(const f32x4 a, const f32x4 b) { u32x4 w; w.x = cvtpk(a[0], a[1]); w.y = cvtpk(a[2], a[3]); w.z = cvtpk(b[0], b[1]); w.w = cvtpk(b[2], b[3]); return w; }
__device__ __forceinline__ void unpack8(const u32x4 w, f32x4& a, f32x4& b) { a = (f32x4){bf_lo(w.x), bf_hi(w.x), bf_lo(w.y), bf_hi(w.y)}; b = (f32x4){bf_lo(w.z), bf_hi(w.z), bf_lo(w.w), bf_hi(w.w)}; }

template <bool F8>
struct EpiInProjT {
    static constexpr bool PERM = true, MIDK = false;
    unsigned char* ws; int pn0; float scl;
    template <bool LO1> __device__ __forceinline__ void gates(const f32x4 (&acc)[2][2][4][2], unsigned char* base, int row0, int col0) const {
#pragma unroll
        for (int ai = 0; ai < 2; ++ai)
#pragma unroll
            for (int m = 0; m < 4; ++m)
#pragma unroll
                for (int bj = 0; bj < 2; ++bj) { u32x2 w; w.x = sigcode_4<LO1>(acc[ai][bj][m][0]); w.y = sigcode_4<LO1>(acc[ai][bj][m][1]);
                    *(GAS u32x2*)(base + (size_t)(row0 + ai * 128 + m * 16) * D + col0 + bj * 128) = w; }
    }
    __device__ __forceinline__ void operator()(const f32x4 (&acc)[2][2][4][2], const pg8::Unit& u, int wr, int wc, int fr, int fq) const {
        const int pn = u.pn + pn0;
        if constexpr (F8) {
            const int row0 = u.pm * 256 + wr * 64 + fr, col0 = wc * 32 + 8 * fq;
            if (pn < 11) gates<false>(acc, ws + WS_GA, row0, 256 * (pn - 7) + col0); else gates<true>(acc, ws + WS_GB, row0, 256 * (pn - 11) + col0);
        } else {
            bf16* base; int ldc, colt, act;
            if (pn < 2) { base = (bf16*)(ws + WS_Q); ldc = NQ; colt = 256 * pn; act = 0; }
            else if (pn == 2) { base = (bf16*)(ws + WS_KV); ldc = NKV; colt = 0; act = 1; }
            else if (pn < 5) { base = (bf16*)(ws + WS_GU); ldc = GMW; colt = 256 * (pn - 3); act = 2; }
            else { base = (bf16*)(ws + WS_GV); ldc = GMW; colt = 256 * (pn - 5); act = 2; }
            const CSh cs(wr, wc, fr, fq); int kk = 0;
#pragma unroll
            for (int ai = 0; ai < 2; ++ai)
#pragma unroll
                for (int m = 0; m < 4; ++m) { bf16* rowp = base + (size_t)(u.pm * 256 + wr * 64 + cs.rrow + ai * 128 + m * 16) * ldc + colt + wc * 32 + 8 * cs.rpc;
#pragma unroll
                    for (int bj = 0; bj < 2; ++bj) { f32x4 v0 = acc[ai][bj][m][0], v1 = acc[ai][bj][m][1];
                        if (act == 0) { v0 = v0 * QSCALE; v1 = v1 * QSCALE; }
                        else if (act == 2) { v0 = gelu_tanh_4(v0); v1 = gelu_tanh_4(v1); }
                        *(GAS u32x4*)(rowp + bj * 128) = cs.xch(kk++, pack8(v0, v1)); } }
        }
    }
};
struct EpiMerge {
    static constexpr bool PERM = true, MIDK = true;
    const unsigned char* GA; const unsigned char* GB; bf16* MG;
    __device__ __forceinline__ void mid(f32x4 (&acc)[2][2][4][2], const pg8::Unit& u, int wr, int wc, int fr_, int fq) const {
        int fr = fr_; asm volatile("" : "+v"(fr));
        const int row0 = u.pm * 256 + wr * 64 + fr, col0 = u.pn * 256 + wc * 32 + 8 * fq;
#pragma unroll
        for (int ai = 0; ai < 2; ++ai) {
            u32x2 ga[4][2], gb[4][2];
#pragma unroll
            for (int m = 0; m < 4; ++m)
#pragma unroll
                for (int bj = 0; bj < 2; ++bj) { const size_t off = (size_t)(row0 + ai * 128 + m * 16) * D + col0 + bj * 128; ga[m][bj] = *(const GAS u32x2*)(GA + off); gb[m][bj] = *(const GAS u32x2*)(GB + off); }
#pragma unroll
            for (int m = 0; m < 4; ++m)
#pragma unroll
                for (int bj = 0; bj < 2; ++bj) { f32x4 a0, a1, b0, b1; unpack8_u8(ga[m][bj], a0, a1); unpack8_u8(gb[m][bj], b0, b1);
#pragma unroll
                    for (int q = 0; q < 4; ++q) { acc[ai][bj][m][0][q] *= a0[q] * __builtin_amdgcn_rcpf(b0[q]); acc[ai][bj][m][1][q] *= a1[q] * __builtin_amdgcn_rcpf(b1[q]); } }
            asm volatile("" ::: "memory");
        }
    }
    __device__ __forceinline__ void operator()(const f32x4 (&acc)[2][2][4][2], const pg8::Unit& u, int wr, int wc, int fr, int fq) const {
        const int row0 = u.pm * 256 + wr * 64 + fr, col0 = u.pn * 256 + wc * 32 + 8 * fq;
        u32x2 gb[2][4][2];
#pragma unroll
        for (int ai = 0; ai < 2; ++ai)
#pragma unroll
            for (int m = 0; m < 4; ++m)
#pragma unroll
                for (int bj = 0; bj < 2; ++bj) gb[ai][m][bj] = *(const GAS u32x2*)(GB + (size_t)(row0 + ai * 128 + m * 16) * D + col0 + bj * 128);
        const CSh cs(wr, wc, fr, fq); int kk = 0;
#pragma unroll
        for (int ai = 0; ai < 2; ++ai)
#pragma unroll
            for (int m = 0; m < 4; ++m) { const size_t off = (size_t)(u.pm * 256 + wr * 64 + cs.rrow + ai * 128 + m * 16) * D + u.pn * 256 + wc * 32 + 8 * cs.rpc;
#pragma unroll
                for (int bj = 0; bj < 2; ++bj) { f32x4 b0, b1; unpack8_u8(gb[ai][m][bj], b0, b1);
                    *(GAS u32x4*)(MG + off + bj * 128) = cs.xch(kk++, pack8(acc[ai][bj][m][0] * b0, acc[ai][bj][m][1] * b1)); } }
    }
};
struct EpiWo {
    static constexpr bool PERM = true, MIDK = false;
    const float* x; const float* mod; bf16* XM;
    __device__ __forceinline__ void operator()(const f32x4 (&acc)[2][2][4][2], const pg8::Unit& u, int wr, int wc, int fr, int fq) const {
        const int row0 = u.pm * 256 + wr * 64 + fr, col0 = u.pn * 256 + wc * 32 + 8 * fq, b = u.pm >> 4;
        const CSh cs(wr, wc, fr, fq); int kk = 0;
        f32x4 g[2][2];
#pragma unroll
        for (int bj = 0; bj < 2; ++bj)
#pragma unroll
            for (int n = 0; n < 2; ++n) g[bj][n] = *(const GAS f32x4*)(mod + (size_t)b * 6 * D + 2 * D + col0 + bj * 128 + 4 * n);
#pragma unroll
        for (int ai = 0; ai < 2; ++ai) {
            f32x4 xv[4][2][2];
#pragma unroll
            for (int m = 0; m < 4; ++m)
#pragma unroll
                for (int bj = 0; bj < 2; ++bj)
#pragma unroll
                    for (int n = 0; n < 2; ++n) xv[m][bj][n] = __builtin_nontemporal_load((const GAS f32x4*)(x + (size_t)(row0 + ai * 128 + m * 16) * D + col0 + bj * 128 + 4 * n));
#pragma unroll
            for (int m = 0; m < 4; ++m) { const size_t off = (size_t)(u.pm * 256 + wr * 64 + cs.rrow + ai * 128 + m * 16) * D + u.pn * 256 + wc * 32 + 8 * cs.rpc;
#pragma unroll
                for (int bj = 0; bj < 2; ++bj) *(GAS u32x4*)(XM + off + bj * 128) = cs.xch(kk++, pack8(xv[m][bj][0] + g[bj][0] * acc[ai][bj][m][0], xv[m][bj][1] + g[bj][1] * acc[ai][bj][m][1])); }
            asm volatile("" ::: "memory");
        }
    }
};
struct EpiGateUp {
    static constexpr bool PERM = true, MIDK = false;
    unsigned char* H;
    __device__ __forceinline__ void operator()(const f32x4 (&acc)[2][2][4][2], const pg8::Unit& u, int wr, int wc, int fr, int fq) const {
        const int row0 = u.pm * 256 + wr * 64 + fr, col0 = u.pn * 128 + wc * 32 + 8 * fq;
#pragma unroll
        for (int ai = 0; ai < 2; ++ai)
#pragma unroll
            for (int m = 0; m < 4; ++m) { f32x4 v0, v1;
#pragma unroll
                for (int h = 0; h < 2; ++h) {
                    const f32x2 g0 = h ? hi2(acc[ai][0][m][0]) : lo2(acc[ai][0][m][0]), u0 = h ? hi2(acc[ai][1][m][0]) : lo2(acc[ai][1][m][0]);
                    const f32x2 g1 = h ? hi2(acc[ai][0][m][1]) : lo2(acc[ai][0][m][1]), u1 = h ? hi2(acc[ai][1][m][1]) : lo2(acc[ai][1][m][1]);
                    const f32x2 r0 = (g0 * u0) * rcp_2(exp2_2(g0) + 1.0f), r1 = (g1 * u1) * rcp_2(exp2_2(g1) + 1.0f);
                    v0[2 * h] = r0.x; v0[2 * h + 1] = r0.y; v1[2 * h] = r1.x; v1[2 * h + 1] = r1.y; }
                *(GAS u32x2*)(H + (size_t)(row0 + ai * 128 + m * 16) * DEXP + col0) = pack8_fp8(v0, v1); }
    }
};
struct EpiDown {
    static constexpr bool PERM = true, MIDK = false;
    const unsigned* lrow; const float* lw; bf16* YT; const LAS unsigned* tab;
    __device__ __forceinline__ void operator()(const f32x4 (&acc)[2][2][4][2], const pg8::Unit& u, int wr, int wc, int fr, int fq) const {
        const int col0 = u.pn * 256 + wc * 32 + 8 * fq, lt0 = u.pn  ; (void)lt0;
        const int e = u.e & 63, cnt = u.e >> 6;
        const CSh cs(wr, wc, fr, fq); int kk = 0; (void)col0;
#pragma unroll
        for (int ai = 0; ai < 2; ++ai)
#pragma unroll
            for (int m = 0; m < 4; ++m) { const int rb = ai * 128 + wr * 64 + m * 16, r = rb + fr, rs = rb + cs.rrow, li = u.v + rs;
                const float wq = u.ui < 7 ? __uint_as_float(tab[2 * (u.ui * 256 + r) + 1]) : lw[(size_t)e * LIST_CAP + (u.v + r < cnt ? u.v + r : 0)] * (1.0f / WD_SCALE);
                const unsigned ent = u.ui < 7 ? tab[2 * (u.ui * 256 + rs)] : lrow[(size_t)e * LIST_CAP + (li < cnt ? li : 0)];
                bf16* dst = YT + (size_t)ent * D + u.pn * 256 + wc * 32 + 8 * cs.rpc;
#pragma unroll
                for (int bj = 0; bj < 2; ++bj) { const u32x4 t = cs.xch(kk++, pack8(acc[ai][bj][m][0] * wq, acc[ai][bj][m][1] * wq));
                    if (li < cnt) *(GAS u32x4*)(dst + bj * 128) = t; } }
    }
};
struct MoeOrder {
    const LAS int* utab; int n;
    __device__ __forceinline__ bool next(int i, pg8::Unit& u) const { if (i >= n) return false;
        u.pm = __builtin_amdgcn_readfirstlane(utab[4 * i]); u.pn = __builtin_amdgcn_readfirstlane(utab[4 * i + 1]); u.v = __builtin_amdgcn_readfirstlane(utab[4 * i + 2]); u.e = __builtin_amdgcn_readfirstlane(utab[4 * i + 3]); u.ui = i; return true; }
};
__device__ __forceinline__ int moe_tables(Frame& F, bool rows) {
    LAS int* utab = (LAS int*)(F.lds + TAB_UNITS); LAS int* cnts = (LAS int*)(F.lds + TAB_CNT); LAS int* nun = cnts + 72;
    LAS unsigned* rowtab = (LAS unsigned*)(F.lds + TAB_ROWS);
    __syncthreads();
    if (rows || MK_N_LAUNCHES != 1) {
        if (F.tid < 64) {
            const int lane = F.tid, c = lane < 32 ? (int)__hip_atomic_load(F.ctl + CW_CNT + 64 * lane, RLX_AGENT) : 0, tiles = (c + 255) >> 8;
            int x = tiles;
#pragma unroll
            for (int o = 1; o < 32; o <<= 1) { const int y = __shfl_up(x, o); if (lane >= o) x += y; }
            const int excl = x - tiles, total = __shfl(x, 31) * 4;
            int n = 0;
            for (int i = 0; i < MAX_WG_UNITS; ++i) { const int L = i * F.G + F.vcu; if (L >= total) break;
                const int rt = L >> 2, pn = L & 3;
                const unsigned long long m = __ballot(lane < 32 && excl <= rt && rt < excl + tiles);
                const int e = m ? __builtin_ctzll(m) : 0, ce = __shfl(c, e), lt = rt - __shfl(excl, e);
                if (lane == 0) { utab[4 * i] = rt; utab[4 * i + 1] = pn; utab[4 * i + 2] = lt * 256; utab[4 * i + 3] = e | (ce << 6); }
                ++n; }
            if (lane == 0) nun[0] = n;
        }
        __syncthreads();
    }
    const int n = nun[0];
    if (rows) {
        const unsigned* lrow = (const unsigned*)(F.ws + WS_LROW);
        for (int q = F.tid; q < n * 256; q += 512) { const int i = q >> 8, r = q & 255, e = utab[4 * i + 3] & 63, cnt = utab[4 * i + 3] >> 6, li = utab[4 * i + 2] + r;
            const unsigned tok = li < cnt ? (lrow[(size_t)e * LIST_CAP + li] >> 1) : 0u; rowtab[q] = tok * (unsigned)D; }
    } else {
        const unsigned* lrow = (const unsigned*)(F.ws + WS_LROW); const float* lw = (const float*)(F.ws + WS_LW);
        for (int q = F.tid; q < n * 256 && q < 7 * 256; q += 512) { const int i = q >> 8, r = q & 255, e = utab[4 * i + 3] & 63, cnt = utab[4 * i + 3] >> 6, li = utab[4 * i + 2] + r, lc = li < cnt ? li : 0;
            rowtab[2 * q] = lrow[(size_t)e * LIST_CAP + lc]; rowtab[2 * q + 1] = __float_as_uint(lw[(size_t)e * LIST_CAP + lc] * (1.0f / WD_SCALE)); }
    }
    __syncthreads();
    return n;
}

constexpr int KCH = 4112;
constexpr int AT_K = 0, AT_V = 8 * KCH  , AT_POS = AT_V + 32768, AT_TAB = AT_POS + 1024  , AT_TABT = AT_TAB + 4 * 132 * 4  ,
              AT_OST = 72704  , AT_TABR = AT_OST + 8 * 4096  ,
              AT_END = AT_TABR + 4 * 4 * 208 * 4;
static_assert(AT_END <= RING_BYTES, "attention LDS");
static_assert(AT_TABT + 4 * 200 * 4 <= AT_OST, "attention LDS");
static_assert(AT_END <= RING_BYTES, "attention LDS");
__device__ __forceinline__ int crow(int r, int hi) { return (r & 3) + 8 * (r >> 2) + 4 * hi; }
__device__ __forceinline__ s16x4 vtr(const LAS unsigned char* p) { typedef short v4i16_t __attribute__((ext_vector_type(4))); return __builtin_bit_cast(s16x4, __builtin_amdgcn_ds_read_tr16_b64_v4i16((LAS v4i16_t*)p)); }
__device__ __forceinline__ bf16x8 mk8(const s16x4 lo, const s16x4 hi) { return (bf16x8){lo[0], lo[1], lo[2], lo[3], hi[0], hi[1], hi[2], hi[3]}; }

__device__ __forceinline__ void attn_unit(Frame& F, const Args& A, int b, int blk, int kvh) {
    int tid = F.tid; asm volatile("" : "+v"(tid));
    const int lane = tid & 63, wid = F.wave, r32 = lane & 31, hi = lane >> 5;
    LAS unsigned char* L = F.lds + RING_OFF;
    const bf16* Q = (const bf16*)(F.ws + WS_Q); const bf16* KV = (const bf16*)(F.ws + WS_KV); bf16* YAB = (bf16*)(F.ws + WS_YAB);
    const int r0 = b * SEQ + blk * 128, rp = blk > 0 ? r0 - 128 : r0;
    __syncthreads();
#pragma unroll
    for (int j = 0; j < 4; ++j) { const int p = tid + 512 * j, key = p >> 3, c = p & 7; const int grow = key < 128 ? rp + key : r0 + key - 128;
        const u32x4 kk = *(const GAS u32x4*)(KV + (size_t)grow * NKV + kvh * 64 + c * 8);
        const u32x4 vv = *(const GAS u32x4*)(KV + (size_t)grow * NKV + 128 + kvh * 64 + c * 8);
        *(LAS u32x4*)(L + AT_K + c * KCH + key * 16) = kk;
        *(LAS u32x4*)(L + AT_V + ((key >> 4) * 2 + (c >> 2)) * 1024 + (key & 15) * 64 + (c & 3) * 16) = vv; }
    if (tid < 256) { const int grow = tid < 128 ? rp + tid : r0 + tid - 128; ((LAS int*)(L + AT_POS))[tid] = ((const int*)A.in[I_POS])[grow]; }
    if (tid < 200) { int n = tid - 36; n = n < 0 ? 0 : (n > 128 ? 128 : n); int bucket;
        if (n < 16) bucket = n; else { const int lg = (int)(logf((float)n / 16.0f) / logf(8.0f) * 16.0f); bucket = 16 + lg; if (bucket > 31) bucket = 31; }
#pragma unroll
        for (int g = 0; g < 4; ++g) { const float v = A.in[I_RELB][bucket * 8 + kvh * 4 + g] * LOG2E; if (tid >= 36 && tid <= 164) ((LAS float*)(L + AT_TAB))[g * 132 + tid - 36] = v;
            const float vm = (tid >= 36 && tid < 164) ? v : -1e30f;
#pragma unroll
            for (int sft = 0; sft < 4; ++sft) if (199 - tid - sft >= 0) ((LAS float*)(L + AT_TABR))[(g * 4 + sft) * 208 + 199 - tid - sft] = vm; } }
    __syncthreads();
    const int toep = __syncthreads_and(tid >= 255 || (blk == 0 && tid < 128) || ((const LAS int*)(L + AT_POS))[tid + 1] - ((const LAS int*)(L + AT_POS))[tid] == 1);
    const int g = wid & 3, qh = wid >> 2, head = kvh * 4 + g;
    const float sink2 = A.in[I_SINKS][head] * LOG2E;
    const LAS float* tab = (const LAS float*)(L + AT_TAB) + g * 132;
    const LAS int* posl = (const LAS int*)(L + AT_POS);
#pragma unroll 1
    for (int s = 0; s < 2; ++s) {
        const int i0 = 64 * qh + 32 * s, T0 = i0 >> 5;
        bf16x8 qr[4];
#pragma unroll
        for (int ks = 0; ks < 4; ++ks) qr[ks] = *(const GAS bf16x8*)(Q + (size_t)(r0 + i0 + r32) * NQ + head * 64 + ks * 16 + hi * 8);
        const int pq = posl[128 + i0 + r32];
        f32x16 p[5];
        if (toep) {
            const int sft = (35 - r32) & 3, Y = ((35 - r32 - sft) >> 2) + hi;
            const LAS f32x4* tr = (const LAS f32x4*)(L + AT_TABR + (g * 4 + sft) * 208 * 4) + Y;
#pragma unroll
            for (int j = 0; j < 5; ++j) {
                const bool tile_dead = (blk == 0) && (T0 + j < 4);
                f32x4 c0 = tr[8 * j], c1 = tr[8 * j + 2], c2 = tr[8 * j + 4], c3 = tr[8 * j + 6];
                if (tile_dead) { c0 = (f32x4){-1e30f, -1e30f, -1e30f, -1e30f}; c1 = c0; c2 = c0; c3 = c0; }
                f32x16 a = __builtin_shufflevector(__builtin_shufflevector(c0, c1, 0, 1, 2, 3, 4, 5, 6, 7), __builtin_shufflevector(c2, c3, 0, 1, 2, 3, 4, 5, 6, 7), 0, 1, 2, 3, 4, 5, 6, 7, 8, 9, 10, 11, 12, 13, 14, 15);
#pragma unroll
                for (int ks = 0; ks < 4; ++ks) { const bf16x8 kf = *(const LAS bf16x8*)(L + AT_K + (2 * ks + hi) * KCH + (32 * (T0 + j) + r32) * 16);
                    a = __builtin_amdgcn_mfma_f32_32x32x16_bf16(kf, qr[ks], a, 0, 0, 0); }
                p[j] = a;
            }
        } else {
#pragma unroll
        for (int j = 0; j < 5; ++j) {
            f32x16 a = {};
#pragma unroll
            for (int ks = 0; ks < 4; ++ks) { const bf16x8 kf = *(const LAS bf16x8*)(L + AT_K + (2 * ks + hi) * KCH + (32 * (T0 + j) + r32) * 16);
                a = __builtin_amdgcn_mfma_f32_32x32x16_bf16(kf, qr[ks], a, 0, 0, 0); }
            p[j] = a;
        }
#pragma unroll
        for (int j = 0; j < 5; ++j) {
            const bool tile_dead = (blk == 0) && (T0 + j < 4);
#pragma unroll
            for (int rq = 0; rq < 4; ++rq) {
                const int k0 = 32 * (T0 + j) + 8 * rq + 4 * hi;
                typedef int i32x4 __attribute__((ext_vector_type(4))); const i32x4 pk = *(const LAS i32x4*)(posl + k0);
#pragma unroll
                for (int q = 0; q < 4; ++q) { const int r = 4 * rq + q, kl = 8 * rq + 4 * hi + q;
                    const int pkv = pk[q];
                    int n = pq - pkv; n = n < 0 ? 0 : (n > 128 ? 128 : n);
                    float sv = p[j][r] + tab[n];
                    bool ok = !tile_dead;
                    if (j == 0) ok = ok && (kl > r32);
                    if (j == 4) ok = ok && (kl <= r32);
                    p[j][r] = ok ? sv : -1e30f; }
            }
        }
        }
        float mx = sink2;
#pragma unroll
        for (int j = 0; j < 5; ++j)
#pragma unroll
            for (int r = 0; r < 16; ++r) mx = fmaxf(mx, p[j][r]);
        mx = fmaxf(mx, __shfl_xor(mx, 32));
        f32x2 l2 = {0.f, 0.f}; const f32x2 mx2 = {mx, mx};
#pragma unroll
        for (int j = 0; j < 5; ++j)
#pragma unroll
            for (int r = 0; r < 16; r += 2) { const f32x2 e = exp2_2((f32x2){p[j][r], p[j][r + 1]} - mx2); p[j][r] = e.x; p[j][r + 1] = e.y; l2 += e; }
        float l = l2.x + l2.y;
        l += __shfl_xor(l, 32);
        l += __builtin_amdgcn_exp2f(sink2 - mx);
        const float rl = __builtin_amdgcn_rcpf(l);
        f32x16 o[2]; o[0] = (f32x16){}; o[1] = (f32x16){};
        const int vlane = (4 * hi + ((lane & 15) >> 2)) * 64 + ((lane >> 4) & 1) * 32 + (lane & 3) * 8;
#pragma unroll
        for (int j = 0; j < 5; ++j)
#pragma unroll
            for (int s2 = 0; s2 < 2; ++s2) {
                u32x4 pw; pw.x = cvtpk(p[j][8 * s2 + 0], p[j][8 * s2 + 1]); pw.y = cvtpk(p[j][8 * s2 + 2], p[j][8 * s2 + 3]);
                pw.z = cvtpk(p[j][8 * s2 + 4], p[j][8 * s2 + 5]); pw.w = cvtpk(p[j][8 * s2 + 6], p[j][8 * s2 + 7]);
                const bf16x8 pa = __builtin_bit_cast(bf16x8, pw);
                const int kg = 2 * (T0 + j) + s2;
#pragma unroll
                for (int d0 = 0; d0 < 2; ++d0) { const LAS unsigned char* vp = L + AT_V + (kg * 2 + d0) * 1024 + vlane;
                    const bf16x8 vf = mk8(vtr(vp), vtr(vp + 512));
                    o[d0] = __builtin_amdgcn_mfma_f32_32x32x16_bf16(vf, pa, o[d0], 0, 0, 0); }
            }
        {
            LAS unsigned char* stg = L + AT_OST + wid * 4096; const f32x2 rl2 = {rl, rl};
#pragma unroll
            for (int d0 = 0; d0 < 2; ++d0)
#pragma unroll
                for (int rq = 0; rq < 4; ++rq) { const f32x2 a = (f32x2){o[d0][4 * rq], o[d0][4 * rq + 1]} * rl2, b2 = (f32x2){o[d0][4 * rq + 2], o[d0][4 * rq + 3]} * rl2;
                    u32x2 w; w.x = cvtpk(a.x, a.y); w.y = cvtpk(b2.x, b2.y);
                    *(LAS u32x2*)(stg + r32 * 128 + (((4 * d0 + rq) ^ (r32 & 7)) << 4) + hi * 8) = w; }
#pragma unroll
            for (int i = 0; i < 4; ++i) { const int pc = lane + 64 * i, row = pc >> 3, ch = pc & 7;
                const u32x4 v = *(const LAS u32x4*)(stg + row * 128 + ((ch ^ (row & 7)) << 4));
                *(GAS u32x4*)(YAB + (size_t)(r0 + i0 + row) * D + head * 64 + ch * 8) = v; }
        }
    }
}

__device__ __forceinline__ void gmlp_unit(Frame& F, const Args& A, int b, int ch) {
    int tid = F.tid; asm volatile("" : "+v"(tid));
    const int lane = tid & 63, wid = F.wave, r32 = lane & 31, hi = lane >> 5;
    LAS unsigned char* L = F.lds + RING_OFF;
    const bf16* GU = (const bf16*)(F.ws + WS_GU); const bf16* GV = (const bf16*)(F.ws + WS_GV); bf16* YAB = (bf16*)(F.ws + WS_YAB);
    const bf16* WST = (const bf16*)(F.ws + WS_WST);
    const int r0 = b * SEQ + ch * 128;
    const int g = wid >> 1, chalf = wid & 1;
    bf16x8 wfl[20];
#pragma unroll
    for (int tt = 0; tt < 4; ++tt)
#pragma unroll
        for (int ks = 0; ks < 8; ++ks) if (ks <= 2 * tt + 1) wfl[tt * (tt + 1) + ks] = *(const GAS bf16x8*)(WST + ((size_t)g * 128 + 32 * tt + r32) * 128 + 16 * ks + 8 * hi);
    float bin[4]; u32x4 gun[4];
#pragma unroll
    for (int i = 0; i < 4; ++i) { const int pc = lane + 64 * i; bin[i] = A.in[I_GBS][g * 128 + (pc >> 3)]; gun[i] = *(const GAS u32x4*)(GU + (size_t)(r0 + (pc >> 3)) * GMW + g * 128 + 64 * chalf + 8 * (pc & 7)); }
    __syncthreads();
    {
        const float* lg = A.in[I_LNG]; const float* lb = A.in[I_LNB];
        const f32x4 g0 = *(const GAS f32x4*)(lg + 8 * lane), g1 = *(const GAS f32x4*)(lg + 8 * lane + 4), b0 = *(const GAS f32x4*)(lb + 8 * lane), b1 = *(const GAS f32x4*)(lb + 8 * lane + 4);
        const int grp = lane >> 4, cb = (lane & 15) >> 2;
        u32x4 gvr[16];
#pragma unroll
        for (int j = 0; j < 16; ++j) gvr[j] = *(const GAS u32x4*)(GV + (size_t)(r0 + 16 * wid + j) * GMW + 8 * lane);
#pragma unroll
        for (int j = 0; j < 16; ++j) {
            f32x4 v0, v1; unpack8(gvr[j], v0, v1);
            const float mu = wave_sum((v0[0] + v0[1]) + (v0[2] + v0[3]) + (v1[0] + v1[1]) + (v1[2] + v1[3])) * (1.0f / GMW);
            v0 = v0 - mu; v1 = v1 - mu;
            const float var = wave_sum((v0[0] * v0[0] + v0[1] * v0[1]) + (v0[2] * v0[2] + v0[3] * v0[3]) + (v1[0] * v1[0] + v1[1] * v1[1]) + (v1[2] * v1[2] + v1[3] * v1[3])) * (1.0f / GMW);
            const float rstd = __builtin_amdgcn_rsqf(var + EPS);
            *(LAS u32x4*)(L + grp * 32768 + (wid * 4 + cb) * 1024 + j * 64 + (lane & 3) * 16) = pack8(v0 * rstd * g0 + b0, v1 * rstd * g1 + b1); }
    }
    __syncthreads();
    const int vlane = (8 * hi + ((lane & 15) >> 2)) * 64 + ((lane >> 4) & 1) * 32 + (lane & 3) * 8;
    bf16x8 bfr[2][8];
#pragma unroll
    for (int ct = 0; ct < 2; ++ct)
#pragma unroll
        for (int ks = 0; ks < 8; ++ks) { const LAS unsigned char* vp = L + g * 32768 + (ks * 4 + 2 * chalf + ct) * 1024 + vlane; bfr[ct][ks] = mk8(vtr(vp), vtr(vp + 256)); }
    __syncthreads();
    LAS float* stg = (LAS float*)(L + wid * (32 * 68 * 4));
#pragma unroll
    for (int tt = 0; tt < 4; ++tt) {
        f32x16 acc[2]; acc[0] = (f32x16){}; acc[1] = (f32x16){};
#pragma unroll
        for (int ks = 0; ks < 8; ++ks) if (ks <= 2 * tt + 1) {
            acc[0] = __builtin_amdgcn_mfma_f32_32x32x16_bf16(wfl[tt * (tt + 1) + ks], bfr[0][ks], acc[0], 0, 0, 0);
            acc[1] = __builtin_amdgcn_mfma_f32_32x32x16_bf16(wfl[tt * (tt + 1) + ks], bfr[1][ks], acc[1], 0, 0, 0); }
#pragma unroll
        for (int ct = 0; ct < 2; ++ct)
#pragma unroll
            for (int r = 0; r < 16; ++r) stg[crow(r, hi) * 68 + 32 * ct + r32] = acc[ct][r];
        u32x4 gu[4]; float bi[4];
#pragma unroll
        for (int i = 0; i < 4; ++i) { gu[i] = gun[i]; bi[i] = bin[i]; }
        if (tt < 3) {
#pragma unroll
            for (int i = 0; i < 4; ++i) { const int pc = lane + 64 * i; bin[i] = A.in[I_GBS][g * 128 + 32 * (tt + 1) + (pc >> 3)];
                gun[i] = *(const GAS u32x4*)(GU + (size_t)(r0 + 32 * (tt + 1) + (pc >> 3)) * GMW + g * 128 + 64 * chalf + 8 * (pc & 7)); } }
#pragma unroll
        for (int i = 0; i < 4; ++i) { const int pc = lane + 64 * i, row = pc >> 3, chn = pc & 7, t = 32 * tt + row, c = g * 128 + 64 * chalf + 8 * chn;
            const f32x4 s0 = *(const LAS f32x4*)(stg + row * 68 + 8 * chn), s1 = *(const LAS f32x4*)(stg + row * 68 + 8 * chn + 4);
            const float bb = bi[i]; f32x4 u0, u1; unpack8(gu[i], u0, u1);
            *(GAS u32x4*)(YAB + (size_t)(r0 + t) * D + NQ + c) = pack8(u0 * (s0 + bb), u1 * (s1 + bb)); }
    }
}

__device__ __forceinline__ void router_images(Frame& F, const Args& A) {
    const float* mod = (const float*)(F.ws + WS_MOD); bf16* GT = (bf16*)(F.ws + WS_GT); float* GC = (float*)(F.ws + WS_GC);
    LAS float* red = (LAS float*)(F.lds + RING_OFF);
    for (int it = F.vcu; it < 8 * 48; it += F.G) { const int b = it / 48, n = it % 48; float part = 0.f;
#pragma unroll
        for (int cc = 0; cc < 2; ++cc) { const int c = F.tid + 512 * cc;
            const float sh = mod[(size_t)b * 6 * D + 3 * D + c], sc = mod[(size_t)b * 6 * D + 4 * D + c], a2 = A.in[I_N2G][c] * (1.0f + sc);
            const float w = n < 4 ? A.in[I_WRG][(size_t)c * 4 + n] : (n < 36 ? A.in[I_WRE][(size_t)c * 32 + (n - 4)] : 0.f);
            GT[((size_t)b * 48 + n) * D + c] = (bf16)(cvtpk(a2 * w, 0.f) & 0xffffu); part += sh * w; }
        part = wave_sum(part);
        __syncthreads(); if (F.lane == 0) red[F.wave] = part; __syncthreads();
        if (F.tid == 0) { float s = n < 4 ? A.in[I_BRG][n] : (n < 36 ? A.in[I_BRE][n - 4] : 0.f);
#pragma unroll
            for (int w = 0; w < 8; ++w) s += red[w];
            GC[b * 48 + n] = s; }
    }
}

constexpr int GT_STRIDE = 2064;
constexpr int R6_GT = 0, R6_A2 = 48 * GT_STRIDE  , R6_B2 = R6_A2 + 4096, R6_CONST = R6_B2 + 4096, R6_LCNT = R6_CONST + 256, R6_LBASE = R6_LCNT + 128, R6_RED = R6_LBASE + 128, R6_LOG = R6_RED + 8 * 40 * 4, R6_END = R6_LOG + 8 * 16 * 40 * 4;
static_assert(R6_END <= RING_BYTES, "router LDS");
__device__ __forceinline__ void p6_router(Frame& F, const Args& A) {
    const int wid = F.wave;
    LAS unsigned char* L = F.lds + RING_OFF;
    const float* mod = (const float*)(F.ws + WS_MOD);
    const bf16* XM = (const bf16*)(F.ws + WS_XMID); unsigned char* H2 = (unsigned char*)(F.ws + WS_H2);
    unsigned* lrow = (unsigned*)(F.ws + WS_LROW); float* lw = (float*)(F.ws + WS_LW);
    LAS float* A2 = (LAS float*)(L + R6_A2); LAS float* B2 = (LAS float*)(L + R6_B2); LAS float* cst = (LAS float*)(L + R6_CONST);
    LAS int* lcnt = (LAS int*)(L + R6_LCNT); LAS int* lbase = (LAS int*)(L + R6_LBASE); LAS float* red = (LAS float*)(L + R6_RED);
    LAS float* lg = (LAS float*)(L + R6_LOG) + wid * 16 * 40;
    for (int rb = F.vcu; rb < M / 128; rb += F.G) {
        const int b = rb / (SEQ / 128);
        int tid = F.tid; asm volatile("" : "+v"(tid)); const int lane = tid & 63;
        const int rloc = lane & 15, kq = lane >> 4, row = rb * 128 + wid * 16 + rloc;
        u32x4 xk[32];
#pragma unroll
        for (int ks = 0; ks < 32; ++ks) xk[ks] = *(const GAS u32x4*)(XM + (size_t)row * D + 32 * ks + 8 * kq);
        asm volatile("" ::: "memory");
        __syncthreads();
        {
            const bf16* GTb = (const bf16*)(F.ws + WS_GT) + (size_t)b * 48 * D;
            u32x4 gt[12];
#pragma unroll
            for (int i = 0; i < 12; ++i) gt[i] = *(const GAS u32x4*)(GTb + (size_t)(tid + 512 * i) * 8);
#pragma unroll
            for (int cc = 0; cc < 2; ++cc) { const int c = tid + 512 * cc; A2[c] = A.in[I_N2G][c] * (1.0f + mod[(size_t)b * 6 * D + 4 * D + c]); B2[c] = mod[(size_t)b * 6 * D + 3 * D + c]; }
            if (tid < 48) cst[tid] = ((const float*)(F.ws + WS_GC))[b * 48 + tid];
            if (tid < 32) lcnt[tid] = 0;
#pragma unroll
            for (int i = 0; i < 12; ++i) { const int pc = tid + 512 * i, n = pc >> 7, ch = pc & 127; *(LAS u32x4*)(L + R6_GT + n * GT_STRIDE + ch * 16) = gt[i]; }
        }
        __syncthreads();
        float ss = 0.f;
#pragma unroll
        for (int ks = 0; ks < 32; ++ks) { f32x4 a, c; unpack8(xk[ks], a, c); ss += (a[0] * a[0] + a[1] * a[1]) + (a[2] * a[2] + a[3] * a[3]) + (c[0] * c[0] + c[1] * c[1]) + (c[2] * c[2] + c[3] * c[3]); }
        ss += __shfl_xor(ss, 16); ss += __shfl_xor(ss, 32);
        const float rinv = 1.0f / sqrtf(ss * (1.0f / D) + EPS);
        f32x4 acc[3]; acc[0] = (f32x4){0.f, 0.f, 0.f, 0.f}; acc[1] = acc[0]; acc[2] = acc[0];
#pragma unroll
        for (int ks = 0; ks < 32; ++ks) { const bf16x8 af = __builtin_bit_cast(bf16x8, xk[ks]);
#pragma unroll
            for (int nt = 0; nt < 3; ++nt) { const bf16x8 bfg = *(const LAS bf16x8*)(L + R6_GT + (16 * nt + rloc) * GT_STRIDE + (32 * ks + 8 * kq) * 2);
                acc[nt] = __builtin_amdgcn_mfma_f32_16x16x32_bf16(af, bfg, acc[nt], 0, 0, 0); }
            if ((ks & 3) == 3) asm volatile("" ::: "memory"); }
#pragma unroll
        for (int nt = 0; nt < 3; ++nt) { const int n = 16 * nt + rloc; if (n < 36) {
#pragma unroll
            for (int q = 0; q < 4; ++q) lg[(4 * kq + q) * 40 + n] = acc[nt][q]; } }
#pragma unroll
        for (int ks = 0; ks < 32; ++ks) asm volatile("" : "+v"(xk[ks]));
#pragma unroll
        for (int ks = 0; ks < 32; ++ks) { const int c0 = 32 * ks + 8 * kq; f32x4 a, c; unpack8(xk[ks], a, c);
            const f32x4 a0 = *(const LAS f32x4*)(A2 + c0), a1 = *(const LAS f32x4*)(A2 + c0 + 4), b0 = *(const LAS f32x4*)(B2 + c0), b1 = *(const LAS f32x4*)(B2 + c0 + 4);
            *(GAS u32x2*)(H2 + (size_t)row * D + c0) = pack8_fp8(a * rinv * a0 + b0, c * rinv * a1 + b1);
            if ((ks & 3) == 3) asm volatile("" ::: "memory"); }
        LDS_WAIT(); asm volatile("" ::: "memory");
        int e1 = 0, e2 = 0, lp1 = 0, lp2 = 0; float w1 = 0.f, w2 = 0.f;
        if (lane < 16) {
            const LAS float* lr = lg + lane * 40;
            float l0[4]; int gi = 0;
#pragma unroll
            for (int n = 0; n < 4; ++n) l0[n] = lr[n] * rinv + cst[n];
            float gm = l0[0];
#pragma unroll
            for (int n = 1; n < 4; ++n) if (l0[n] > gm) { gm = l0[n]; gi = n; }
            float gs = 0.f;
#pragma unroll
            for (int n = 0; n < 4; ++n) gs += __expf(l0[n] - gm);
            const float pg = 1.0f / gs;
            float le[8];
#pragma unroll
            for (int j = 0; j < 8; ++j) le[j] = lr[4 + 8 * gi + j] * rinv + cst[4 + 8 * gi + j];
            int i1 = 0; float m1 = le[0];
#pragma unroll
            for (int j = 1; j < 8; ++j) if (le[j] > m1) { m1 = le[j]; i1 = j; }
            int i2 = -1; float m2 = -INFINITY;
#pragma unroll
            for (int j = 0; j < 8; ++j) if (j != i1 && le[j] > m2) { m2 = le[j]; i2 = j; }
            const float ex = __expf(m2 - m1); const float t1 = 1.0f / (1.0f + ex);
            w1 = pg * t1; w2 = pg * (ex * t1);
            if (i2 < 0) i2 = (i1 + 1) & 7;
            e1 = gi * 8 + i1; e2 = gi * 8 + i2;
            lp1 = atomicAdd((int*)&lcnt[e1], 1); lp2 = atomicAdd((int*)&lcnt[e2], 1);
        }
        __syncthreads();
        if (tid < 32) { const int c = lcnt[tid]; lbase[tid] = c > 0 ? (int)__hip_atomic_fetch_add(F.ctl + CW_CNT + 64 * tid, (unsigned)c, RLX_AGENT) : 0; }
        __syncthreads();
        if (lane < 16) {
            const int p1 = lbase[e1] + lp1, p2 = lbase[e2] + lp2;
            lrow[(size_t)e1 * LIST_CAP + p1] = (unsigned)row * 2u; lw[(size_t)e1 * LIST_CAP + p1] = w1;
            lrow[(size_t)e2 * LIST_CAP + p2] = (unsigned)row * 2u + 1u; lw[(size_t)e2 * LIST_CAP + p2] = w2;
#if DEBUG_CHECKS
            { float* rec = (float*)(F.ws + 490 * MiB) + (size_t)row * 4; rec[0] = (float)e1; rec[1] = (float)e2; rec[2] = w1; rec[3] = w2; }
#endif
        }
    }
}

__device__ __forceinline__ void p9_final(Frame& F, const Args& A) {
    const int lane = F.lane, wid = F.wave;
    const float* mod = (const float*)(F.ws + WS_MOD); const bf16* XM = (const bf16*)(F.ws + WS_XMID); const bf16* YT = (const bf16*)(F.ws + WS_YT);
    for (int rb = F.vcu; rb < M / 128; rb += F.G) {
        const int b = rb / (SEQ / 128);
        f32x4 g2[2][2], fg[2][2];
#pragma unroll
        for (int jj = 0; jj < 2; ++jj)
#pragma unroll
            for (int q = 0; q < 2; ++q) { const int c = 512 * jj + 8 * lane + 4 * q; g2[jj][q] = *(const GAS f32x4*)(mod + (size_t)b * 6 * D + 5 * D + c); fg[jj][q] = *(const GAS f32x4*)(A.in[I_FG] + c); }
#pragma unroll 1
        for (int j0 = 0; j0 < 16; j0 += 4) {
            u32x4 xm[4][2], y0[4][2], y1[4][2];
#pragma unroll
            for (int jr = 0; jr < 4; ++jr) { const int row = rb * 128 + wid * 16 + j0 + jr;
#pragma unroll
                for (int jj = 0; jj < 2; ++jj) { const int c = 512 * jj + 8 * lane;
                    xm[jr][jj] = __builtin_nontemporal_load((const GAS u32x4*)(XM + (size_t)row * D + c));
                    y0[jr][jj] = __builtin_nontemporal_load((const GAS u32x4*)(YT + (size_t)row * 2 * D + c));
                    y1[jr][jj] = __builtin_nontemporal_load((const GAS u32x4*)(YT + (size_t)row * 2 * D + D + c)); } }
#pragma unroll
            for (int jr = 0; jr < 4; ++jr) { const int row = rb * 128 + wid * 16 + j0 + jr;
                f32x4 v[2][2]; float ss = 0.f;
#pragma unroll
                for (int jj = 0; jj < 2; ++jj) { f32x4 x0, x1, a0, a1, z0, z1;
                    unpack8(xm[jr][jj], x0, x1); unpack8(y0[jr][jj], a0, a1); unpack8(y1[jr][jj], z0, z1);
                    v[jj][0] = x0 + g2[jj][0] * (a0 + z0); v[jj][1] = x1 + g2[jj][1] * (a1 + z1);
#pragma unroll
                    for (int q = 0; q < 2; ++q) ss += (v[jj][q][0] * v[jj][q][0] + v[jj][q][1] * v[jj][q][1]) + (v[jj][q][2] * v[jj][q][2] + v[jj][q][3] * v[jj][q][3]); }
                const float rinv = 1.0f / sqrtf(wave_sum(ss) * (1.0f / D) + EPS);
#pragma unroll
                for (int jj = 0; jj < 2; ++jj)
#pragma unroll
                    for (int q = 0; q < 2; ++q) __builtin_nontemporal_store(v[jj][q] * rinv * fg[jj][q], (GAS f32x4*)(A.out + (size_t)row * D + 512 * jj + 8 * lane + 4 * q)); }
        }
    }
}

__global__ void __launch_bounds__(NWAVES * 64, 2) mk_fwd(Args args) {
    extern __shared__ __attribute__((aligned(16))) unsigned char lds[];
    Frame F;
    F.lds = (LAS unsigned char*)lds;
    F.MISC = (volatile LAS unsigned*)(F.lds + MISC_OFF);
    F.tid = threadIdx.x; F.lane = F.tid & 63; F.wave = __builtin_amdgcn_readfirstlane(F.tid >> 6);
    F.G = gridDim.x; { const int bx = blockIdx.x; F.vcu = (F.G % 8 == 0) ? (bx % 8) * (F.G / 8) + bx / 8 : bx; }
    F.ws = args.ws; F.ctl = (gu32*)(args.ws + WS_CTL);
    for (int u = F.tid; u < (TAB_OFF - LDSCTL_OFF) / 4; u += NWAVES * 64) ((LAS unsigned*)(F.lds + LDSCTL_OFF))[u] = 0u;
    __syncthreads();
    XcdBarrier bar; bar.bar = (unsigned*)(F.ctl + CW_BAR); bar.x = 0; bar.st = nullptr;
    if (MK_N_LAUNCHES == 1) bar = xcd_barrier_post((unsigned*)(F.ctl + CW_BAR), F.MISC + 8);
#define GRID_BAR() do { if (MK_N_LAUNCHES == 1) xcd_barrier(bar); } while (0)
    const int lo = args.ph_lo, hi = args.ph_hi;
#ifdef ONLY_PHASE
#define IN(k) ((k) == ONLY_PHASE && lo <= (k) && (k) < hi)
#else
#define IN(k) (lo <= (k) && (k) < hi)
#endif
#define BOTH(k) (IN(k) && IN((k) + 1))

    if (IN(0)) { p0_prologue(F, args); if (BOTH(0)) GRID_BAR(); }
    if (IN(1)) { p1_h1(F, args); if (BOTH(1)) GRID_BAR(); }
    if (IN(2)) {
        const bool fp8_first = (blockIdx.x & 1) != 0;
#define P2_BF16() do { ProbDense P{D * 2, D * 2u, D * 2u, (const char*)(F.ws + WS_A), (const char*)(F.ws + WS_WIN), nullptr}; \
            pg8::DenseOrder S; S.init(M, NBF, F.G, (int)blockIdx.x); EpiInProjT<false> E{F.ws, 0, 1.0f}; \
            pg8::gemm_phase<ProbDense, EpiInProjT<false>, pg8::DenseOrder, true>(F.lds + RING_OFF, P, S, E); } while (0)
#define P2_FP8() do { ProbDense8 P{D, (unsigned)D, (unsigned)D, (const char*)(F.ws + WS_H1F8), (const char*)(F.ws + WS_WIN8), nullptr}; \
            pg8::BackfillOrder S; S.init(M, INW - NBF, F.G, (int)blockIdx.x); EpiInProjT<true> E{F.ws, NBF / 256, 1.0f}; \
            pg8::gemm_phase<ProbDense8, EpiInProjT<true>, pg8::BackfillOrder, true>(F.lds + RING_OFF, P, S, E); } while (0)
        if (fp8_first) { P2_FP8(); P2_BF16(); } else { P2_BF16(); P2_FP8(); }
#undef P2_BF16
#undef P2_FP8
        if (BOTH(2)) GRID_BAR();
    }
    if (IN(3)) {
        router_images(F, args);
        for (int ub = F.vcu; ub < M / 128; ub += F.G) { const int b = ub / (SEQ / 128), blk = ub % (SEQ / 128);

#ifndef NO_ATTN
#pragma unroll 1
            for (int kvh = 0; kvh < 2; ++kvh) attn_unit(F, args, b, blk, kvh);
            asm volatile("" ::: "memory");
#endif
#ifndef NO_GMLP
            gmlp_unit(F, args, b, blk);
#endif
        }
        __syncthreads();
        if (BOTH(3)) GRID_BAR();
    }
    if (IN(4)) {
        ProbDense P{D * 2, D * 2u, D * 2u, (const char*)(F.ws + WS_YAB), (const char*)(F.ws + WS_PA), nullptr};
        pg8::DenseOrder S; S.init(M, D, F.G, (int)blockIdx.x);
        EpiMerge E{(const unsigned char*)(F.ws + WS_GA), (const unsigned char*)(F.ws + WS_GB), (bf16*)(F.ws + WS_A)};
        pg8::gemm_phase<ProbDense, EpiMerge, pg8::DenseOrder, true>(F.lds + RING_OFF, P, S, E);
        if (BOTH(4)) GRID_BAR();
    }
    if (IN(5)) {
        ProbDense P{D * 2, D * 2u, D * 2u, (const char*)(F.ws + WS_A), (const char*)(F.ws + WS_WO), nullptr};
        pg8::DenseOrder S; S.init(M, D, F.G, (int)blockIdx.x);
        EpiWo E{args.in[I_X], (const float*)(F.ws + WS_MOD), (bf16*)(F.ws + WS_XMID)};
        pg8::gemm_phase<ProbDense, EpiWo, pg8::DenseOrder, true>(F.lds + RING_OFF, P, S, E);
        if (BOTH(5)) GRID_BAR();
    }
    if (IN(6)) { p6_router(F, args); __syncthreads(); if (BOTH(6)) GRID_BAR(); }
    if (IN(7)) {
        const int n = moe_tables(F, true);
        ProbGateUp P{D, (unsigned)D, (unsigned)D, (const char*)(F.ws + WS_H2), (const char*)(F.ws + WS_WGU), (const LAS unsigned*)(F.lds + TAB_ROWS)};
        MoeOrder S{(const LAS int*)(F.lds + TAB_UNITS), n};
        EpiGateUp E{(unsigned char*)(F.ws + WS_HACT)};
        pg8::gemm_phase<ProbGateUp, EpiGateUp, MoeOrder, true>(F.lds + RING_OFF, P, S, E);
        if (BOTH(7)) GRID_BAR();
    }
    if (IN(8)) {
        const int n = moe_tables(F, false);
        ProbDown P{DEXP, (unsigned)DEXP, (unsigned)DEXP, (const char*)(F.ws + WS_HACT), (const char*)(F.ws + WS_WD), nullptr};
        MoeOrder S{(const LAS int*)(F.lds + TAB_UNITS), n};
        EpiDown E{(const unsigned*)(F.ws + WS_LROW), (const float*)(F.ws + WS_LW), (bf16*)(F.ws + WS_YT), (const LAS unsigned*)(F.lds + TAB_ROWS)};
        pg8::gemm_phase<ProbDown, EpiDown, MoeOrder, true>(F.lds + RING_OFF, P, S, E);
        if (BOTH(8)) GRID_BAR();
    }
    if (IN(9)) { p9_final(F, args); }
#undef IN
#undef BOTH
}


#if DEBUG_CHECKS
constexpr size_t WS_DBG = 490 * MiB;
constexpr int CW_DBG = 200000;
constexpr int NSAMP = 512;
__device__ __forceinline__ int samp_row(int i) { return 64 * i + ((i * 7) & 63); }
__device__ __forceinline__ float bfr(float v) { return bf_lo(cvtpk(v, 0.f) & 0xffffu); }
__device__ __forceinline__ float ldbf(const bf16* p) { return __uint_as_float((unsigned)(*p) << 16); }
__device__ __forceinline__ float f8dec(unsigned char b) { return __builtin_amdgcn_cvt_f32_fp8((int)b, 0); }
__device__ __forceinline__ float f8r(float v) { return f8dec((unsigned char)(pk4_fp8(v, 0.f, 0.f, 0.f) & 0xffu)); }
__device__ __forceinline__ void dbg_acc(unsigned char* ws, int k, float err, float ref) { float* a = (float*)(ws + WS_CTL) + CW_DBG; atomicAdd(a + 2 * k, err * err); atomicAdd(a + 2 * k + 1, ref * ref); }
__device__ __forceinline__ float block_sum256(float v, float* sh) {
    v = wave_sum(v); __syncthreads(); if ((threadIdx.x & 63) == 0) sh[threadIdx.x >> 6] = v; __syncthreads(); const float r = sh[0] + sh[1] + sh[2] + sh[3]; __syncthreads(); return r; }
__global__ void __launch_bounds__(256) chk_h1(Args a) {
    __shared__ float sh[8];
    const int row = samp_row(blockIdx.x), b = row / SEQ, t = threadIdx.x;
    float sc[4], shf[4];
#pragma unroll
    for (int q = 0; q < 4; ++q) { sc[q] = a.in[I_BADA][D + t + 256 * q]; shf[q] = a.in[I_BADA][t + 256 * q]; }
    for (int k = 0; k < D; ++k) { const float cv = a.in[I_C][b * D + k]; const float cs = cv / (1.0f + expf(-cv));
#pragma unroll
        for (int q = 0; q < 4; ++q) { sc[q] += cs * a.in[I_WADA][(size_t)k * 6 * D + D + t + 256 * q]; shf[q] += cs * a.in[I_WADA][(size_t)k * 6 * D + t + 256 * q]; } }
    float ss = 0.f; float xv[4];
#pragma unroll
    for (int q = 0; q < 4; ++q) { xv[q] = a.in[I_X][(size_t)row * D + t + 256 * q]; ss += xv[q] * xv[q]; }
    const float rinv = 1.0f / sqrtf(block_sum256(ss, sh) / D + EPS);
    const bf16* h1 = (const bf16*)(a.ws + WS_A);
#pragma unroll
    for (int q = 0; q < 4; ++q) { const int c = t + 256 * q; const float ref = xv[q] * rinv * a.in[I_N1G][c] * (1.0f + sc[q]) + shf[q]; dbg_acc(a.ws, 0, ldbf(h1 + (size_t)row * D + c) - ref, ref); }
}
__global__ void __launch_bounds__(256) chk_inproj(Args a) {
    const int idx = blockIdx.x * 256 + threadIdx.x; if (idx >= NSAMP * INW) return;
    const int row = samp_row(idx / INW), n = idx % INW;
    const bf16* h1 = (const bf16*)(a.ws + WS_A); float s = 0.f;
    if (n < NBF) { for (int k = 0; k < D; ++k) s += ldbf(h1 + (size_t)row * D + k) * bfr(a.in[I_WIN][(size_t)k * INW + n]); }
    else { for (int k = 0; k < D; ++k) s += f8dec(((const unsigned char*)(a.ws + WS_H1F8))[(size_t)row * D + k]) * f8r(a.in[I_WIN][(size_t)k * INW + n] * WGU_SCALE); s *= 1.0f / WGU_SCALE; }
    float ref, got;
    if (n < 512) { ref = s * QSCALE; got = ldbf((const bf16*)(a.ws + WS_Q) + (size_t)row * NQ + n); }
    else if (n < 768) { ref = s; got = ldbf((const bf16*)(a.ws + WS_KV) + (size_t)row * NKV + n - 512); }
    else if (n < 1280) { ref = 0.5f * s * (1.0f + tanhf(0.7978845608f * (s + 0.044715f * s * s * s))); got = ldbf((const bf16*)(a.ws + WS_GU) + (size_t)row * GMW + n - 768); }
    else if (n < 1792) { ref = 0.5f * s * (1.0f + tanhf(0.7978845608f * (s + 0.044715f * s * s * s))); got = ldbf((const bf16*)(a.ws + WS_GV) + (size_t)row * GMW + n - 1280); }
    else if (n < 2816) { ref = 1.0f / (1.0f + expf(-s)); got = (float)((const unsigned char*)(a.ws + WS_GA))[(size_t)row * D + n - 1792] * (1.0f / 255.0f); }
    else { ref = fmaxf(1.0f / (1.0f + expf(-s)), 1.0f / 255.0f); got = (float)((const unsigned char*)(a.ws + WS_GB))[(size_t)row * D + n - 2816] * (1.0f / 255.0f); }
    dbg_acc(a.ws, 1, got - ref, ref);
}
__global__ void __launch_bounds__(256) chk_attn(Args a) {
    const int idx = blockIdx.x * 256 + threadIdx.x; if (idx >= NSAMP * 8 * 4) return;
    const int row = samp_row(idx / 32), head = (idx >> 2) & 7, dq = idx & 3, b = row / SEQ, tpos = row % SEQ, blk = tpos / 128, kvh = head >> 2;
    const bf16* Q = (const bf16*)(a.ws + WS_Q); const bf16* KV = (const bf16*)(a.ws + WS_KV); const int* pos = (const int*)a.in[I_POS];
    const int band0 = b * SEQ + blk * 128 - 128;
    const int i = tpos % 128;
    float m = a.in[I_SINKS][head], l = 0.f; float o[16];
#pragma unroll
    for (int d = 0; d < 16; ++d) o[d] = 0.f;
    for (int kj = i + 1; kj <= i + 128; ++kj) { if (blk == 0 && kj < 128) continue; const int kr = band0 + kj;
        float s = 0.f; for (int d = 0; d < 64; ++d) s += ldbf(Q + (size_t)row * NQ + head * 64 + d) * ldbf(KV + (size_t)kr * NKV + kvh * 64 + d);
        s *= (1.0f / LOG2E);
        int n = pos[row] - pos[kr]; if (n < 0) n = 0; int bucket; if (n < 16) bucket = n; else { bucket = 16 + (int)(logf((float)n / 16.0f) / logf(8.0f) * 16.0f); if (bucket > 31) bucket = 31; }
        s += a.in[I_RELB][bucket * 8 + head]; m = fmaxf(m, s); }
    for (int kj = i + 1; kj <= i + 128; ++kj) { if (blk == 0 && kj < 128) continue; const int kr = band0 + kj;
        float s = 0.f; for (int d = 0; d < 64; ++d) s += ldbf(Q + (size_t)row * NQ + head * 64 + d) * ldbf(KV + (size_t)kr * NKV + kvh * 64 + d);
        s *= (1.0f / LOG2E);
        int n = pos[row] - pos[kr]; if (n < 0) n = 0; int bucket; if (n < 16) bucket = n; else { bucket = 16 + (int)(logf((float)n / 16.0f) / logf(8.0f) * 16.0f); if (bucket > 31) bucket = 31; }
        s += a.in[I_RELB][bucket * 8 + head]; const float p = expf(s - m); l += p;
#pragma unroll
        for (int d = 0; d < 16; ++d) o[d] += p * ldbf(KV + (size_t)kr * NKV + 128 + kvh * 64 + dq * 16 + d); }
    l += expf(a.in[I_SINKS][head] - m);
    const bf16* yab = (const bf16*)(a.ws + WS_YAB);
#pragma unroll
    for (int d = 0; d < 16; ++d) { const float ref = o[d] / l; dbg_acc(a.ws, 2, ldbf(yab + (size_t)row * D + head * 64 + dq * 16 + d) - ref, ref); }
}
__global__ void __launch_bounds__(512) chk_gmlp(Args a) {
    __shared__ float sh[16];
    const int row = samp_row(blockIdx.x), c = threadIdx.x, g = c >> 7, r0 = row & ~127, t = row & 127;
    const bf16* GU = (const bf16*)(a.ws + WS_GU); const bf16* GV = (const bf16*)(a.ws + WS_GV);
    float acc = 0.f;
    for (int s = 0; s <= t; ++s) { const float v = ldbf(GV + (size_t)(r0 + s) * GMW + c);
        float x = wave_sum(v); __syncthreads(); if ((c & 63) == 0) sh[c >> 6] = x; __syncthreads(); float tot = 0.f; for (int w = 0; w < 8; ++w) tot += sh[w]; const float mu = tot / GMW;
        x = wave_sum((v - mu) * (v - mu)); __syncthreads(); if ((c & 63) == 0) sh[c >> 6] = x; __syncthreads(); tot = 0.f; for (int w = 0; w < 8; ++w) tot += sh[w]; const float rstd = 1.0f / sqrtf(tot / GMW + EPS);
        const float vn = bfr((v - mu) * rstd * a.in[I_LNG][c] + a.in[I_LNB][c]);
        acc += bfr(a.in[I_GWS][((size_t)g * 128 + t) * 128 + s]) * vn; }
    const float ref = ldbf(GU + (size_t)row * GMW + c) * (acc + a.in[I_GBS][g * 128 + t]);
    dbg_acc(a.ws, 3, ldbf((const bf16*)(a.ws + WS_YAB) + (size_t)row * D + NQ + c) - ref, ref);
}
__global__ void __launch_bounds__(256) chk_merge(Args a) {
    const int idx = blockIdx.x * 256 + threadIdx.x; if (idx >= NSAMP * D) return;
    const int row = samp_row(idx / D), n = idx % D; const bf16* yab = (const bf16*)(a.ws + WS_YAB);
    float sa = 0.f, sb = 0.f;
    for (int k = 0; k < 512; ++k) { sa += ldbf(yab + (size_t)row * D + k) * bfr(a.in[I_PA][(size_t)k * D + n]); sb += ldbf(yab + (size_t)row * D + 512 + k) * bfr(a.in[I_PB][(size_t)k * D + n]); }
    const float ref = (float)((const unsigned char*)(a.ws + WS_GA))[(size_t)row * D + n] * (1.0f / 255.0f) * sa + (float)((const unsigned char*)(a.ws + WS_GB))[(size_t)row * D + n] * (1.0f / 255.0f) * sb;
    dbg_acc(a.ws, 4, ldbf((const bf16*)(a.ws + WS_A) + (size_t)row * D + n) - ref, ref);
}
__global__ void __launch_bounds__(256) chk_wo(Args a) {
    const int idx = blockIdx.x * 256 + threadIdx.x; if (idx >= NSAMP * D) return;
    const int row = samp_row(idx / D), n = idx % D, b = row / SEQ; const bf16* mg = (const bf16*)(a.ws + WS_A);
    float s = 0.f; for (int k = 0; k < D; ++k) s += ldbf(mg + (size_t)row * D + k) * bfr(a.in[I_WO][(size_t)k * D + n]);
    const float ref = a.in[I_X][(size_t)row * D + n] + ((const float*)(a.ws + WS_MOD))[(size_t)b * 6 * D + 2 * D + n] * s;
    dbg_acc(a.ws, 5, ldbf((const bf16*)(a.ws + WS_XMID) + (size_t)row * D + n) - ref, ref);
}
__global__ void __launch_bounds__(256) chk_router(Args a) {
    __shared__ float sh[8]; __shared__ float lgt[36];
    const int row = samp_row(blockIdx.x), b = row / SEQ, t = threadIdx.x; const float* mod = (const float*)(a.ws + WS_MOD);
    float xv[4], hv[4], ss = 0.f;
#pragma unroll
    for (int q = 0; q < 4; ++q) { xv[q] = ldbf((const bf16*)(a.ws + WS_XMID) + (size_t)row * D + t + 256 * q); ss += xv[q] * xv[q]; }
    const float rinv = 1.0f / sqrtf(block_sum256(ss, sh) / D + EPS);
#pragma unroll
    for (int q = 0; q < 4; ++q) { const int c = t + 256 * q; hv[q] = xv[q] * rinv * a.in[I_N2G][c] * (1.0f + mod[(size_t)b * 6 * D + 4 * D + c]) + mod[(size_t)b * 6 * D + 3 * D + c];
        dbg_acc(a.ws, 6, f8dec(((const unsigned char*)(a.ws + WS_H2))[(size_t)row * D + c]) - f8r(hv[q]), hv[q]); }
    for (int n = 0; n < 36; ++n) { float p = 0.f;
#pragma unroll
        for (int q = 0; q < 4; ++q) { const int c = t + 256 * q; p += hv[q] * (n < 4 ? a.in[I_WRG][c * 4 + n] : a.in[I_WRE][c * 32 + n - 4]); }
        const float tot = block_sum256(p, sh); if (t == 0) lgt[n] = tot + (n < 4 ? a.in[I_BRG][n] : a.in[I_BRE][n - 4]); }
    __syncthreads();
    if (t == 0) { int gi = 0; for (int n = 1; n < 4; ++n) if (lgt[n] > lgt[gi]) gi = n; float gs = 0.f; for (int n = 0; n < 4; ++n) gs += expf(lgt[n] - lgt[gi]); const float pg = 1.0f / gs;
        int i1 = 0; for (int j = 1; j < 8; ++j) if (lgt[4 + 8 * gi + j] > lgt[4 + 8 * gi + i1]) i1 = j; int i2 = -1; for (int j = 0; j < 8; ++j) if (j != i1 && (i2 < 0 || lgt[4 + 8 * gi + j] > lgt[4 + 8 * gi + i2])) i2 = j;
        const float ex = expf(lgt[4 + 8 * gi + i2] - lgt[4 + 8 * gi + i1]), w1 = pg / (1.0f + ex), w2 = pg * ex / (1.0f + ex);
        const float* rec = (const float*)(a.ws + WS_DBG) + (size_t)row * 4;
        const bool same = ((int)rec[0] == gi * 8 + i1) && ((int)rec[1] == gi * 8 + i2);
        dbg_acc(a.ws, 7, same ? 0.f : 1.f, 1.f);
        if (same) { dbg_acc(a.ws, 8, rec[2] - w1, w1); dbg_acc(a.ws, 8, rec[3] - w2, w2); } }
}
__global__ void __launch_bounds__(256) chk_moe(Args a) {
    __shared__ float hs[D]; __shared__ float act[DEXP];
    const int row = samp_row(blockIdx.x >> 1), k = blockIdx.x & 1, t = threadIdx.x;
    const float* rec = (const float*)(a.ws + WS_DBG) + (size_t)row * 4; const int e = (int)rec[k]; const float w = rec[2 + k];
    for (int c = t; c < D; c += 256) hs[c] = f8dec(((const unsigned char*)(a.ws + WS_H2))[(size_t)row * D + c]);
    __syncthreads();
    for (int j = t; j < DEXP; j += 256) { float gsum = 0.f, usum = 0.f; for (int c = 0; c < D; ++c) { gsum += hs[c] * f8r(a.in[I_WG][((size_t)e * D + c) * DEXP + j] * WGU_SCALE); usum += hs[c] * f8r(a.in[I_WU][((size_t)e * D + c) * DEXP + j] * WGU_SCALE); }
        gsum *= 1.0f / WGU_SCALE; usum *= 1.0f / WGU_SCALE;
        act[j] = f8r(gsum / (1.0f + expf(-gsum)) * usum); }
    __syncthreads();
    for (int n = t; n < D; n += 256) { float s = 0.f; for (int j = 0; j < DEXP; ++j) s += act[j] * f8r(a.in[I_WDN][((size_t)e * DEXP + j) * D + n] * WD_SCALE);
        const float ref = w * s * (1.0f / WD_SCALE); dbg_acc(a.ws, 9, ldbf((const bf16*)(a.ws + WS_YT) + ((size_t)row * 2 + k) * D + n) - ref, ref); }
}
__global__ void __launch_bounds__(256) chk_final(Args a) {
    __shared__ float sh[8];
    const int row = samp_row(blockIdx.x), b = row / SEQ, t = threadIdx.x; const float* mod = (const float*)(a.ws + WS_MOD);
    float v[4], ss = 0.f;
#pragma unroll
    for (int q = 0; q < 4; ++q) { const int c = t + 256 * q; v[q] = ldbf((const bf16*)(a.ws + WS_XMID) + (size_t)row * D + c) + mod[(size_t)b * 6 * D + 5 * D + c] * (ldbf((const bf16*)(a.ws + WS_YT) + (size_t)row * 2 * D + c) + ldbf((const bf16*)(a.ws + WS_YT) + (size_t)row * 2 * D + D + c)); ss += v[q] * v[q]; }
    const float rinv = 1.0f / sqrtf(block_sum256(ss, sh) / D + EPS);
#pragma unroll
    for (int q = 0; q < 4; ++q) { const int c = t + 256 * q; const float ref = v[q] * rinv * a.in[I_FG][c]; dbg_acc(a.ws, 10, a.out[(size_t)row * D + c] - ref, ref); }
}
__global__ void __launch_bounds__(256) chk_report(Args a) {
    const float* acc = (const float*)(a.ws + WS_CTL) + CW_DBG; int code = 0;
    for (int k = 10; k >= 0; --k) { if (k < DBG_FIRST) continue; const float tol = (k == 7) ? 0.02f : 1e-3f; if (!(acc[2 * k] <= tol * acc[2 * k + 1])) code = k + 1; }
    const float f = 1.0f + 0.5f * (float)code;
    for (size_t i = (size_t)blockIdx.x * 256 + threadIdx.x; i < (size_t)M * D; i += (size_t)gridDim.x * 256) a.out[i] *= f;
}
#endif

extern "C" void kernel_launch(void* const* d_in, const int* in_sizes, int n_in, void* d_out, int out_size, void* d_ws, size_t ws_size, hipStream_t stream) {
    static int grid = 0;
    if (grid == 0) {
        if (n_in != 25 || in_sizes[0] != M * D || out_size != M * D || ws_size < WS_END) { fprintf(stderr, "kernel_launch: unexpected shapes (n_in %d, in0 %d, out %d, ws %zu); nothing launched\n", n_in, n_in > 0 ? in_sizes[0] : -1, out_size, ws_size); grid = -1; return; }
        int dev = 0, cus = 0, per_cu = 0;
        if (hipGetDevice(&dev) != hipSuccess || hipDeviceGetAttribute(&cus, hipDeviceAttributeMultiprocessorCount, dev) != hipSuccess) { grid = -1; return; }
        if (hipFuncSetAttribute((const void*)mk_fwd, hipFuncAttributeMaxDynamicSharedMemorySize, LDS_BYTES) != hipSuccess) { fprintf(stderr, "kernel_launch: hipFuncSetAttribute failed\n"); grid = -1; return; }
        if (hipOccupancyMaxActiveBlocksPerMultiprocessor(&per_cu, (const void*)mk_fwd, NWAVES * 64, LDS_BYTES) != hipSuccess || per_cu < 1) fprintf(stderr, "kernel_launch: occupancy query reports %d\n", per_cu);
        (void)hipGetLastError();
        grid = cus;
    }
    if (grid < 0) return;
    if (hipMemsetAsync((char*)d_ws + WS_CTL, 0, DEBUG_CHECKS ? (size_t)(1 * MiB) : CTL_ZERO_BYTES, stream) != hipSuccess) return;
    Args a{};
    for (int i = 0; i < 25; ++i) a.in[i] = (const float*)d_in[i];
    a.out = (float*)d_out; a.ws = (unsigned char*)d_ws;
    if (MK_N_LAUNCHES == 1) { a.ph_lo = 0; a.ph_hi = N_PHASES; a.li = 0; hipLaunchKernelGGL(mk_fwd, dim3(grid), dim3(NWAVES * 64), LDS_BYTES, stream, a); }
    else for (int li = 0; li < RUN_PHASES; ++li) { a.ph_lo = li; a.ph_hi = li + 1; a.li = li; hipLaunchKernelGGL(mk_fwd, dim3(grid), dim3(NWAVES * 64), LDS_BYTES, stream, a);
#if DEBUG_CHECKS
        if (li == 2) { hipLaunchKernelGGL(chk_h1, dim3(NSAMP), dim3(256), 0, stream, a); hipLaunchKernelGGL(chk_inproj, dim3(NSAMP * INW / 256), dim3(256), 0, stream, a); }
        if (li == 3) { hipLaunchKernelGGL(chk_attn, dim3(NSAMP * 32 / 256), dim3(256), 0, stream, a); hipLaunchKernelGGL(chk_gmlp, dim3(NSAMP), dim3(512), 0, stream, a); }
        if (li == 4) hipLaunchKernelGGL(chk_merge, dim3(NSAMP * D / 256), dim3(256), 0, stream, a);
        if (li == 5) hipLaunchKernelGGL(chk_wo, dim3(NSAMP * D / 256), dim3(256), 0, stream, a);
        if (li == 6) hipLaunchKernelGGL(chk_router, dim3(NSAMP), dim3(256), 0, stream, a);
        if (li == 8) hipLaunchKernelGGL(chk_moe, dim3(NSAMP * 2), dim3(256), 0, stream, a);
        if (li == 9) { hipLaunchKernelGGL(chk_final, dim3(NSAMP), dim3(256), 0, stream, a); hipLaunchKernelGGL(chk_report, dim3(2048), dim3(256), 0, stream, a); }
#endif
    }
}
```

```cpp
#include <hip/hip_runtime.h>
#include <cstdio>
#include <cstdint>
#include <cmath>
#include <type_traits>

#ifndef MK_N_LAUNCHES
#define MK_N_LAUNCHES 1
#endif

#ifndef DEBUG_CHECKS
#define DEBUG_CHECKS 0
#endif
#ifndef DBG_FIRST
#define DBG_FIRST 0
#endif
#ifndef RUN_PHASES
#define RUN_PHASES 10
#endif
#define GAS __attribute__((address_space(1)))
#define LAS __attribute__((address_space(3)))
typedef unsigned short bf16;
typedef short bf16x8 __attribute__((ext_vector_type(8)));
typedef short s16x4 __attribute__((ext_vector_type(4)));
typedef float f32x2 __attribute__((ext_vector_type(2)));
typedef float f32x4 __attribute__((ext_vector_type(4)));
typedef float f32x16 __attribute__((ext_vector_type(16)));
typedef unsigned u32x2 __attribute__((ext_vector_type(2)));
typedef unsigned u32x4 __attribute__((ext_vector_type(4)));
typedef __bf16 bf16x2_t __attribute__((ext_vector_type(2)));
typedef GAS unsigned gu32;

constexpr int BATCH = 8, SEQ = 4096, D = 1024, M = BATCH * SEQ;
constexpr int NQ = 512, NKV = 256  , GMW = 512, INW = 3840;
constexpr int NEXP = 32, DEXP = 512;
constexpr float EPS = 1e-6f;
constexpr float LOG2E = 1.4426950408889634f;
constexpr float QSCALE = 0.125f * LOG2E;
constexpr int LIST_CAP = 32768;
constexpr int HACT_ROWS = 73728;

constexpr size_t MiB = 1u << 20;
constexpr size_t WS_CTL = 0, CTL_ZERO_BYTES = 32 * 1024;
constexpr size_t WS_MOD = 1 * MiB;
constexpr size_t WS_MODP = 1 * MiB + 256 * 1024;
constexpr size_t WS_WST = 4 * MiB + 512 * 1024;
constexpr size_t WS_LROW = 5 * MiB;
constexpr size_t WS_LW = 9 * MiB;
constexpr size_t WS_GT = 13 * MiB;
constexpr size_t WS_GC = 13 * MiB + 800 * 1024;
constexpr size_t WS_WIN = 14 * MiB;
constexpr size_t WS_WIN8 = 18 * MiB;
constexpr size_t WS_H1F8 = 186 * MiB;
#ifndef GUGV_FP8
#define GUGV_FP8 1
#endif
constexpr int NBF = GUGV_FP8 ? 768 : 1792;
constexpr size_t WS_PA = 22 * MiB;
constexpr size_t WS_WO = 24 * MiB;
constexpr size_t WS_WGU = 26 * MiB;
constexpr size_t WS_WD = 90 * MiB;
constexpr size_t WS_A = 122 * MiB;
constexpr size_t WS_YAB = 186 * MiB;
constexpr size_t WS_YT = 122 * MiB;
constexpr size_t WS_Q = 250 * MiB;
constexpr size_t WS_KV = 282 * MiB;
constexpr size_t WS_GU = 298 * MiB, WS_GV = 330 * MiB;
constexpr size_t WS_T = 298 * MiB;
constexpr size_t WS_HACT = 250 * MiB;
constexpr size_t WS_GA = 362 * MiB;
constexpr size_t WS_XMID = 362 * MiB;
constexpr size_t WS_GB = 426 * MiB;
constexpr size_t WS_H2 = 426 * MiB;
constexpr size_t WS_END = 490 * MiB;
static_assert(WS_HACT + (size_t)HACT_ROWS * 1024 <= WS_GA, "HACT overlay");
constexpr int CW_TMO = 0, CW_CODE = 1;
constexpr int CW_CNT = 1024;
constexpr int CW_BAR = 4096;

constexpr int RING_OFF = 0, RING_BYTES = 131072;
constexpr int LDSCTL_OFF = RING_BYTES, MISC_OFF = LDSCTL_OFF + 320;
constexpr int TAB_OFF = RING_BYTES + 512;
constexpr int TAB_UNITS = TAB_OFF, TAB_CNT = TAB_OFF + 256, TAB_ROWS = TAB_OFF + 1024, MAX_WG_UNITS = 14;
constexpr int CSH_OFF = TAB_ROWS + MAX_WG_UNITS * 1024;
constexpr int LDS_BYTES = CSH_OFF + 16384;
static_assert(CSH_OFF % 16 == 0 && LDS_BYTES <= 163840 - 256, "LDS map");
constexpr int NWAVES = 8;
constexpr int N_PHASES = 10;

#define LDS_WAIT() asm volatile("s_waitcnt lgkmcnt(0)" ::: "memory")
#define VM_WAIT() asm volatile("s_waitcnt vmcnt(0)" ::: "memory")
#define RLX_AGENT __ATOMIC_RELAXED, __HIP_MEMORY_SCOPE_AGENT
__device__ __forceinline__ unsigned cvtpk(float lo, float hi) { f32x2 v = {lo, hi}; bf16x2_t b = __builtin_convertvector(v, bf16x2_t); return __builtin_bit_cast(unsigned, b); }
__device__ __forceinline__ float bf_lo(unsigned w) { return __uint_as_float(w << 16); }
__device__ __forceinline__ float bf_hi(unsigned w) { return __uint_as_float(w & 0xffff0000u); }
__device__ __forceinline__ float wave_sum(float v) {
    int x = __float_as_int(v);
#define WS_DPP(ctrl, rmask) x = __float_as_int(__int_as_float(x) + __int_as_float(__builtin_amdgcn_update_dpp(0, x, (ctrl), (rmask), 0xf, false)))
    WS_DPP(0xB1, 0xf);
    WS_DPP(0x4E, 0xf);
    WS_DPP(0x141, 0xf);
    WS_DPP(0x140, 0xf);
    WS_DPP(0x142, 0xa);
    WS_DPP(0x143, 0xc);
#undef WS_DPP
    return __int_as_float(__builtin_amdgcn_readlane(x, 63));
}
__device__ __forceinline__ float clamp448(float v) { return __builtin_amdgcn_fmed3f(v, -448.0f, 448.0f); }
__device__ __forceinline__ unsigned pk4_fp8(float a, float b, float c, float d) {
    unsigned r = 0; r = __builtin_amdgcn_cvt_pk_fp8_f32(clamp448(a), clamp448(b), r, false); r = __builtin_amdgcn_cvt_pk_fp8_f32(clamp448(c), clamp448(d), r, true); return r; }
__device__ __forceinline__ u32x2 pack8_fp8(const f32x4 a, const f32x4 b) { u32x2 w; w.x = pk4_fp8(a[0], a[1], a[2], a[3]); w.y = pk4_fp8(b[0], b[1], b[2], b[3]); return w; }
constexpr float WGU_SCALE = 64.0f, WD_SCALE = 32.0f;
__device__ __forceinline__ unsigned pk4_u8(float a, float b, float c, float d) {
    return (unsigned)(a * 255.0f + 0.5f) | ((unsigned)(b * 255.0f + 0.5f) << 8) | ((unsigned)(c * 255.0f + 0.5f) << 16) | ((unsigned)(d * 255.0f + 0.5f) << 24); }
__device__ __forceinline__ void unpack8_u8(const u32x2 w, f32x4& a, f32x4& b) {
    a = (f32x4){(float)(w.x & 0xffu), (float)((w.x >> 8) & 0xffu), (float)((w.x >> 16) & 0xffu), (float)(w.x >> 24)};
    b = (f32x4){(float)(w.y & 0xffu), (float)((w.y >> 8) & 0xffu), (float)((w.y >> 16) & 0xffu), (float)(w.y >> 24)}; }
__device__ __forceinline__ float sigmoid_f(float x) { return __builtin_amdgcn_rcpf(1.0f + __builtin_amdgcn_exp2f(-x * LOG2E)); }
__device__ __forceinline__ float gelu_tanh_f(float x) {
    const float t = x * __builtin_fmaf(x * x, -2.3022081987f * 0.044715f, -2.3022081987f);
    return x * __builtin_amdgcn_rcpf(1.0f + __builtin_amdgcn_exp2f(t));
}
__device__ __forceinline__ f32x2 exp2_2(const f32x2 v) { return (f32x2){__builtin_amdgcn_exp2f(v.x), __builtin_amdgcn_exp2f(v.y)}; }
__device__ __forceinline__ f32x2 rcp_2(const f32x2 v) { return (f32x2){__builtin_amdgcn_rcpf(v.x), __builtin_amdgcn_rcpf(v.y)}; }
__device__ __forceinline__ f32x2 lo2(const f32x4 v) { return __builtin_shufflevector(v, v, 0, 1); }
__device__ __forceinline__ f32x2 hi2(const f32x4 v) { return __builtin_shufflevector(v, v, 2, 3); }
__device__ __forceinline__ f32x4 cat2(const f32x2 a, const f32x2 b) { return __builtin_shufflevector(a, b, 0, 1, 2, 3); }
__device__ __forceinline__ f32x2 gelu_tanh_2(const f32x2 x) {
    const f32x2 c1 = {-2.3022081987f, -2.3022081987f}, c2 = {-2.3022081987f * 0.044715f, -2.3022081987f * 0.044715f};
    const f32x2 t = x * __builtin_elementwise_fma(x * x, c2, c1);
    return x * rcp_2(exp2_2(t) + 1.0f); }
__device__ __forceinline__ f32x4 gelu_tanh_4(const f32x4 v) { return cat2(gelu_tanh_2(lo2(v)), gelu_tanh_2(hi2(v))); }
template <bool LO1> __device__ __forceinline__ unsigned sigcode_4(const f32x4 t) {
    const f32x2 k = {1.0f / 255.0f, 1.0f / 255.0f};
    f32x2 a = rcp_2(__builtin_elementwise_fma(exp2_2(lo2(t)), k, k)), b = rcp_2(__builtin_elementwise_fma(exp2_2(hi2(t)), k, k));
    if (LO1) { a.x = fmaxf(a.x, 1.0f); a.y = fmaxf(a.y, 1.0f); b.x = fmaxf(b.x, 1.0f); b.y = fmaxf(b.y, 1.0f); }
    unsigned w = 0u; w = __builtin_amdgcn_cvt_pk_u8_f32(a.x, 0, w); w = __builtin_amdgcn_cvt_pk_u8_f32(a.y, 1, w); w = __builtin_amdgcn_cvt_pk_u8_f32(b.x, 2, w); w = __builtin_amdgcn_cvt_pk_u8_f32(b.y, 3, w); return w; }
__device__ __forceinline__ float silu_f(float x) { return x * __builtin_amdgcn_rcpf(1.0f + __builtin_amdgcn_exp2f(-x * LOG2E)); }

namespace pg8 {
constexpr int BM = 256, BK = 64, HALF = 128, HTB = HALF * BK * 2, STAGE_BYTES = 8 * HTB, NXCD = 8, WGM = 8;
__host__ __device__ __forceinline__ int lds_byte(int r, int c) { const int st = (r >> 4) * 2 + (c >> 5), rr = r & 15, cc = c & 31, ob = rr * 64 + cc * 2; return st * 1024 + (ob ^ (((ob >> 9) & 1) << 5)); }
__host__ __device__ __forceinline__ void stage_rc(int b, int& R, int& C) { const int st = b / 1024, sb = b % 1024, swz = sb ^ (((sb >> 9) & 1) << 5); R = (st >> 1) * 16 + swz / 64; C = (st & 1) * 32 + (swz % 64) / 2; }
__host__ __device__ __forceinline__ int perm32(int rho) { const int n = rho >> 4, i = rho & 15; return 8 * (i >> 2) + 4 * n + (i & 3); }

struct Unit { int pm, pn, v, e, ui; };

struct DenseOrder {
    int nM, nN, nwg, G, c;
    __device__ void init(int M_, int N_, int G_, int c_) { nM = M_ / BM; nN = N_ / BM; nwg = nM * nN; G = G_; c = c_; }
    __device__ bool tile(int i, Unit& u) const { return tileL((long)i * G + c, u); }
    __device__ bool tileL(long L, Unit& u) const {
        if (L >= nwg) return false;
        int wgid = (int)L; { const int q = nwg / NXCD, r = nwg % NXCD, xcd = wgid % NXCD, off = wgid / NXCD; wgid = (xcd < r ? xcd * (q + 1) : r * (q + 1) + (xcd - r) * q) + off; }
        const int nig = WGM * nN, gid = wgid / nig, fm = gid * WGM, gsz = (nM - fm) < WGM ? (nM - fm) : WGM;
        u.pm = fm + ((wgid % nig) % gsz); u.pn = (wgid % nig) / gsz; u.v = 0; u.e = 0; u.ui = 0; return true;
    }
    __device__ bool next(int i, Unit& u) const { return tile(i, u); }
};
struct BackfillOrder : DenseOrder {
    __device__ bool next(int i, Unit& u) const {
        const int full = 3;
        if (i < full) return tileL((long)i * G + c, u);
        if (c >= G / 2) return tileL((long)full * G + (long)(i - full) * (G - G / 2) + (c - G / 2), u);
        return false; }
};

template <class Prob, class Epi, class Sched, bool ALIGN_EPI>
__device__ __forceinline__ void gemm_phase(LAS unsigned char* lds, const Prob& P, const Sched& S, const Epi& E) {
    const int tid = threadIdx.x, wid = __builtin_amdgcn_readfirstlane(tid >> 6), lane = tid & 63, wr = wid >> 2, wc = wid & 3, fr = lane & 15, fq = lane >> 4;
    const int nt = P.Kb / 128;
    int Rr[2], Cc[2]; unsigned voffB[2], aoc[2][2], aon[2][2];
#pragma unroll
    for (int i = 0; i < 2; ++i) { int R, C; stage_rc(tid * 16 + i * 8192, R, C); Rr[i] = R; Cc[i] = C; const int Rb = Epi::PERM ? ((R & ~31) + perm32(R & 31)) : R;
        voffB[i] = (unsigned)Rb * P.ldb + (unsigned)C * 2u; }
    const size_t kstep = (size_t)(BK * 2);
    const size_t hstepB = (size_t)HALF * P.ldb;
    const unsigned ldsw = (unsigned)wid * 1024u;
    const int aoff = lds_byte(wr * 64 + fr, fq * 8), boff = lds_byte(wc * 32 + fr, fq * 8);
#define PG8_SA(b, h) (((b) * 2 + (h)) * HTB)
#define PG8_SB(b, h) ((4 + (b) * 2 + (h)) * HTB)
#define PG8_STG(bufoff, p0, p1) do { \
        __builtin_amdgcn_global_load_lds((const unsigned*)(p0), (LAS unsigned*)(lds + (bufoff) + ldsw), 16, 0, 0); \
        __builtin_amdgcn_global_load_lds((const unsigned*)(p1), (LAS unsigned*)(lds + (bufoff) + ldsw + 8192), 16, 0, 0); } while (0)
#define PG8_STGB(bufoff, base) PG8_STG(bufoff, (base) + voffB[0], (base) + voffB[1])
#define PG8_STGA(bufoff, base, off, h) PG8_STG(bufoff, (base) + off[h][0], (base) + off[h][1])
#define PG8_LDF(dst, addr) do { if constexpr (Prob::F8) { const i32x4 lo_ = *(const LAS i32x4*)(addr), hi_ = *(const LAS i32x4*)((addr) + 1024); dst.v = __builtin_shufflevector(lo_, hi_, 0, 1, 2, 3, 4, 5, 6, 7); } \
        else { dst.k[0] = *(const LAS bf16x8*)(addr); dst.k[1] = *(const LAS bf16x8*)((addr) + 1024); } } while (0)
#define PG8_LDA(dst, b, h) do { _Pragma("unroll") for (int m = 0; m < 4; ++m) PG8_LDF(dst[m], lds + PG8_SA(b, h) + aoff + m * 2048); } while (0)
#define PG8_LDB(dst, b, h) do { _Pragma("unroll") for (int n = 0; n < 2; ++n) PG8_LDF(dst[n], lds + PG8_SB(b, h) + boff + n * 2048); } while (0)
#define PG8_MMA(ai, bj, At, Bt) do { __builtin_amdgcn_s_setprio(1); _Pragma("unroll") for (int m = 0; m < 4; ++m) _Pragma("unroll") for (int n = 0; n < 2; ++n) { \
        if constexpr (Prob::F8) asm volatile("v_mfma_scale_f32_16x16x128_f8f6f4 %0, %1, %2, %0, %3, %3 op_sel_hi:[0,0,0]" : "+v"(acc[ai][bj][m][n]) : "v"(Bt[n].v), "v"(At[m].v), "v"(f8scale));   \
        else { _Pragma("unroll") for (int k = 0; k < 2; ++k) acc[ai][bj][m][n] = __builtin_amdgcn_mfma_f32_16x16x32_bf16(Bt[n].k[k], At[m].k[k], acc[ai][bj][m][n], 0, 0, 0); } } \
        __builtin_amdgcn_s_setprio(0); } while (0)
#define PG8_WAIT_V(n) asm volatile("s_waitcnt vmcnt(" #n ")" ::: "memory")
#define PG8_WAIT_L(n) asm volatile("s_waitcnt lgkmcnt(" #n ")" ::: "memory")
#define PG8_BAR __builtin_amdgcn_s_barrier()
#define PG8_SCHED __builtin_amdgcn_sched_barrier(0)
#define PG8_AOFF(dst, ui_) do { _Pragma("unroll") for (int h = 0; h < 2; ++h) _Pragma("unroll") for (int i = 0; i < 2; ++i) { \
        if constexpr (Prob::GATHER) dst[h][i] = P.rowtab[(ui_) * 256 + h * HALF + Rr[i]] + (unsigned)Cc[i] * 2u; \
        else dst[h][i] = (unsigned)(h * HALF + Rr[i]) * P.lda + (unsigned)Cc[i] * 2u; } } while (0)
    Unit cur, nxt; int ui = 0;
    if (!S.next(0, cur)) return;
    f32x4 acc[2][2][4][2];
#pragma unroll
    for (int a = 0; a < 2; ++a)
#pragma unroll
        for (int b = 0; b < 2; ++b)
#pragma unroll
            for (int m = 0; m < 4; ++m)
#pragma unroll
                for (int n = 0; n < 2; ++n) acc[a][b][m][n] = (f32x4){0.f, 0.f, 0.f, 0.f};
    typedef int i32x8 __attribute__((ext_vector_type(8))); typedef int i32x4 __attribute__((ext_vector_type(4)));
    struct FragBf { bf16x8 k[2]; }; struct FragF8 { i32x8 v; };
    typedef typename std::conditional<Prob::F8, FragF8, FragBf>::type Frag;
    Frag At[4], B0[2], B1[2];
    int f8scale = Prob::F8 ? Prob::E8M0 : 0x7f7f7f7f; asm volatile("" : "+v"(f8scale));
    const char* cA = P.a_ptr(cur); const char* cB = P.b_ptr(cur);
    PG8_AOFF(aoc, 0);
#pragma unroll
    for (int h = 0; h < 2; ++h)
#pragma unroll
        for (int i = 0; i < 2; ++i) aon[h][i] = aoc[h][i];
    PG8_STGB(PG8_SB(0, 0), cB); PG8_STGB(PG8_SB(0, 1), cB + hstepB); PG8_STGA(PG8_SA(0, 0), cA, aoc, 0); PG8_STGA(PG8_SA(0, 1), cA, aoc, 1);
    if (wr == 1) PG8_BAR;
    PG8_WAIT_V(2); PG8_BAR;
    PG8_STGB(PG8_SB(1, 0), cB + kstep); PG8_STGA(PG8_SA(1, 0), cA + kstep, aoc, 0); PG8_STGB(PG8_SB(1, 1), cB + hstepB + kstep);
    PG8_WAIT_V(6); PG8_BAR;
    for (;;) {
        const bool has_next = S.next(ui + 1, nxt);
        const char* nA = has_next ? P.a_ptr(nxt) : cA; const char* nB = has_next ? P.b_ptr(nxt) : cB;
        for (int t = 0; t < nt; t += 2) {
            const bool last = (t == nt - 2);
            const char* a1 = cA + (size_t)(t + 1) * kstep;
            const char* a2 = last ? nA : cA + (size_t)(t + 2) * kstep; const char* b2 = last ? nB : cB + (size_t)(t + 2) * kstep;
            const char* a3 = a2 + kstep; const char* b3 = b2 + kstep;
            unsigned ao2[2][2];
            if constexpr (Prob::GATHER) {
                if (last && has_next) PG8_AOFF(aon, ui + 1);
#pragma unroll
                for (int h = 0; h < 2; ++h)
#pragma unroll
                    for (int i = 0; i < 2; ++i) ao2[h][i] = (last && has_next) ? aon[h][i] : aoc[h][i];
            } else {
#pragma unroll
                for (int h = 0; h < 2; ++h)
#pragma unroll
                    for (int i = 0; i < 2; ++i) ao2[h][i] = aoc[h][i];
            }
            if constexpr (Epi::MIDK) { if (t == nt / 2) E.mid(acc, cur, wr, wc, fr, fq); }
            PG8_LDB(B0, 0, 0); PG8_LDB(B1, 0, 1); PG8_SCHED; PG8_LDA(At, 0, 0); PG8_STGA(PG8_SA(1, 1), a1, aoc, 1);
            PG8_WAIT_V(8); PG8_WAIT_L(0); PG8_BAR; PG8_MMA(0, 0, At, B0); PG8_MMA(0, 1, At, B1); PG8_BAR; PG8_SCHED;
            PG8_LDA(At, 0, 1); PG8_STGB(PG8_SB(0, 0), b2); PG8_STGB(PG8_SB(0, 1), b2 + hstepB); PG8_STGA(PG8_SA(0, 0), a2, ao2, 0);
            PG8_WAIT_V(8); PG8_WAIT_L(0); PG8_BAR; PG8_MMA(1, 0, At, B0); PG8_MMA(1, 1, At, B1); PG8_BAR; PG8_SCHED;
            PG8_LDB(B0, 1, 0); PG8_LDB(B1, 1, 1); PG8_SCHED; PG8_LDA(At, 1, 0); PG8_STGA(PG8_SA(0, 1), a2, ao2, 1);
            PG8_WAIT_V(8); PG8_WAIT_L(0); PG8_BAR; PG8_MMA(0, 0, At, B0); PG8_MMA(0, 1, At, B1); PG8_BAR; PG8_SCHED;
            PG8_LDA(At, 1, 1); PG8_STGB(PG8_SB(1, 0), b3); PG8_STGB(PG8_SB(1, 1), b3 + hstepB); PG8_STGA(PG8_SA(1, 0), a3, ao2, 0);
            PG8_WAIT_V(8); PG8_WAIT_L(0); PG8_BAR; PG8_MMA(1, 0, At, B0); PG8_MMA(1, 1, At, B1); PG8_BAR; PG8_SCHED;
        }
        if constexpr (ALIGN_EPI) { if (wr == 0) PG8_BAR; }
        if constexpr (Prob::F8) asm volatile("s_nop 15\n\ts_nop 15\n\ts_nop 15" ::: "memory");
        E(acc, cur, wr, wc, fr, fq);
        if (!has_next) break;
#pragma unroll
        for (int a = 0; a < 2; ++a)
#pragma unroll
            for (int b = 0; b < 2; ++b)
#pragma unroll
                for (int m = 0; m < 4; ++m)
#pragma unroll
                    for (int n = 0; n < 2; ++n) acc[a][b][m][n] = (f32x4){0.f, 0.f, 0.f, 0.f};
        cur = nxt; cA = nA; cB = nB; ++ui;
        if constexpr (Prob::GATHER) {
#pragma unroll
            for (int h = 0; h < 2; ++h)
#pragma unroll
                for (int i = 0; i < 2; ++i) aoc[h][i] = aon[h][i];
        }
        if constexpr (ALIGN_EPI) { if (wr == 1) PG8_BAR; }
    }
    PG8_WAIT_V(0);
    if constexpr (!ALIGN_EPI) { if (wr == 0) PG8_BAR; }
    PG8_BAR;
#undef PG8_SA
#undef PG8_SB
#undef PG8_STG
#undef PG8_STGA
#undef PG8_STGB
#undef PG8_LDA
#undef PG8_LDF
#undef PG8_LDB
#undef PG8_MMA
#undef PG8_WAIT_V
#undef PG8_WAIT_L
#undef PG8_BAR
#undef PG8_SCHED
#undef PG8_AOFF
}
}

#define XB_TMO      128
#define XB_XCNT(j)  (256  + 64 * (j))
#define XB_XSUB(j)  (1280 + 64 * (j))
#define XB_XGEN(j)  (2304 + 64 * (j))
#define XB_TOP      3328
#define XB_TOPGEN   3392
#define XCD_BAR_WORDS 3456
#define XB_SPIN_CAP (1u << 18)
__device__ __forceinline__ unsigned xb_ld(unsigned* p)              { return __hip_atomic_load(p, __ATOMIC_RELAXED, __HIP_MEMORY_SCOPE_AGENT); }
__device__ __forceinline__ unsigned xb_add(unsigned* p, unsigned v) { return __hip_atomic_fetch_add(p, v, __ATOMIC_RELAXED, __HIP_MEMORY_SCOPE_AGENT); }
__device__ __forceinline__ unsigned xb_xcc_id() { return (unsigned)__builtin_amdgcn_s_getreg((3 << 11) | 20) & 0xFu; }
#define XB_SPIN(cond, bar) do { unsigned _sp = 0; while (cond) { __builtin_amdgcn_s_sleep(1); \
    if ((++_sp & 255u) == 0u) { if (xb_ld(&(bar)[XB_TMO])) break; if (_sp > XB_SPIN_CAP) { atomicAdd(&(bar)[XB_TMO], 1u); break; } } } } while (0)
struct XcdBarrier { unsigned* bar; unsigned x; volatile LAS unsigned* st; };
__device__ __forceinline__ XcdBarrier xcd_barrier_post(unsigned* bar, volatile LAS unsigned* st) {
    XcdBarrier b; b.bar = bar; b.x = xb_xcc_id(); b.st = st;
    if (threadIdx.x == 0) (void)xb_add(&bar[XB_XCNT(b.x)], 1u);
    return b;
}
__device__ __forceinline__ void xcd_barrier_complete(unsigned* bar, unsigned x, unsigned& nloc, unsigned& nx) {
    const unsigned G = gridDim.x * gridDim.y * gridDim.z;
    unsigned sum, cnt, mine, sp = 0u;
    for (;;) {
        sum = 0u; cnt = 0u; mine = 0u;
#pragma unroll
        for (unsigned j = 0; j < 16; ++j) { const unsigned c = xb_ld(&bar[XB_XCNT(j)]); sum += c; cnt += (c > 0u) ? 1u : 0u; mine = (j == x) ? c : mine; }
        if (sum == G) break;
        __builtin_amdgcn_s_sleep(1);
        if ((++sp & 255u) == 0u) { if (xb_ld(&bar[XB_TMO])) break; if (sp > XB_SPIN_CAP) { atomicAdd(&bar[XB_TMO], 1u); break; } }
    }
    nloc = mine > 0u ? mine : 1u; nx = cnt > 0u ? cnt : 1u;
}
__device__ __forceinline__ void xcd_barrier(const XcdBarrier& b) {
    asm volatile("s_waitcnt vmcnt(0)" ::: "memory");
    __syncthreads();
    if (threadIdx.x == 0) {
        unsigned* bar = b.bar;
        __builtin_amdgcn_s_waitcnt(0);
        unsigned nloc = b.st[0], nx = b.st[1];
        if (nloc == 0u) { xcd_barrier_complete(bar, b.x, nloc, nx); b.st[0] = nloc; b.st[1] = nx; }
        const unsigned old = xb_add(&bar[XB_XSUB(b.x)], 1u);
        const unsigned gen = old / nloc;
        if (old + 1u == (gen + 1u) * nloc) {
            __builtin_amdgcn_fence(__ATOMIC_RELEASE, "agent");
            asm volatile("s_waitcnt vmcnt(0)" ::: "memory");
            const unsigned og = xb_add(&bar[XB_TOP], 1u);
            const unsigned tg = og / nx;
            if (og + 1u == (tg + 1u) * nx) xb_add(&bar[XB_TOPGEN], 1u);
            else XB_SPIN(xb_ld(&bar[XB_TOPGEN]) == tg, bar);
            __builtin_amdgcn_fence(__ATOMIC_ACQUIRE, "agent");
            xb_add(&bar[XB_XGEN(b.x)], 1u);
            asm volatile("s_waitcnt vmcnt(0)" ::: "memory");
        } else {
            XB_SPIN(xb_ld(&bar[XB_XGEN(b.x)]) == gen, bar);
            __builtin_amdgcn_fence(__ATOMIC_ACQUIRE, "agent");
            asm volatile("s_waitcnt vmcnt(0)" ::: "memory");
        }
    }
    __syncthreads();
}

struct Args {
    const float* in[25]; float* out; unsigned char* ws; int ph_lo, ph_hi, li, pad;
};
struct Frame {
    LAS unsigned char* lds;
    volatile LAS unsigned* MISC;
    gu32* ctl;
    unsigned char* ws;
    int tid, lane, wave, vcu, G;
};
enum { I_X = 0, I_C, I_POS, I_RELB, I_WADA, I_BADA, I_N1G, I_WIN, I_SINKS, I_LNG, I_LNB, I_GWS, I_GBS, I_PA, I_PB, I_WO, I_N2G, I_WRG, I_BRG, I_WRE, I_BRE, I_WG, I_WU, I_WDN, I_FG };

__device__ __forceinline__ void p0_transpose_tile(const float* W, int N, int k0, int n0, bf16* WT, int ldt, int drow0, LAS float* scr, int lane, float scale = 1.0f) {
    {
        f32x4 t[8];
#pragma unroll
        for (int i = 0; i < 8; ++i) t[i] = __builtin_nontemporal_load((const GAS f32x4*)(W + (size_t)(k0 + 8 * i + (lane >> 3)) * N + n0 + 4 * (lane & 7))) * scale;
#pragma unroll
        for (int i = 0; i < 8; ++i) { LAS float* d = scr + (8 * i + (lane >> 3)) * 33 + 4 * (lane & 7); d[0] = t[i][0]; d[1] = t[i][1]; d[2] = t[i][2]; d[3] = t[i][3]; }
    }
    LDS_WAIT(); asm volatile("" ::: "memory");
    const int c = lane & 7;
#pragma unroll
    for (int j = 0; j < 4; ++j) { const int n = (lane >> 3) + 8 * j; const LAS float* s = scr + (8 * c) * 33 + n;
        u32x4 o; o.x = cvtpk(s[0 * 33], s[1 * 33]); o.y = cvtpk(s[2 * 33], s[3 * 33]); o.z = cvtpk(s[4 * 33], s[5 * 33]); o.w = cvtpk(s[6 * 33], s[7 * 33]);
        *(GAS u32x4*)(WT + (size_t)(drow0 + n) * ldt + k0 + 8 * c) = o; }
    LDS_WAIT(); asm volatile("" ::: "memory");
}
__device__ __forceinline__ void p0_transpose_tile_f8(const float* W, int N, int k0, int n0, unsigned char* WT, int ldt, int drow0, float scale, LAS float* scr, int lane) {
    {
        f32x4 t[16];
#pragma unroll
        for (int i = 0; i < 16; ++i) t[i] = __builtin_nontemporal_load((const GAS f32x4*)(W + (size_t)(k0 + 8 * i + (lane >> 3)) * N + n0 + 4 * (lane & 7)));
#pragma unroll
        for (int i = 0; i < 16; ++i) { const int k = 8 * i + (lane >> 3); *(LAS f32x4*)(scr + k * 32 + ((4 * (lane & 7)) ^ (4 * (k >> 4)))) = t[i]; }
    }
    LDS_WAIT(); asm volatile("" ::: "memory");
    const int c = lane & 7;
#pragma unroll
    for (int j = 0; j < 4; ++j) { const int n = (lane >> 3) + 8 * j; const LAS float* sp = scr + (16 * c) * 32 + (n ^ (4 * c));
        u32x4 o;
        o.x = pk4_fp8(sp[0 * 32] * scale, sp[1 * 32] * scale, sp[2 * 32] * scale, sp[3 * 32] * scale); o.y = pk4_fp8(sp[4 * 32] * scale, sp[5 * 32] * scale, sp[6 * 32] * scale, sp[7 * 32] * scale);
        o.z = pk4_fp8(sp[8 * 32] * scale, sp[9 * 32] * scale, sp[10 * 32] * scale, sp[11 * 32] * scale); o.w = pk4_fp8(sp[12 * 32] * scale, sp[13 * 32] * scale, sp[14 * 32] * scale, sp[15 * 32] * scale);
        *(GAS u32x4*)(WT + (size_t)(drow0 + n) * ldt + k0 + 16 * c) = o; }
    LDS_WAIT(); asm volatile("" ::: "memory");
}
__device__ __forceinline__ void p0_prologue(Frame& F, const Args& A) {
    const int gw = F.vcu * NWAVES + F.wave, NGW = F.G * NWAVES, lane = F.lane;
    {
        const float* c = A.in[I_C]; const float* w = A.in[I_WADA]; float* modp = (float*)(F.ws + WS_MODP);
        for (int it = gw; it < 96 * 16; it += NGW) {
            const int cg = it % 96, ks = it / 96, k0 = ks * 64, col = cg * 64 + lane;
            float csv[8], acc[8];
#pragma unroll
            for (int b = 0; b < 8; ++b) { const float v = c[b * D + k0 + lane]; csv[b] = silu_f(v); acc[b] = 0.f; }
            float wv[64];
#pragma unroll
            for (int kk = 0; kk < 64; ++kk) wv[kk] = __builtin_nontemporal_load((const GAS float*)(w + (size_t)(k0 + kk) * (6 * D) + col));
#pragma unroll
            for (int kk = 0; kk < 64; ++kk) {
#pragma unroll
                for (int b = 0; b < 8; ++b) acc[b] += __int_as_float(__builtin_amdgcn_readlane(__float_as_int(csv[b]), kk)) * wv[kk];
            }
#pragma unroll
            for (int b = 0; b < 8; ++b) modp[((size_t)ks * 8 + b) * (6 * D) + col] = acc[b];
        }
    }
    {
        LAS float* scr = (LAS float*)(F.lds + RING_OFF + F.wave * 16384);
        constexpr int NB0 = NBF / 32, NB0F = (INW - NBF) / 32, S0 = 16 * NB0  , S0F = 8 * NB0F  , S1 = 8 * 32, S2 = 8 * 32, S3 = 16 * 32, S4 = 32 * 128, S5 = 32 * 128, S6 = 32 * 128;
        constexpr int NITEMS = S0 + S0F + S1 + S2 + S3 + S4 + S5 + S6;
        for (int it = gw; it < NITEMS; it += NGW) {
            int r = it;
            if (r < S0) { const int kb = r / NB0, nb = r % NB0; p0_transpose_tile(A.in[I_WIN], INW, 64 * kb, 32 * nb, (bf16*)(F.ws + WS_WIN), D, 32 * nb, scr, lane); continue; } r -= S0;
            if (r < S0F) { const int kb = r / NB0F, nb = r % NB0F; p0_transpose_tile_f8(A.in[I_WIN], INW, 128 * kb, NBF + 32 * nb, (unsigned char*)(F.ws + WS_WIN8), D, 32 * nb, NBF + 32 * nb < 1792 ? WGU_SCALE : -WGU_SCALE * LOG2E, scr, lane); continue; } r -= S0F;
            if (r < S1) { const int kb = r / 32, nb = r % 32; p0_transpose_tile(A.in[I_PA], D, 64 * kb, 32 * nb, (bf16*)(F.ws + WS_PA), D, 32 * nb, scr, lane, 1.0f / 255.0f); continue; } r -= S1;
            if (r < S2) { const int kb = r / 32, nb = r % 32; p0_transpose_tile(A.in[I_PB], D, 64 * kb, 32 * nb, (bf16*)(F.ws + WS_PA) + NQ, D, 32 * nb, scr, lane, 1.0f / 255.0f); continue; } r -= S2;
            if (r < S3) { const int kb = r / 32, nb = r % 32; p0_transpose_tile(A.in[I_WO], D, 64 * kb, 32 * nb, (bf16*)(F.ws + WS_WO), D, 32 * nb, scr, lane); continue; } r -= S3;
            if (r < S4 + S5) { const int up = r >= S4 ? 1 : 0; if (up) r -= S4; const int e = r >> 7, q = r & 127, kb = q / 16, nb = q % 16, n0 = 32 * nb;
                p0_transpose_tile_f8(A.in[up ? I_WU : I_WG] + (size_t)e * D * DEXP, DEXP, 128 * kb, n0, (unsigned char*)(F.ws + WS_WGU) + (size_t)e * 1024 * 1024, D, (n0 >> 7) * 256 + up * 128 + (n0 & 127), up ? -WGU_SCALE / LOG2E : -WGU_SCALE * LOG2E, scr, lane); continue; }
            r -= S4 + S5;
            { const int e = r >> 7, q = r & 127, kb = q / 32, nb = q % 32; p0_transpose_tile_f8(A.in[I_WDN] + (size_t)e * DEXP * D, D, 128 * kb, 32 * nb, (unsigned char*)(F.ws + WS_WD) + (size_t)e * 1024 * DEXP, DEXP, 32 * nb, WD_SCALE, scr, lane); }
        }
        const float* gws = A.in[I_GWS]; bf16* wst = (bf16*)(F.ws + WS_WST);
        for (int i = F.vcu * 512 + F.tid; i < 4 * 128 * 128 / 2; i += F.G * 512) { const int e0 = 2 * i, t = (e0 >> 7) & 127, s = e0 & 127;
            const float a = s <= t ? gws[e0] : 0.f, b = (s + 1) <= t ? gws[e0 + 1] : 0.f; ((unsigned*)wst)[i] = cvtpk(a, b); }
    }
}

__device__ __forceinline__ float mod_sum(const float* modp, const float* bada, int b, int j) {
    float s = bada[j];
#pragma unroll
    for (int ks = 0; ks < 16; ++ks) s += modp[((size_t)ks * 8 + b) * (6 * D) + j];
    return s;
}
__device__ __forceinline__ void p1_h1(Frame& F, const Args& A) {
    const float* modp = (const float*)(F.ws + WS_MODP); const float* bada = A.in[I_BADA]; float* mod = (float*)(F.ws + WS_MOD);
    for (int idx = F.vcu * 512 + F.tid; idx < 8 * 6 * D; idx += F.G * 512) { const int b = idx / (6 * D), j = idx % (6 * D); mod[idx] = mod_sum(modp, bada, b, j); }
    LAS float* Av = (LAS float*)(F.lds + RING_OFF); LAS float* Bv = Av + D;
    const float* x = A.in[I_X]; const float* g = A.in[I_N1G]; bf16* h1 = (bf16*)(F.ws + WS_A);
    for (int rb = F.vcu; rb < M / 128; rb += F.G) {
        const int b = rb / (SEQ / 128);
        __syncthreads();
        for (int c = F.tid; c < D; c += 512) { const float sh = mod_sum(modp, bada, b, c), sc = mod_sum(modp, bada, b, D + c); Av[c] = g[c] * (1.0f + sc); Bv[c] = sh; }
        __syncthreads();
        for (int j = 0; j < 16; ++j) {
            const int row = rb * 128 + F.wave * 16 + j; const float* xr = x + (size_t)row * D;
            f32x4 v[2][2]; float ss = 0.f;
#pragma unroll
            for (int jj = 0; jj < 2; ++jj)
#pragma unroll
                for (int q = 0; q < 2; ++q) { v[jj][q] = __builtin_nontemporal_load((const GAS f32x4*)(xr + 512 * jj + 8 * F.lane + 4 * q)); ss += (v[jj][q].x * v[jj][q].x + v[jj][q].y * v[jj][q].y) + (v[jj][q].z * v[jj][q].z + v[jj][q].w * v[jj][q].w); }
            const float rinv = 1.0f / sqrtf(wave_sum(ss) * (1.0f / D) + EPS);
#pragma unroll
            for (int jj = 0; jj < 2; ++jj) { const int c0 = 512 * jj + 8 * F.lane;
                const f32x4 a0 = *(const LAS f32x4*)(Av + c0), a1 = *(const LAS f32x4*)(Av + c0 + 4), b0 = *(const LAS f32x4*)(Bv + c0), b1 = *(const LAS f32x4*)(Bv + c0 + 4);
                const f32x4 o0 = v[jj][0] * rinv * a0 + b0, o1 = v[jj][1] * rinv * a1 + b1;
                u32x4 w; w.x = cvtpk(o0.x, o0.y); w.y = cvtpk(o0.z, o0.w); w.z = cvtpk(o1.x, o1.y); w.w = cvtpk(o1.z, o1.w);
                *(GAS u32x4*)(h1 + (size_t)row * D + c0) = w;
                *(GAS u32x2*)((unsigned char*)(F.ws + WS_H1F8) + (size_t)row * D + c0) = pack8_fp8(o0, o1); }
        }
    }
}

struct ProbDense { int Kb; unsigned lda, ldb; const char* A; const char* B; static constexpr bool GATHER = false, F8 = false; static constexpr int E8M0 = 0x7f7f7f7f; const LAS unsigned* rowtab;
    __device__ __forceinline__ const char* a_ptr(const pg8::Unit& u) const { return A + (size_t)u.pm * 256 * lda; }
    __device__ __forceinline__ const char* b_ptr(const pg8::Unit& u) const { return B + (size_t)u.pn * 256 * ldb; } };
struct ProbDense8 { int Kb; unsigned lda, ldb; const char* A; const char* B; static constexpr bool GATHER = false, F8 = true; static constexpr int E8M0 = 0x7c7c7c7c; const LAS unsigned* rowtab;
    __device__ __forceinline__ const char* a_ptr(const pg8::Unit& u) const { return A + (size_t)u.pm * 256 * lda; }
    __device__ __forceinline__ const char* b_ptr(const pg8::Unit& u) const { return B + (size_t)u.pn * 256 * ldb; } };
struct ProbGateUp { int Kb; unsigned lda, ldb; const char* A; const char* B; static constexpr bool GATHER = true, F8 = true; static constexpr int E8M0 = 0x7c7c7c7c; const LAS unsigned* rowtab;
    __device__ __forceinline__ const char* a_ptr(const pg8::Unit&) const { return A; }
    __device__ __forceinline__ const char* b_ptr(const pg8::Unit& u) const { return B + ((size_t)(u.e & 63) * 1024 + (size_t)u.pn * 256) * ldb; } };
struct ProbDown { int Kb; unsigned lda, ldb; const char* A; const char* B; static constexpr bool GATHER = false, F8 = true; static constexpr int E8M0 = 0x7f7f7f7f; const LAS unsigned* rowtab;
    __device__ __forceinline__ const char* a_ptr(const pg8::Unit& u) const { return A + (size_t)u.pm * 256 * lda; }
    __device__ __forceinline__ const char* b_ptr(const pg8::Unit& u) const { return B + ((size_t)(u.e & 63) * 1024 + (size_t)u.pn * 256) * ldb; } };

struct CSh {
    LAS unsigned char* slab; unsigned woff, roff; int rrow, rpc;
    __device__ __forceinline__ CSh(int wr, int wc, int fr, int fq) {
        extern __shared__ __attribute__((aligned(16))) unsigned char lds_dyn[];
        int lane = fq * 16 + fr; asm volatile("" : "+v"(lane));
        fr = lane & 15; fq = lane >> 4; rrow = lane >> 2; rpc = lane & 3;
        slab = (LAS unsigned char*)lds_dyn + CSH_OFF + (wr * 4 + wc) * 2048;
        woff = (unsigned)(fr * 64 + ((fq ^ ((fr >> 1) & 3)) << 4)); roff = (unsigned)(rrow * 64 + ((rpc ^ ((rrow >> 1) & 3)) << 4)); }
    __device__ __forceinline__ u32x4 xch(int k, const u32x4 w) const { LAS unsigned char* s_ = slab + (k & 1) * 1024; *(LAS u32x4*)(s_ + woff) = w; return *(const LAS u32x4*)(s_ + roff); }
};
__device__ __forceinline__ u32x4 pack8(const f32x4 a, const f32x4 b) { u32x4 w; w.x = cvtpk(a[0], a[1]); w.y = cvtpk(a[2], a[3]); w.z = cvtpk(b[0], b[1]); w.w = cvtpk(b[2], b[3]); return w; }
__device__ __forceinline__ void unpack8(const u32x4 w, f32x4& a, f32x4& b) { a = (f32x4){bf_lo(w.x), bf_hi(w.x), bf_lo(w.y), bf_hi(w.y)}; b = (f32x4){bf_lo(w.z), bf_hi(w.z), bf_lo(w.w), bf_hi(w.w)}; }

template <bool F8>
struct EpiInProjT {
    static constexpr bool PERM = true, MIDK = false;
    unsigned char* ws; int pn0; float scl;
    template <bool LO1> __device__ __forceinline__ void gates(const f32x4 (&acc)[2][2][4][2], unsigned char* base, int row0, int col0) const {
        asm volatile("" : "+v"(row0));
#pragma unroll
        for (int ai = 0; ai < 2; ++ai)
#pragma unroll
            for (int m = 0; m < 4; ++m)
#pragma unroll
                for (int bj = 0; bj < 2; ++bj) { u32x2 w; w.x = sigcode_4<LO1>(acc[ai][bj][m][0]); w.y = sigcode_4<LO1>(acc[ai][bj][m][1]);
                    *(GAS u32x2*)(base + (size_t)(row0 + ai * 128 + m * 16) * D + col0 + bj * 128) = w; }
    }
    __device__ __forceinline__ void operator()(const f32x4 (&acc)[2][2][4][2], const pg8::Unit& u, int wr, int wc, int fr, int fq) const {
        const int pn = u.pn + pn0;
        if constexpr (F8) {
            const int row0 = u.pm * 256 + wr * 64 + fr, col0 = wc * 32 + 8 * fq;
            if (pn < 11) gates<false>(acc, ws + WS_GA, row0, 256 * (pn - 7) + col0); else gates<true>(acc, ws + WS_GB, row0, 256 * (pn - 11) + col0);
        } else {
            bf16* base; int ldc, colt, act;
            if (pn < 2) { base = (bf16*)(ws + WS_Q); ldc = NQ; colt = 256 * pn; act = 0; }
            else if (pn == 2) { base = (bf16*)(ws + WS_KV); ldc = NKV; colt = 0; act = 1; }
            else if (pn < 5) { base = (bf16*)(ws + WS_GU); ldc = GMW; colt = 256 * (pn - 3); act = 2; }
            else { base = (bf16*)(ws + WS_GV); ldc = GMW; colt = 256 * (pn - 5); act = 2; }
            const CSh cs(wr, wc, fr, fq); int kk = 0;
#pragma unroll
            for (int ai = 0; ai < 2; ++ai)
#pragma unroll
                for (int m = 0; m < 4; ++m) { bf16* rowp = base + (size_t)(u.pm * 256 + wr * 64 + cs.rrow + ai * 128 + m * 16) * ldc + colt + wc * 32 + 8 * cs.rpc;
#pragma unroll
                    for (int bj = 0; bj < 2; ++bj) { f32x4 v0 = acc[ai][bj][m][0], v1 = acc[ai][bj][m][1];
                        if (act == 0) { v0 = v0 * QSCALE; v1 = v1 * QSCALE; }
                        else if (!GUGV_FP8 && act == 2) { v0 = gelu_tanh_4(v0); v1 = gelu_tanh_4(v1); }
                        *(GAS u32x4*)(rowp + bj * 128) = cs.xch(kk++, pack8(v0, v1)); } }
        }
    }
};
struct EpiGelu8 {
    static constexpr bool PERM = true, MIDK = false;
    unsigned char* ws;
    __device__ __forceinline__ void operator()(const f32x4 (&acc)[2][2][4][2], const pg8::Unit& u, int wr, int wc, int fr, int fq) const {
        bf16* base = (bf16*)(ws + (u.pn < 2 ? WS_GU : WS_GV)); const int colt = 256 * (u.pn & 1);
        const CSh cs(wr, wc, fr, fq); int kk = 0;
#pragma unroll
        for (int ai = 0; ai < 2; ++ai)
#pragma unroll
            for (int m = 0; m < 4; ++m) { bf16* rowp = base + (size_t)(u.pm * 256 + wr * 64 + cs.rrow + ai * 128 + m * 16) * GMW + colt + wc * 32 + 8 * cs.rpc;
#pragma unroll
                for (int bj = 0; bj < 2; ++bj) *(GAS u32x4*)(rowp + bj * 128) = cs.xch(kk++, pack8(gelu_tanh_4(acc[ai][bj][m][0]), gelu_tanh_4(acc[ai][bj][m][1]))); }
    }
};
struct EpiMerge {
    static constexpr bool PERM = true, MIDK = true;
    const unsigned char* GA; const unsigned char* GB; bf16* MG;
    __device__ __forceinline__ void mid(f32x4 (&acc)[2][2][4][2], const pg8::Unit& u, int wr, int wc, int fr_, int fq) const {
        int fr = fr_; asm volatile("" : "+v"(fr));
        const int row0 = u.pm * 256 + wr * 64 + fr, col0 = u.pn * 256 + wc * 32 + 8 * fq;
#pragma unroll
        for (int ai = 0; ai < 2; ++ai) {
            u32x2 ga[4][2], gb[4][2];
#pragma unroll
            for (int m = 0; m < 4; ++m)
#pragma unroll
                for (int bj = 0; bj < 2; ++bj) { const size_t off = (size_t)(row0 + ai * 128 + m * 16) * D + col0 + bj * 128; ga[m][bj] = *(const GAS u32x2*)(GA + off); gb[m][bj] = *(const GAS u32x2*)(GB + off); }
#pragma unroll
            for (int m = 0; m < 4; ++m)
#pragma unroll
                for (int bj = 0; bj < 2; ++bj) { f32x4 a0, a1, b0, b1; unpack8_u8(ga[m][bj], a0, a1); unpack8_u8(gb[m][bj], b0, b1);
#pragma unroll
                    for (int q = 0; q < 4; ++q) { acc[ai][bj][m][0][q] *= a0[q] * __builtin_amdgcn_rcpf(b0[q]); acc[ai][bj][m][1][q] *= a1[q] * __builtin_amdgcn_rcpf(b1[q]); } }
            asm volatile("" ::: "memory");
        }
    }
    __device__ __forceinline__ void operator()(const f32x4 (&acc)[2][2][4][2], const pg8::Unit& u, int wr, int wc, int fr, int fq) const {
        const int row0 = u.pm * 256 + wr * 64 + fr, col0 = u.pn * 256 + wc * 32 + 8 * fq;
        u32x2 gb[2][4][2];
#pragma unroll
        for (int ai = 0; ai < 2; ++ai)
#pragma unroll
            for (int m = 0; m < 4; ++m)
#pragma unroll
                for (int bj = 0; bj < 2; ++bj) gb[ai][m][bj] = *(const GAS u32x2*)(GB + (size_t)(row0 + ai * 128 + m * 16) * D + col0 + bj * 128);
        const CSh cs(wr, wc, fr, fq); int kk = 0;
#pragma unroll
        for (int ai = 0; ai < 2; ++ai)
#pragma unroll
            for (int m = 0; m < 4; ++m) { const size_t off = (size_t)(u.pm * 256 + wr * 64 + cs.rrow + ai * 128 + m * 16) * D + u.pn * 256 + wc * 32 + 8 * cs.rpc;
#pragma unroll
                for (int bj = 0; bj < 2; ++bj) { f32x4 b0, b1; unpack8_u8(gb[ai][m][bj], b0, b1);
                    *(GAS u32x4*)(MG + off + bj * 128) = cs.xch(kk++, pack8(acc[ai][bj][m][0] * b0, acc[ai][bj][m][1] * b1)); } }
    }
};
struct EpiWo {
    static constexpr bool PERM = true, MIDK = false;
    const float* x; const float* mod; bf16* XM;
    __device__ __forceinline__ void operator()(const f32x4 (&acc)[2][2][4][2], const pg8::Unit& u, int wr, int wc, int fr, int fq) const {
        const int row0 = u.pm * 256 + wr * 64 + fr, col0 = u.pn * 256 + wc * 32 + 8 * fq, b = u.pm >> 4;
        const CSh cs(wr, wc, fr, fq); int kk = 0;
        f32x4 g[2][2];
#pragma unroll
        for (int bj = 0; bj < 2; ++bj)
#pragma unroll
            for (int n = 0; n < 2; ++n) g[bj][n] = *(const GAS f32x4*)(mod + (size_t)b * 6 * D + 2 * D + col0 + bj * 128 + 4 * n);
#pragma unroll
        for (int ai = 0; ai < 2; ++ai) {
            f32x4 xv[4][2][2];
#pragma unroll
            for (int m = 0; m < 4; ++m)
#pragma unroll
                for (int bj = 0; bj < 2; ++bj)
#pragma unroll
                    for (int n = 0; n < 2; ++n) xv[m][bj][n] = __builtin_nontemporal_load((const GAS f32x4*)(x + (size_t)(row0 + ai * 128 + m * 16) * D + col0 + bj * 128 + 4 * n));
#pragma unroll
            for (int m = 0; m < 4; ++m) { const size_t off = (size_t)(u.pm * 256 + wr * 64 + cs.rrow + ai * 128 + m * 16) * D + u.pn * 256 + wc * 32 + 8 * cs.rpc;
#pragma unroll
                for (int bj = 0; bj < 2; ++bj) *(GAS u32x4*)(XM + off + bj * 128) = cs.xch(kk++, pack8(xv[m][bj][0] + g[bj][0] * acc[ai][bj][m][0], xv[m][bj][1] + g[bj][1] * acc[ai][bj][m][1])); }
            asm volatile("" ::: "memory");
        }
    }
};
struct EpiGateUp {
    static constexpr bool PERM = true, MIDK = false;
    unsigned char* H;
    __device__ __forceinline__ void operator()(const f32x4 (&acc)[2][2][4][2], const pg8::Unit& u, int wr, int wc, int fr, int fq) const {
        const int row0 = u.pm * 256 + wr * 64 + fr, col0 = u.pn * 128 + wc * 32 + 8 * fq;
#pragma unroll
        for (int ai = 0; ai < 2; ++ai)
#pragma unroll
            for (int m = 0; m < 4; ++m) { f32x4 v0, v1;
#pragma unroll
                for (int h = 0; h < 2; ++h) {
                    const f32x2 g0 = h ? hi2(acc[ai][0][m][0]) : lo2(acc[ai][0][m][0]), u0 = h ? hi2(acc[ai][1][m][0]) : lo2(acc[ai][1][m][0]);
                    const f32x2 g1 = h ? hi2(acc[ai][0][m][1]) : lo2(acc[ai][0][m][1]), u1 = h ? hi2(acc[ai][1][m][1]) : lo2(acc[ai][1][m][1]);
                    const f32x2 r0 = (g0 * u0) * rcp_2(exp2_2(g0) + 1.0f), r1 = (g1 * u1) * rcp_2(exp2_2(g1) + 1.0f);
                    v0[2 * h] = r0.x; v0[2 * h + 1] = r0.y; v1[2 * h] = r1.x; v1[2 * h + 1] = r1.y; }
                *(GAS u32x2*)(H + (size_t)(row0 + ai * 128 + m * 16) * DEXP + col0) = pack8_fp8(v0, v1); }
    }
};
struct EpiDown {
    static constexpr bool PERM = true, MIDK = false;
    const unsigned* lrow; const float* lw; bf16* YT; const LAS unsigned* tab;
    __device__ __forceinline__ void operator()(const f32x4 (&acc)[2][2][4][2], const pg8::Unit& u, int wr, int wc, int fr, int fq) const {
        const int col0 = u.pn * 256 + wc * 32 + 8 * fq, lt0 = u.pn  ; (void)lt0;
        const int e = u.e & 63, cnt = u.e >> 6;
        const CSh cs(wr, wc, fr, fq); int kk = 0; (void)col0;
#pragma unroll
        for (int ai = 0; ai < 2; ++ai)
#pragma unroll
            for (int m = 0; m < 4; ++m) { const int rb = ai * 128 + wr * 64 + m * 16, r = rb + fr, rs = rb + cs.rrow, li = u.v + rs;
                const float wq = u.ui < 7 ? __uint_as_float(tab[2 * (u.ui * 256 + r) + 1]) : lw[(size_t)e * LIST_CAP + (u.v + r < cnt ? u.v + r : 0)] * (1.0f / WD_SCALE);
                const unsigned ent = u.ui < 7 ? tab[2 * (u.ui * 256 + rs)] : lrow[(size_t)e * LIST_CAP + (li < cnt ? li : 0)];
                bf16* dst = YT + (size_t)ent * D + u.pn * 256 + wc * 32 + 8 * cs.rpc;
#pragma unroll
                for (int bj = 0; bj < 2; ++bj) { const u32x4 t = cs.xch(kk++, pack8(acc[ai][bj][m][0] * wq, acc[ai][bj][m][1] * wq));
                    if (li < cnt) *(GAS u32x4*)(dst + bj * 128) = t; } }
    }
};
struct MoeOrder {
    const LAS int* utab; int n;
    __device__ __forceinline__ bool next(int i, pg8::Unit& u) const { if (i >= n) return false;
        u.pm = __builtin_amdgcn_readfirstlane(utab[4 * i]); u.pn = __builtin_amdgcn_readfirstlane(utab[4 * i + 1]); u.v = __builtin_amdgcn_readfirstlane(utab[4 * i + 2]); u.e = __builtin_amdgcn_readfirstlane(utab[4 * i + 3]); u.ui = i; return true; }
};
__device__ __forceinline__ int moe_tables(Frame& F, bool rows) {
    LAS int* utab = (LAS int*)(F.lds + TAB_UNITS); LAS int* cnts = (LAS int*)(F.lds + TAB_CNT); LAS int* nun = cnts + 72;
    LAS unsigned* rowtab = (LAS unsigned*)(F.lds + TAB_ROWS);
    __syncthreads();
    if (rows || MK_N_LAUNCHES != 1) {
        if (F.tid < 64) {
            const int lane = F.tid, c = lane < 32 ? (int)__hip_atomic_load(F.ctl + CW_CNT + 64 * lane, RLX_AGENT) : 0, tiles = (c + 255) >> 8;
            int x = tiles;
#pragma unroll
            for (int o = 1; o < 32; o <<= 1) { const int y = __shfl_up(x, o); if (lane >= o) x += y; }
            const int excl = x - tiles, total = __shfl(x, 31) * 4;
            int n = 0;
            for (int i = 0; i < MAX_WG_UNITS; ++i) { const int L = i * F.G + F.vcu; if (L >= total) break;
                const int rt = L >> 2, pn = L & 3;
                const unsigned long long m = __ballot(lane < 32 && excl <= rt && rt < excl + tiles);
                const int e = m ? __builtin_ctzll(m) : 0, ce = __shfl(c, e), lt = rt - __shfl(excl, e);
                if (lane == 0) { utab[4 * i] = rt; utab[4 * i + 1] = pn; utab[4 * i + 2] = lt * 256; utab[4 * i + 3] = e | (ce << 6); }
                ++n; }
            if (lane == 0) nun[0] = n;
        }
        __syncthreads();
    }
    const int n = nun[0];
    if (rows) {
        const unsigned* lrow = (const unsigned*)(F.ws + WS_LROW);
        for (int q = F.tid; q < n * 256; q += 512) { const int i = q >> 8, r = q & 255, e = utab[4 * i + 3] & 63, cnt = utab[4 * i + 3] >> 6, li = utab[4 * i + 2] + r;
            const unsigned tok = li < cnt ? (lrow[(size_t)e * LIST_CAP + li] >> 1) : 0u; rowtab[q] = tok * (unsigned)D; }
    } else {
        const unsigned* lrow = (const unsigned*)(F.ws + WS_LROW); const float* lw = (const float*)(F.ws + WS_LW);
        for (int q = F.tid; q < n * 256 && q < 7 * 256; q += 512) { const int i = q >> 8, r = q & 255, e = utab[4 * i + 3] & 63, cnt = utab[4 * i + 3] >> 6, li = utab[4 * i + 2] + r, lc = li < cnt ? li : 0;
            rowtab[2 * q] = lrow[(size_t)e * LIST_CAP + lc]; rowtab[2 * q + 1] = __float_as_uint(lw[(size_t)e * LIST_CAP + lc] * (1.0f / WD_SCALE)); }
    }
    __syncthreads();
    return n;
}

constexpr int KCH = 4112;
constexpr int AT_K = 0, AT_V = 8 * KCH  , AT_POS = AT_V + 32768, AT_TAB = AT_POS + 1024  , AT_TABT = AT_TAB + 4 * 132 * 4  ,
              AT_OST = 72704  , AT_TABR = AT_OST + 8 * 4096  ,
              AT_END = AT_TABR + 4 * 4 * 208 * 4;
static_assert(AT_END <= RING_BYTES, "attention LDS");
static_assert(AT_TABT + 4 * 200 * 4 <= AT_OST, "attention LDS");
static_assert(AT_END <= RING_BYTES, "attention LDS");
__device__ __forceinline__ int crow(int r, int hi) { return (r & 3) + 8 * (r >> 2) + 4 * hi; }
__device__ __forceinline__ s16x4 vtr(const LAS unsigned char* p) { typedef short v4i16_t __attribute__((ext_vector_type(4))); return __builtin_bit_cast(s16x4, __builtin_amdgcn_ds_read_tr16_b64_v4i16((LAS v4i16_t*)p)); }
__device__ __forceinline__ bf16x8 mk8(const s16x4 lo, const s16x4 hi) { return (bf16x8){lo[0], lo[1], lo[2], lo[3], hi[0], hi[1], hi[2], hi[3]}; }

__device__ __forceinline__ void attn_unit(Frame& F, const Args& A, int b, int blk, int kvh) {
    int tid = F.tid; asm volatile("" : "+v"(tid));
    const int lane = tid & 63, wid = F.wave, r32 = lane & 31, hi = lane >> 5;
    LAS unsigned char* L = F.lds + RING_OFF;
    const bf16* Q = (const bf16*)(F.ws + WS_Q); const bf16* KV = (const bf16*)(F.ws + WS_KV); bf16* YAB = (bf16*)(F.ws + WS_YAB);
    const int r0 = b * SEQ + blk * 128, rp = blk > 0 ? r0 - 128 : r0;
    __syncthreads();
#pragma unroll
    for (int j = 0; j < 4; ++j) { const int p = tid + 512 * j, key = p >> 3, c = p & 7; const int grow = key < 128 ? rp + key : r0 + key - 128;
        const u32x4 kk = *(const GAS u32x4*)(KV + (size_t)grow * NKV + kvh * 64 + c * 8);
        const u32x4 vv = *(const GAS u32x4*)(KV + (size_t)grow * NKV + 128 + kvh * 64 + c * 8);
        *(LAS u32x4*)(L + AT_K + c * KCH + key * 16) = kk;
        *(LAS u32x4*)(L + AT_V + ((key >> 4) * 2 + (c >> 2)) * 1024 + (key & 15) * 64 + (c & 3) * 16) = vv; }
    if (tid < 256) { const int grow = tid < 128 ? rp + tid : r0 + tid - 128; ((LAS int*)(L + AT_POS))[tid] = ((const int*)A.in[I_POS])[grow]; }
    if (tid < 200) { int n = tid - 36; n = n < 0 ? 0 : (n > 128 ? 128 : n); int bucket;
        if (n < 16) bucket = n; else { const int lg = (int)(logf((float)n / 16.0f) / logf(8.0f) * 16.0f); bucket = 16 + lg; if (bucket > 31) bucket = 31; }
#pragma unroll
        for (int g = 0; g < 4; ++g) { const float v = A.in[I_RELB][bucket * 8 + kvh * 4 + g] * LOG2E; if (tid >= 36 && tid <= 164) ((LAS float*)(L + AT_TAB))[g * 132 + tid - 36] = v;
            const float vm = (tid >= 36 && tid < 164) ? v : -1e30f;
#pragma unroll
            for (int sft = 0; sft < 4; ++sft) if (199 - tid - sft >= 0) ((LAS float*)(L + AT_TABR))[(g * 4 + sft) * 208 + 199 - tid - sft] = vm; } }
    __syncthreads();
    const int toep = __syncthreads_and(tid >= 255 || (blk == 0 && tid < 128) || ((const LAS int*)(L + AT_POS))[tid + 1] - ((const LAS int*)(L + AT_POS))[tid] == 1);
    const int g = wid & 3, qh = wid >> 2, head = kvh * 4 + g;
    const float sink2 = A.in[I_SINKS][head] * LOG2E;
    const LAS float* tab = (const LAS float*)(L + AT_TAB) + g * 132;
    const LAS int* posl = (const LAS int*)(L + AT_POS);
#pragma unroll 1
    for (int s = 0; s < 2; ++s) {
        const int i0 = 64 * qh + 32 * s, T0 = i0 >> 5;
        bf16x8 qr[4];
#pragma unroll
        for (int ks = 0; ks < 4; ++ks) qr[ks] = *(const GAS bf16x8*)(Q + (size_t)(r0 + i0 + r32) * NQ + head * 64 + ks * 16 + hi * 8);
        const int pq = posl[128 + i0 + r32];
        f32x16 p[5];
        if (toep) {
            const int sft = (35 - r32) & 3, Y = ((35 - r32 - sft) >> 2) + hi;
            const LAS f32x4* tr = (const LAS f32x4*)(L + AT_TABR + (g * 4 + sft) * 208 * 4) + Y;
#pragma unroll
            for (int j = 0; j < 5; ++j) {
                const bool tile_dead = (blk == 0) && (T0 + j < 4);
                f32x4 c0 = tr[8 * j], c1 = tr[8 * j + 2], c2 = tr[8 * j + 4], c3 = tr[8 * j + 6];
                if (tile_dead) { c0 = (f32x4){-1e30f, -1e30f, -1e30f, -1e30f}; c1 = c0; c2 = c0; c3 = c0; }
                f32x16 a = __builtin_shufflevector(__builtin_shufflevector(c0, c1, 0, 1, 2, 3, 4, 5, 6, 7), __builtin_shufflevector(c2, c3, 0, 1, 2, 3, 4, 5, 6, 7), 0, 1, 2, 3, 4, 5, 6, 7, 8, 9, 10, 11, 12, 13, 14, 15);
#pragma unroll
                for (int ks = 0; ks < 4; ++ks) { const bf16x8 kf = *(const LAS bf16x8*)(L + AT_K + (2 * ks + hi) * KCH + (32 * (T0 + j) + r32) * 16);
                    a = __builtin_amdgcn_mfma_f32_32x32x16_bf16(kf, qr[ks], a, 0, 0, 0); }
                p[j] = a;
            }
        } else {
#pragma unroll
        for (int j = 0; j < 5; ++j) {
            f32x16 a = {};
#pragma unroll
            for (int ks = 0; ks < 4; ++ks) { const bf16x8 kf = *(const LAS bf16x8*)(L + AT_K + (2 * ks + hi) * KCH + (32 * (T0 + j) + r32) * 16);
                a = __builtin_amdgcn_mfma_f32_32x32x16_bf16(kf, qr[ks], a, 0, 0, 0); }
            p[j] = a;
        }
#pragma unroll
        for (int j = 0; j < 5; ++j) {
            const bool tile_dead = (blk == 0) && (T0 + j < 4);
#pragma unroll
            for (int rq = 0; rq < 4; ++rq) {
                const int k0 = 32 * (T0 + j) + 8 * rq + 4 * hi;
                typedef int i32x4 __attribute__((ext_vector_type(4))); const i32x4 pk = *(const LAS i32x4*)(posl + k0);
#pragma unroll
                for (int q = 0; q < 4; ++q) { const int r = 4 * rq + q, kl = 8 * rq + 4 * hi + q;
                    const int pkv = pk[q];
                    int n = pq - pkv; n = n < 0 ? 0 : (n > 128 ? 128 : n);
                    float sv = p[j][r] + tab[n];
                    bool ok = !tile_dead;
                    if (j == 0) ok = ok && (kl > r32);
                    if (j == 4) ok = ok && (kl <= r32);
                    p[j][r] = ok ? sv : -1e30f; }
            }
        }
        }
        float mx = sink2;
#pragma unroll
        for (int j = 0; j < 5; ++j)
#pragma unroll
            for (int r = 0; r < 16; ++r) mx = fmaxf(mx, p[j][r]);
        mx = fmaxf(mx, __shfl_xor(mx, 32));
        f32x2 l2 = {0.f, 0.f}; const f32x2 mx2 = {mx, mx};
#pragma unroll
        for (int j = 0; j < 5; ++j)
#pragma unroll
            for (int r = 0; r < 16; r += 2) { const f32x2 e = exp2_2((f32x2){p[j][r], p[j][r + 1]} - mx2); p[j][r] = e.x; p[j][r + 1] = e.y; l2 += e; }
        float l = l2.x + l2.y;
        l += __shfl_xor(l, 32);
        l += __builtin_amdgcn_exp2f(sink2 - mx);
        const float rl = __builtin_amdgcn_rcpf(l);
        f32x16 o[2]; o[0] = (f32x16){}; o[1] = (f32x16){};
        const int vlane = (4 * hi + ((lane & 15) >> 2)) * 64 + ((lane >> 4) & 1) * 32 + (lane & 3) * 8;
#pragma unroll
        for (int j = 0; j < 5; ++j)
#pragma unroll
            for (int s2 = 0; s2 < 2; ++s2) {
                u32x4 pw; pw.x = cvtpk(p[j][8 * s2 + 0], p[j][8 * s2 + 1]); pw.y = cvtpk(p[j][8 * s2 + 2], p[j][8 * s2 + 3]);
                pw.z = cvtpk(p[j][8 * s2 + 4], p[j][8 * s2 + 5]); pw.w = cvtpk(p[j][8 * s2 + 6], p[j][8 * s2 + 7]);
                const bf16x8 pa = __builtin_bit_cast(bf16x8, pw);
                const int kg = 2 * (T0 + j) + s2;
#pragma unroll
                for (int d0 = 0; d0 < 2; ++d0) { const LAS unsigned char* vp = L + AT_V + (kg * 2 + d0) * 1024 + vlane;
                    const bf16x8 vf = mk8(vtr(vp), vtr(vp + 512));
                    o[d0] = __builtin_amdgcn_mfma_f32_32x32x16_bf16(vf, pa, o[d0], 0, 0, 0); }
            }
        {
            LAS unsigned char* stg = L + AT_OST + wid * 4096; const f32x2 rl2 = {rl, rl};
#pragma unroll
            for (int d0 = 0; d0 < 2; ++d0)
#pragma unroll
                for (int rq = 0; rq < 4; ++rq) { const f32x2 a = (f32x2){o[d0][4 * rq], o[d0][4 * rq + 1]} * rl2, b2 = (f32x2){o[d0][4 * rq + 2], o[d0][4 * rq + 3]} * rl2;
                    u32x2 w; w.x = cvtpk(a.x, a.y); w.y = cvtpk(b2.x, b2.y);
                    *(LAS u32x2*)(stg + r32 * 128 + (((4 * d0 + rq) ^ (r32 & 7)) << 4) + hi * 8) = w; }
#pragma unroll
            for (int i = 0; i < 4; ++i) { const int pc = lane + 64 * i, row = pc >> 3, ch = pc & 7;
                const u32x4 v = *(const LAS u32x4*)(stg + row * 128 + ((ch ^ (row & 7)) << 4));
                *(GAS u32x4*)(YAB + (size_t)(r0 + i0 + row) * D + head * 64 + ch * 8) = v; }
        }
    }
}

__device__ __forceinline__ void gmlp_unit(Frame& F, const Args& A, int b, int ch) {
    int tid = F.tid; asm volatile("" : "+v"(tid));
    const int lane = tid & 63, wid = F.wave, r32 = lane & 31, hi = lane >> 5;
    LAS unsigned char* L = F.lds + RING_OFF;
    const bf16* GU = (const bf16*)(F.ws + WS_GU); const bf16* GV = (const bf16*)(F.ws + WS_GV); bf16* YAB = (bf16*)(F.ws + WS_YAB);
    const bf16* WST = (const bf16*)(F.ws + WS_WST);
    const int r0 = b * SEQ + ch * 128;
    const int g = wid >> 1, chalf = wid & 1;
    bf16x8 wfl[20];
#pragma unroll
    for (int tt = 0; tt < 4; ++tt)
#pragma unroll
        for (int ks = 0; ks < 8; ++ks) if (ks <= 2 * tt + 1) wfl[tt * (tt + 1) + ks] = *(const GAS bf16x8*)(WST + ((size_t)g * 128 + 32 * tt + r32) * 128 + 16 * ks + 8 * hi);
    float bin[4]; u32x4 gun[4];
#pragma unroll
    for (int i = 0; i < 4; ++i) { const int pc = lane + 64 * i; bin[i] = A.in[I_GBS][g * 128 + (pc >> 3)]; gun[i] = *(const GAS u32x4*)(GU + (size_t)(r0 + (pc >> 3)) * GMW + g * 128 + 64 * chalf + 8 * (pc & 7)); }
    __syncthreads();
    {
        const float* lg = A.in[I_LNG]; const float* lb = A.in[I_LNB];
        const f32x4 g0 = *(const GAS f32x4*)(lg + 8 * lane), g1 = *(const GAS f32x4*)(lg + 8 * lane + 4), b0 = *(const GAS f32x4*)(lb + 8 * lane), b1 = *(const GAS f32x4*)(lb + 8 * lane + 4);
        const int grp = lane >> 4, cb = (lane & 15) >> 2;
        u32x4 gvr[16];
#pragma unroll
        for (int j = 0; j < 16; ++j) gvr[j] = *(const GAS u32x4*)(GV + (size_t)(r0 + 16 * wid + j) * GMW + 8 * lane);
#pragma unroll
        for (int j = 0; j < 16; ++j) {
            f32x4 v0, v1; unpack8(gvr[j], v0, v1);
            const float mu = wave_sum((v0[0] + v0[1]) + (v0[2] + v0[3]) + (v1[0] + v1[1]) + (v1[2] + v1[3])) * (1.0f / GMW);
            v0 = v0 - mu; v1 = v1 - mu;
            const float var = wave_sum((v0[0] * v0[0] + v0[1] * v0[1]) + (v0[2] * v0[2] + v0[3] * v0[3]) + (v1[0] * v1[0] + v1[1] * v1[1]) + (v1[2] * v1[2] + v1[3] * v1[3])) * (1.0f / GMW);
            const float rstd = __builtin_amdgcn_rsqf(var + EPS);
            *(LAS u32x4*)(L + grp * 32768 + (wid * 4 + cb) * 1024 + j * 64 + (lane & 3) * 16) = pack8(v0 * rstd * g0 + b0, v1 * rstd * g1 + b1); }
    }
    __syncthreads();
    const int vlane = (8 * hi + ((lane & 15) >> 2)) * 64 + ((lane >> 4) & 1) * 32 + (lane & 3) * 8;
    bf16x8 bfr[2][8];
#pragma unroll
    for (int ct = 0; ct < 2; ++ct)
#pragma unroll
        for (int ks = 0; ks < 8; ++ks) { const LAS unsigned char* vp = L + g * 32768 + (ks * 4 + 2 * chalf + ct) * 1024 + vlane; bfr[ct][ks] = mk8(vtr(vp), vtr(vp + 256)); }
    __syncthreads();
    LAS float* stg = (LAS float*)(L + wid * (32 * 68 * 4));
#pragma unroll
    for (int tt = 0; tt < 4; ++tt) {
        f32x16 acc[2]; acc[0] = (f32x16){}; acc[1] = (f32x16){};
#pragma unroll
        for (int ks = 0; ks < 8; ++ks) if (ks <= 2 * tt + 1) {
            acc[0] = __builtin_amdgcn_mfma_f32_32x32x16_bf16(wfl[tt * (tt + 1) + ks], bfr[0][ks], acc[0], 0, 0, 0);
            acc[1] = __builtin_amdgcn_mfma_f32_32x32x16_bf16(wfl[tt * (tt + 1) + ks], bfr[1][ks], acc[1], 0, 0, 0); }
#pragma unroll
        for (int ct = 0; ct < 2; ++ct)
#pragma unroll
            for (int r = 0; r < 16; ++r) stg[crow(r, hi) * 68 + 32 * ct + r32] = acc[ct][r];
        u32x4 gu[4]; float bi[4];
#pragma unroll
        for (int i = 0; i < 4; ++i) { gu[i] = gun[i]; bi[i] = bin[i]; }
        if (tt < 3) {
#pragma unroll
            for (int i = 0; i < 4; ++i) { const int pc = lane + 64 * i; bin[i] = A.in[I_GBS][g * 128 + 32 * (tt + 1) + (pc >> 3)];
                gun[i] = *(const GAS u32x4*)(GU + (size_t)(r0 + 32 * (tt + 1) + (pc >> 3)) * GMW + g * 128 + 64 * chalf + 8 * (pc & 7)); } }
#pragma unroll
        for (int i = 0; i < 4; ++i) { const int pc = lane + 64 * i, row = pc >> 3, chn = pc & 7, t = 32 * tt + row, c = g * 128 + 64 * chalf + 8 * chn;
            const f32x4 s0 = *(const LAS f32x4*)(stg + row * 68 + 8 * chn), s1 = *(const LAS f32x4*)(stg + row * 68 + 8 * chn + 4);
            const float bb = bi[i]; f32x4 u0, u1; unpack8(gu[i], u0, u1);
            *(GAS u32x4*)(YAB + (size_t)(r0 + t) * D + NQ + c) = pack8(u0 * (s0 + bb), u1 * (s1 + bb)); }
    }
}

__device__ __forceinline__ void router_images(Frame& F, const Args& A) {
    const float* mod = (const float*)(F.ws + WS_MOD); bf16* GT = (bf16*)(F.ws + WS_GT); float* GC = (float*)(F.ws + WS_GC);
    LAS float* red = (LAS float*)(F.lds + RING_OFF);
    for (int it = F.vcu; it < 8 * 48; it += F.G) { const int b = it / 48, n = it % 48; float part = 0.f;
#pragma unroll
        for (int cc = 0; cc < 2; ++cc) { const int c = F.tid + 512 * cc;
            const float sh = mod[(size_t)b * 6 * D + 3 * D + c], sc = mod[(size_t)b * 6 * D + 4 * D + c], a2 = A.in[I_N2G][c] * (1.0f + sc);
            const float w = n < 4 ? A.in[I_WRG][(size_t)c * 4 + n] : (n < 36 ? A.in[I_WRE][(size_t)c * 32 + (n - 4)] : 0.f);
            GT[((size_t)b * 48 + n) * D + c] = (bf16)(cvtpk(a2 * w, 0.f) & 0xffffu); part += sh * w; }
        part = wave_sum(part);
        __syncthreads(); if (F.lane == 0) red[F.wave] = part; __syncthreads();
        if (F.tid == 0) { float s = n < 4 ? A.in[I_BRG][n] : (n < 36 ? A.in[I_BRE][n - 4] : 0.f);
#pragma unroll
            for (int w = 0; w < 8; ++w) s += red[w];
            GC[b * 48 + n] = s; }
    }
}

constexpr int GT_STRIDE = 2064;
constexpr int R6_GT = 0, R6_A2 = 48 * GT_STRIDE  , R6_B2 = R6_A2 + 4096, R6_CONST = R6_B2 + 4096, R6_LCNT = R6_CONST + 256, R6_LBASE = R6_LCNT + 128, R6_RED = R6_LBASE + 128, R6_LOG = R6_RED + 8 * 40 * 4, R6_END = R6_LOG + 8 * 16 * 40 * 4;
static_assert(R6_END <= RING_BYTES, "router LDS");
__device__ __forceinline__ void p6_router(Frame& F, const Args& A) {
    const int wid = F.wave;
    LAS unsigned char* L = F.lds + RING_OFF;
    const float* mod = (const float*)(F.ws + WS_MOD);
    const bf16* XM = (const bf16*)(F.ws + WS_XMID); unsigned char* H2 = (unsigned char*)(F.ws + WS_H2);
    unsigned* lrow = (unsigned*)(F.ws + WS_LROW); float* lw = (float*)(F.ws + WS_LW);
    LAS float* A2 = (LAS float*)(L + R6_A2); LAS float* B2 = (LAS float*)(L + R6_B2); LAS float* cst = (LAS float*)(L + R6_CONST);
    LAS int* lcnt = (LAS int*)(L + R6_LCNT); LAS int* lbase = (LAS int*)(L + R6_LBASE); LAS float* red = (LAS float*)(L + R6_RED);
    LAS float* lg = (LAS float*)(L + R6_LOG) + wid * 16 * 40;
    for (int rb = F.vcu; rb < M / 128; rb += F.G) {
        const int b = rb / (SEQ / 128);
        int tid = F.tid; asm volatile("" : "+v"(tid)); const int lane = tid & 63;
        const int rloc = lane & 15, kq = lane >> 4, row = rb * 128 + wid * 16 + rloc;
        u32x4 xk[32];
#pragma unroll
        for (int ks = 0; ks < 32; ++ks) xk[ks] = *(const GAS u32x4*)(XM + (size_t)row * D + 32 * ks + 8 * kq);
        asm volatile("" ::: "memory");
        __syncthreads();
        {
            const bf16* GTb = (const bf16*)(F.ws + WS_GT) + (size_t)b * 48 * D;
            u32x4 gt[12];
#pragma unroll
            for (int i = 0; i < 12; ++i) gt[i] = *(const GAS u32x4*)(GTb + (size_t)(tid + 512 * i) * 8);
#pragma unroll
            for (int cc = 0; cc < 2; ++cc) { const int c = tid + 512 * cc; A2[c] = A.in[I_N2G][c] * (1.0f + mod[(size_t)b * 6 * D + 4 * D + c]); B2[c] = mod[(size_t)b * 6 * D + 3 * D + c]; }
            if (tid < 48) cst[tid] = ((const float*)(F.ws + WS_GC))[b * 48 + tid];
            if (tid < 32) lcnt[tid] = 0;
#pragma unroll
            for (int i = 0; i < 12; ++i) { const int pc = tid + 512 * i, n = pc >> 7, ch = pc & 127; *(LAS u32x4*)(L + R6_GT + n * GT_STRIDE + ch * 16) = gt[i]; }
        }
        __syncthreads();
        float ss = 0.f;
#pragma unroll
        for (int ks = 0; ks < 32; ++ks) { f32x4 a, c; unpack8(xk[ks], a, c); ss += (a[0] * a[0] + a[1] * a[1]) + (a[2] * a[2] + a[3] * a[3]) + (c[0] * c[0] + c[1] * c[1]) + (c[2] * c[2] + c[3] * c[3]); }
        ss += __shfl_xor(ss, 16); ss += __shfl_xor(ss, 32);
        const float rinv = 1.0f / sqrtf(ss * (1.0f / D) + EPS);
        f32x4 acc[3]; acc[0] = (f32x4){0.f, 0.f, 0.f, 0.f}; acc[1] = acc[0]; acc[2] = acc[0];
#pragma unroll
        for (int ks = 0; ks < 32; ++ks) { const bf16x8 af = __builtin_bit_cast(bf16x8, xk[ks]);
#pragma unroll
            for (int nt = 0; nt < 3; ++nt) { const bf16x8 bfg = *(const LAS bf16x8*)(L + R6_GT + (16 * nt + rloc) * GT_STRIDE + (32 * ks + 8 * kq) * 2);
                acc[nt] = __builtin_amdgcn_mfma_f32_16x16x32_bf16(af, bfg, acc[nt], 0, 0, 0); }
            if ((ks & 3) == 3) asm volatile("" ::: "memory"); }
#pragma unroll
        for (int nt = 0; nt < 3; ++nt) { const int n = 16 * nt + rloc; if (n < 36) {
#pragma unroll
            for (int q = 0; q < 4; ++q) lg[(4 * kq + q) * 40 + n] = acc[nt][q]; } }
#pragma unroll
        for (int ks = 0; ks < 32; ++ks) asm volatile("" : "+v"(xk[ks]));
#pragma unroll
        for (int ks = 0; ks < 32; ++ks) { const int c0 = 32 * ks + 8 * kq; f32x4 a, c; unpack8(xk[ks], a, c);
            const f32x4 a0 = *(const LAS f32x4*)(A2 + c0), a1 = *(const LAS f32x4*)(A2 + c0 + 4), b0 = *(const LAS f32x4*)(B2 + c0), b1 = *(const LAS f32x4*)(B2 + c0 + 4);
            *(GAS u32x2*)(H2 + (size_t)row * D + c0) = pack8_fp8(a * rinv * a0 + b0, c * rinv * a1 + b1);
            if ((ks & 3) == 3) asm volatile("" ::: "memory"); }
        LDS_WAIT(); asm volatile("" ::: "memory");
        int e1 = 0, e2 = 0, lp1 = 0, lp2 = 0; float w1 = 0.f, w2 = 0.f;
        if (lane < 16) {
            const LAS float* lr = lg + lane * 40;
            float l0[4]; int gi = 0;
#pragma unroll
            for (int n = 0; n < 4; ++n) l0[n] = lr[n] * rinv + cst[n];
            float gm = l0[0];
#pragma unroll
            for (int n = 1; n < 4; ++n) if (l0[n] > gm) { gm = l0[n]; gi = n; }
            float gs = 0.f;
#pragma unroll
            for (int n = 0; n < 4; ++n) gs += __expf(l0[n] - gm);
            const float pg = 1.0f / gs;
            float le[8];
#pragma unroll
            for (int j = 0; j < 8; ++j) le[j] = lr[4 + 8 * gi + j] * rinv + cst[4 + 8 * gi + j];
            int i1 = 0; float m1 = le[0];
#pragma unroll
            for (int j = 1; j < 8; ++j) if (le[j] > m1) { m1 = le[j]; i1 = j; }
            int i2 = -1; float m2 = -INFINITY;
#pragma unroll
            for (int j = 0; j < 8; ++j) if (j != i1 && le[j] > m2) { m2 = le[j]; i2 = j; }
            const float ex = __expf(m2 - m1); const float t1 = 1.0f / (1.0f + ex);
            w1 = pg * t1; w2 = pg * (ex * t1);
            if (i2 < 0) i2 = (i1 + 1) & 7;
            e1 = gi * 8 + i1; e2 = gi * 8 + i2;
            lp1 = atomicAdd((int*)&lcnt[e1], 1); lp2 = atomicAdd((int*)&lcnt[e2], 1);
        }
        __syncthreads();
        if (tid < 32) { const int c = lcnt[tid]; lbase[tid] = c > 0 ? (int)__hip_atomic_fetch_add(F.ctl + CW_CNT + 64 * tid, (unsigned)c, RLX_AGENT) : 0; }
        __syncthreads();
        if (lane < 16) {
            const int p1 = lbase[e1] + lp1, p2 = lbase[e2] + lp2;
            lrow[(size_t)e1 * LIST_CAP + p1] = (unsigned)row * 2u; lw[(size_t)e1 * LIST_CAP + p1] = w1;
            lrow[(size_t)e2 * LIST_CAP + p2] = (unsigned)row * 2u + 1u; lw[(size_t)e2 * LIST_CAP + p2] = w2;
#if DEBUG_CHECKS
            { float* rec = (float*)(F.ws + 490 * MiB) + (size_t)row * 4; rec[0] = (float)e1; rec[1] = (float)e2; rec[2] = w1; rec[3] = w2; }
#endif
        }
    }
}

__device__ __forceinline__ void p9_final(Frame& F, const Args& A) {
    const int lane = F.lane, wid = F.wave;
    const float* mod = (const float*)(F.ws + WS_MOD); const bf16* XM = (const bf16*)(F.ws + WS_XMID); const bf16* YT = (const bf16*)(F.ws + WS_YT);
    for (int rb = F.vcu; rb < M / 128; rb += F.G) {
        const int b = rb / (SEQ / 128);
        f32x4 g2[2][2], fg[2][2];
#pragma unroll
        for (int jj = 0; jj < 2; ++jj)
#pragma unroll
            for (int q = 0; q < 2; ++q) { const int c = 512 * jj + 8 * lane + 4 * q; g2[jj][q] = *(const GAS f32x4*)(mod + (size_t)b * 6 * D + 5 * D + c); fg[jj][q] = *(const GAS f32x4*)(A.in[I_FG] + c); }
#pragma unroll 1
        for (int j0 = 0; j0 < 16; j0 += 4) {
            u32x4 xm[4][2], y0[4][2], y1[4][2];
#pragma unroll
            for (int jr = 0; jr < 4; ++jr) { const int row = rb * 128 + wid * 16 + j0 + jr;
#pragma unroll
                for (int jj = 0; jj < 2; ++jj) { const int c = 512 * jj + 8 * lane;
                    xm[jr][jj] = __builtin_nontemporal_load((const GAS u32x4*)(XM + (size_t)row * D + c));
                    y0[jr][jj] = __builtin_nontemporal_load((const GAS u32x4*)(YT + (size_t)row * 2 * D + c));
                    y1[jr][jj] = __builtin_nontemporal_load((const GAS u32x4*)(YT + (size_t)row * 2 * D + D + c)); } }
#pragma unroll
            for (int jr = 0; jr < 4; ++jr) { const int row = rb * 128 + wid * 16 + j0 + jr;
                f32x4 v[2][2]; float ss = 0.f;
#pragma unroll
                for (int jj = 0; jj < 2; ++jj) { f32x4 x0, x1, a0, a1, z0, z1;
                    unpack8(xm[jr][jj], x0, x1); unpack8(y0[jr][jj], a0, a1); unpack8(y1[jr][jj], z0, z1);
                    v[jj][0] = x0 + g2[jj][0] * (a0 + z0); v[jj][1] = x1 + g2[jj][1] * (a1 + z1);
#pragma unroll
                    for (int q = 0; q < 2; ++q) ss += (v[jj][q][0] * v[jj][q][0] + v[jj][q][1] * v[jj][q][1]) + (v[jj][q][2] * v[jj][q][2] + v[jj][q][3] * v[jj][q][3]); }
                const float rinv = 1.0f / sqrtf(wave_sum(ss) * (1.0f / D) + EPS);
#pragma unroll
                for (int jj = 0; jj < 2; ++jj)
#pragma unroll
                    for (int q = 0; q < 2; ++q) __builtin_nontemporal_store(v[jj][q] * rinv * fg[jj][q], (GAS f32x4*)(A.out + (size_t)row * D + 512 * jj + 8 * lane + 4 * q)); }
        }
    }
}

__global__ void __launch_bounds__(NWAVES * 64, 2) mk_fwd(Args args) {
    extern __shared__ __attribute__((aligned(16))) unsigned char lds[];
    Frame F;
    F.lds = (LAS unsigned char*)lds;
    F.MISC = (volatile LAS unsigned*)(F.lds + MISC_OFF);
    F.tid = threadIdx.x; F.lane = F.tid & 63; F.wave = __builtin_amdgcn_readfirstlane(F.tid >> 6);
    F.G = gridDim.x; { const int bx = blockIdx.x; F.vcu = (F.G % 8 == 0) ? (bx % 8) * (F.G / 8) + bx / 8 : bx; }
    F.ws = args.ws; F.ctl = (gu32*)(args.ws + WS_CTL);
    for (int u = F.tid; u < (TAB_OFF - LDSCTL_OFF) / 4; u += NWAVES * 64) ((LAS unsigned*)(F.lds + LDSCTL_OFF))[u] = 0u;
    __syncthreads();
    XcdBarrier bar; bar.bar = (unsigned*)(F.ctl + CW_BAR); bar.x = 0; bar.st = nullptr;
    if (MK_N_LAUNCHES == 1) bar = xcd_barrier_post((unsigned*)(F.ctl + CW_BAR), F.MISC + 8);
#define GRID_BAR() do { if (MK_N_LAUNCHES == 1) xcd_barrier(bar); } while (0)
    const int lo = args.ph_lo, hi = args.ph_hi;
#ifdef ONLY_PHASE
#define IN(k) ((k) == ONLY_PHASE && lo <= (k) && (k) < hi)
#else
#define IN(k) (lo <= (k) && (k) < hi)
#endif
#define BOTH(k) (IN(k) && IN((k) + 1))

    if (IN(0)) { p0_prologue(F, args); if (BOTH(0)) GRID_BAR(); }
    if (IN(1)) { p1_h1(F, args); if (BOTH(1)) GRID_BAR(); }
    if (IN(2)) {
        const bool fp8_first = (blockIdx.x & 1) != 0;
        constexpr int NG8 = GUGV_FP8 ? 1024 : 0;
#define P2_BF16() do { ProbDense P{D * 2, D * 2u, D * 2u, (const char*)(F.ws + WS_A), (const char*)(F.ws + WS_WIN), nullptr}; \
            pg8::DenseOrder S; S.init(M, NBF, F.G, (int)blockIdx.x); EpiInProjT<false> E{F.ws, 0, 1.0f}; \
            pg8::gemm_phase<ProbDense, EpiInProjT<false>, pg8::DenseOrder, true>(F.lds + RING_OFF, P, S, E); } while (0)
#define P2_GELU8() do { if constexpr (GUGV_FP8) { ProbDense8 P{D, (unsigned)D, (unsigned)D, (const char*)(F.ws + WS_H1F8), (const char*)(F.ws + WS_WIN8), nullptr}; \
            pg8::DenseOrder S; S.init(M, NG8, F.G, (int)blockIdx.x); EpiGelu8 E{F.ws}; \
            pg8::gemm_phase<ProbDense8, EpiGelu8, pg8::DenseOrder, true>(F.lds + RING_OFF, P, S, E); } } while (0)
#define P2_GATES8() do { ProbDense8 P{D, (unsigned)D, (unsigned)D, (const char*)(F.ws + WS_H1F8), (const char*)(F.ws + WS_WIN8) + (size_t)NG8 * D, nullptr}; \
            pg8::BackfillOrder S; S.init(M, INW - NBF - NG8, F.G, (int)blockIdx.x); EpiInProjT<true> E{F.ws, 7, 1.0f}; \
            pg8::gemm_phase<ProbDense8, EpiInProjT<true>, pg8::BackfillOrder, true>(F.lds + RING_OFF, P, S, E); } while (0)
        if (fp8_first) { P2_GATES8(); P2_GELU8(); P2_BF16(); } else { P2_BF16(); P2_GELU8(); P2_GATES8(); }
#undef P2_BF16
#undef P2_GELU8
#undef P2_GATES8
        if (BOTH(2)) GRID_BAR();
    }
    if (IN(3)) {
        router_images(F, args);
        for (int ub = F.vcu; ub < M / 128; ub += F.G) { const int b = ub / (SEQ / 128), blk = ub % (SEQ / 128);

#ifndef NO_ATTN
#pragma unroll 1
            for (int kvh = 0; kvh < 2; ++kvh) attn_unit(F, args, b, blk, kvh);
            asm volatile("" ::: "memory");
#endif
#ifndef NO_GMLP
            gmlp_unit(F, args, b, blk);
#endif
        }
        __syncthreads();
        if (BOTH(3)) GRID_BAR();
    }
    if (IN(4)) {
        ProbDense P{D * 2, D * 2u, D * 2u, (const char*)(F.ws + WS_YAB), (const char*)(F.ws + WS_PA), nullptr};
        pg8::DenseOrder S; S.init(M, D, F.G, (int)blockIdx.x);
        EpiMerge E{(const unsigned char*)(F.ws + WS_GA), (const unsigned char*)(F.ws + WS_GB), (bf16*)(F.ws + WS_A)};
        pg8::gemm_phase<ProbDense, EpiMerge, pg8::DenseOrder, true>(F.lds + RING_OFF, P, S, E);
        if (BOTH(4)) GRID_BAR();
    }
    if (IN(5)) {
        ProbDense P{D * 2, D * 2u, D * 2u, (const char*)(F.ws + WS_A), (const char*)(F.ws + WS_WO), nullptr};
        pg8::DenseOrder S; S.init(M, D, F.G, (int)blockIdx.x);
        EpiWo E{args.in[I_X], (const float*)(F.ws + WS_MOD), (bf16*)(F.ws + WS_XMID)};
        pg8::gemm_phase<ProbDense, EpiWo, pg8::DenseOrder, true>(F.lds + RING_OFF, P, S, E);
        if (BOTH(5)) GRID_BAR();
    }
    if (IN(6)) { p6_router(F, args); __syncthreads(); if (BOTH(6)) GRID_BAR(); }
    if (IN(7)) {
        const int n = moe_tables(F, true);
        ProbGateUp P{D, (unsigned)D, (unsigned)D, (const char*)(F.ws + WS_H2), (const char*)(F.ws + WS_WGU), (const LAS unsigned*)(F.lds + TAB_ROWS)};
        MoeOrder S{(const LAS int*)(F.lds + TAB_UNITS), n};
        EpiGateUp E{(unsigned char*)(F.ws + WS_HACT)};
        pg8::gemm_phase<ProbGateUp, EpiGateUp, MoeOrder, true>(F.lds + RING_OFF, P, S, E);
        if (BOTH(7)) GRID_BAR();
    }
    if (IN(8)) {
        const int n = moe_tables(F, false);
        ProbDown P{DEXP, (unsigned)DEXP, (unsigned)DEXP, (const char*)(F.ws + WS_HACT), (const char*)(F.ws + WS_WD), nullptr};
        MoeOrder S{(const LAS int*)(F.lds + TAB_UNITS), n};
        EpiDown E{(const unsigned*)(F.ws + WS_LROW), (const float*)(F.ws + WS_LW), (bf16*)(F.ws + WS_YT), (const LAS unsigned*)(F.lds + TAB_ROWS)};
        pg8::gemm_phase<ProbDown, EpiDown, MoeOrder, true>(F.lds + RING_OFF, P, S, E);
        if (BOTH(8)) GRID_BAR();
    }
    if (IN(9)) { p9_final(F, args); }
#undef IN
#undef BOTH
}


#if DEBUG_CHECKS
constexpr size_t WS_DBG = 490 * MiB;
constexpr int CW_DBG = 200000;
constexpr int NSAMP = 512;
__device__ __forceinline__ int samp_row(int i) { return 64 * i + ((i * 7) & 63); }
__device__ __forceinline__ float bfr(float v) { return bf_lo(cvtpk(v, 0.f) & 0xffffu); }
__device__ __forceinline__ float ldbf(const bf16* p) { return __uint_as_float((unsigned)(*p) << 16); }
__device__ __forceinline__ float f8dec(unsigned char b) { return __builtin_amdgcn_cvt_f32_fp8((int)b, 0); }
__device__ __forceinline__ float f8r(float v) { return f8dec((unsigned char)(pk4_fp8(v, 0.f, 0.f, 0.f) & 0xffu)); }
__device__ __forceinline__ void dbg_acc(unsigned char* ws, int k, float err, float ref) { float* a = (float*)(ws + WS_CTL) + CW_DBG; atomicAdd(a + 2 * k, err * err); atomicAdd(a + 2 * k + 1, ref * ref); }
__device__ __forceinline__ float block_sum256(float v, float* sh) {
    v = wave_sum(v); __syncthreads(); if ((threadIdx.x & 63) == 0) sh[threadIdx.x >> 6] = v; __syncthreads(); const float r = sh[0] + sh[1] + sh[2] + sh[3]; __syncthreads(); return r; }
__global__ void __launch_bounds__(256) chk_h1(Args a) {
    __shared__ float sh[8];
    const int row = samp_row(blockIdx.x), b = row / SEQ, t = threadIdx.x;
    float sc[4], shf[4];
#pragma unroll
    for (int q = 0; q < 4; ++q) { sc[q] = a.in[I_BADA][D + t + 256 * q]; shf[q] = a.in[I_BADA][t + 256 * q]; }
    for (int k = 0; k < D; ++k) { const float cv = a.in[I_C][b * D + k]; const float cs = cv / (1.0f + expf(-cv));
#pragma unroll
        for (int q = 0; q < 4; ++q) { sc[q] += cs * a.in[I_WADA][(size_t)k * 6 * D + D + t + 256 * q]; shf[q] += cs * a.in[I_WADA][(size_t)k * 6 * D + t + 256 * q]; } }
    float ss = 0.f; float xv[4];
#pragma unroll
    for (int q = 0; q < 4; ++q) { xv[q] = a.in[I_X][(size_t)row * D + t + 256 * q]; ss += xv[q] * xv[q]; }
    const float rinv = 1.0f / sqrtf(block_sum256(ss, sh) / D + EPS);
    const bf16* h1 = (const bf16*)(a.ws + WS_A);
#pragma unroll
    for (int q = 0; q < 4; ++q) { const int c = t + 256 * q; const float ref = xv[q] * rinv * a.in[I_N1G][c] * (1.0f + sc[q]) + shf[q]; dbg_acc(a.ws, 0, ldbf(h1 + (size_t)row * D + c) - ref, ref); }
}
__global__ void __launch_bounds__(256) chk_inproj(Args a) {
    const int idx = blockIdx.x * 256 + threadIdx.x; if (idx >= NSAMP * INW) return;
    const int row = samp_row(idx / INW), n = idx % INW;
    const bf16* h1 = (const bf16*)(a.ws + WS_A); float s = 0.f;
    if (n < NBF) { for (int k = 0; k < D; ++k) s += ldbf(h1 + (size_t)row * D + k) * bfr(a.in[I_WIN][(size_t)k * INW + n]); }
    else { for (int k = 0; k < D; ++k) s += f8dec(((const unsigned char*)(a.ws + WS_H1F8))[(size_t)row * D + k]) * f8r(a.in[I_WIN][(size_t)k * INW + n] * WGU_SCALE); s *= 1.0f / WGU_SCALE; }
    float ref, got;
    if (n < 512) { ref = s * QSCALE; got = ldbf((const bf16*)(a.ws + WS_Q) + (size_t)row * NQ + n); }
    else if (n < 768) { ref = s; got = ldbf((const bf16*)(a.ws + WS_KV) + (size_t)row * NKV + n - 512); }
    else if (n < 1280) { ref = 0.5f * s * (1.0f + tanhf(0.7978845608f * (s + 0.044715f * s * s * s))); got = ldbf((const bf16*)(a.ws + WS_GU) + (size_t)row * GMW + n - 768); }
    else if (n < 1792) { ref = 0.5f * s * (1.0f + tanhf(0.7978845608f * (s + 0.044715f * s * s * s))); got = ldbf((const bf16*)(a.ws + WS_GV) + (size_t)row * GMW + n - 1280); }
    else if (n < 2816) { ref = 1.0f / (1.0f + expf(-s)); got = (float)((const unsigned char*)(a.ws + WS_GA))[(size_t)row * D + n - 1792] * (1.0f / 255.0f); }
    else { ref = fmaxf(1.0f / (1.0f + expf(-s)), 1.0f / 255.0f); got = (float)((const unsigned char*)(a.ws + WS_GB))[(size_t)row * D + n - 2816] * (1.0f / 255.0f); }
    dbg_acc(a.ws, 1, got - ref, ref);
}
__global__ void __launch_bounds__(256) chk_attn(Args a) {
    const int idx = blockIdx.x * 256 + threadIdx.x; if (idx >= NSAMP * 8 * 4) return;
    const int row = samp_row(idx / 32), head = (idx >> 2) & 7, dq = idx & 3, b = row / SEQ, tpos = row % SEQ, blk = tpos / 128, kvh = head >> 2;
    const bf16* Q = (const bf16*)(a.ws + WS_Q); const bf16* KV = (const bf16*)(a.ws + WS_KV); const int* pos = (const int*)a.in[I_POS];
    const int band0 = b * SEQ + blk * 128 - 128;
    const int i = tpos % 128;
    float m = a.in[I_SINKS][head], l = 0.f; float o[16];
#pragma unroll
    for (int d = 0; d < 16; ++d) o[d] = 0.f;
    for (int kj = i + 1; kj <= i + 128; ++kj) { if (blk == 0 && kj < 128) continue; const int kr = band0 + kj;
        float s = 0.f; for (int d = 0; d < 64; ++d) s += ldbf(Q + (size_t)row * NQ + head * 64 + d) * ldbf(KV + (size_t)kr * NKV + kvh * 64 + d);
        s *= (1.0f / LOG2E);
        int n = pos[row] - pos[kr]; if (n < 0) n = 0; int bucket; if (n < 16) bucket = n; else { bucket = 16 + (int)(logf((float)n / 16.0f) / logf(8.0f) * 16.0f); if (bucket > 31) bucket = 31; }
        s += a.in[I_RELB][bucket * 8 + head]; m = fmaxf(m, s); }
    for (int kj = i + 1; kj <= i + 128; ++kj) { if (blk == 0 && kj < 128) continue; const int kr = band0 + kj;
        float s = 0.f; for (int d = 0; d < 64; ++d) s += ldbf(Q + (size_t)row * NQ + head * 64 + d) * ldbf(KV + (size_t)kr * NKV + kvh * 64 + d);
        s *= (1.0f / LOG2E);
        int n = pos[row] - pos[kr]; if (n < 0) n = 0; int bucket; if (n < 16) bucket = n; else { bucket = 16 + (int)(logf((float)n / 16.0f) / logf(8.0f) * 16.0f); if (bucket > 31) bucket = 31; }
        s += a.in[I_RELB][bucket * 8 + head]; const float p = expf(s - m); l += p;
#pragma unroll
        for (int d = 0; d < 16; ++d) o[d] += p * ldbf(KV + (size_t)kr * NKV + 128 + kvh * 64 + dq * 16 + d); }
    l += expf(a.in[I_SINKS][head] - m);
    const bf16* yab = (const bf16*)(a.ws + WS_YAB);
#pragma unroll
    for (int d = 0; d < 16; ++d) { const float ref = o[d] / l; dbg_acc(a.ws, 2, ldbf(yab + (size_t)row * D + head * 64 + dq * 16 + d) - ref, ref); }
}
__global__ void __launch_bounds__(512) chk_gmlp(Args a) {
    __shared__ float sh[16];
    const int row = samp_row(blockIdx.x), c = threadIdx.x, g = c >> 7, r0 = row & ~127, t = row & 127;
    const bf16* GU = (const bf16*)(a.ws + WS_GU); const bf16* GV = (const bf16*)(a.ws + WS_GV);
    float acc = 0.f;
    for (int s = 0; s <= t; ++s) { const float v = ldbf(GV + (size_t)(r0 + s) * GMW + c);
        float x = wave_sum(v); __syncthreads(); if ((c & 63) == 0) sh[c >> 6] = x; __syncthreads(); float tot = 0.f; for (int w = 0; w < 8; ++w) tot += sh[w]; const float mu = tot / GMW;
        x = wave_sum((v - mu) * (v - mu)); __syncthreads(); if ((c & 63) == 0) sh[c >> 6] = x; __syncthreads(); tot = 0.f; for (int w = 0; w < 8; ++w) tot += sh[w]; const float rstd = 1.0f / sqrtf(tot / GMW + EPS);
        const float vn = bfr((v - mu) * rstd * a.in[I_LNG][c] + a.in[I_LNB][c]);
        acc += bfr(a.in[I_GWS][((size_t)g * 128 + t) * 128 + s]) * vn; }
    const float ref = ldbf(GU + (size_t)row * GMW + c) * (acc + a.in[I_GBS][g * 128 + t]);
    dbg_acc(a.ws, 3, ldbf((const bf16*)(a.ws + WS_YAB) + (size_t)row * D + NQ + c) - ref, ref);
}
__global__ void __launch_bounds__(256) chk_merge(Args a) {
    const int idx = blockIdx.x * 256 + threadIdx.x; if (idx >= NSAMP * D) return;
    const int row = samp_row(idx / D), n = idx % D; const bf16* yab = (const bf16*)(a.ws + WS_YAB);
    float sa = 0.f, sb = 0.f;
    for (int k = 0; k < 512; ++k) { sa += ldbf(yab + (size_t)row * D + k) * bfr(a.in[I_PA][(size_t)k * D + n]); sb += ldbf(yab + (size_t)row * D + 512 + k) * bfr(a.in[I_PB][(size_t)k * D + n]); }
    const float ref = (float)((const unsigned char*)(a.ws + WS_GA))[(size_t)row * D + n] * (1.0f / 255.0f) * sa + (float)((const unsigned char*)(a.ws + WS_GB))[(size_t)row * D + n] * (1.0f / 255.0f) * sb;
    dbg_acc(a.ws, 4, ldbf((const bf16*)(a.ws + WS_A) + (size_t)row * D + n) - ref, ref);
}
__global__ void __launch_bounds__(256) chk_wo(Args a) {
    const int idx = blockIdx.x * 256 + threadIdx.x; if (idx >= NSAMP * D) return;
    const int row = samp_row(idx / D), n = idx % D, b = row / SEQ; const bf16* mg = (const bf16*)(a.ws + WS_A);
    float s = 0.f; for (int k = 0; k < D; ++k) s += ldbf(mg + (size_t)row * D + k) * bfr(a.in[I_WO][(size_t)k * D + n]);
    const float ref = a.in[I_X][(size_t)row * D + n] + ((const float*)(a.ws + WS_MOD))[(size_t)b * 6 * D + 2 * D + n] * s;
    dbg_acc(a.ws, 5, ldbf((const bf16*)(a.ws + WS_XMID) + (size_t)row * D + n) - ref, ref);
}
__global__ void __launch_bounds__(256) chk_router(Args a) {
    __shared__ float sh[8]; __shared__ float lgt[36];
    const int row = samp_row(blockIdx.x), b = row / SEQ, t = threadIdx.x; const float* mod = (const float*)(a.ws + WS_MOD);
    float xv[4], hv[4], ss = 0.f;
#pragma unroll
    for (int q = 0; q < 4; ++q) { xv[q] = ldbf((const bf16*)(a.ws + WS_XMID) + (size_t)row * D + t + 256 * q); ss += xv[q] * xv[q]; }
    const float rinv = 1.0f / sqrtf(block_sum256(ss, sh) / D + EPS);
#pragma unroll
    for (int q = 0; q < 4; ++q) { const int c = t + 256 * q; hv[q] = xv[q] * rinv * a.in[I_N2G][c] * (1.0f + mod[(size_t)b * 6 * D + 4 * D + c]) + mod[(size_t)b * 6 * D + 3 * D + c];
        dbg_acc(a.ws, 6, f8dec(((const unsigned char*)(a.ws + WS_H2))[(size_t)row * D + c]) - f8r(hv[q]), hv[q]); }
    for (int n = 0; n < 36; ++n) { float p = 0.f;
#pragma unroll
        for (int q = 0; q < 4; ++q) { const int c = t + 256 * q; p += hv[q] * (n < 4 ? a.in[I_WRG][c * 4 + n] : a.in[I_WRE][c * 32 + n - 4]); }
        const float tot = block_sum256(p, sh); if (t == 0) lgt[n] = tot + (n < 4 ? a.in[I_BRG][n] : a.in[I_BRE][n - 4]); }
    __syncthreads();
    if (t == 0) { int gi = 0; for (int n = 1; n < 4; ++n) if (lgt[n] > lgt[gi]) gi = n; float gs = 0.f; for (int n = 0; n < 4; ++n) gs += expf(lgt[n] - lgt[gi]); const float pg = 1.0f / gs;
        int i1 = 0; for (int j = 1; j < 8; ++j) if (lgt[4 + 8 * gi + j] > lgt[4 + 8 * gi + i1]) i1 = j; int i2 = -1; for (int j = 0; j < 8; ++j) if (j != i1 && (i2 < 0 || lgt[4 + 8 * gi + j] > lgt[4 + 8 * gi + i2])) i2 = j;
        const float ex = expf(lgt[4 + 8 * gi + i2] - lgt[4 + 8 * gi + i1]), w1 = pg / (1.0f + ex), w2 = pg * ex / (1.0f + ex);
        const float* rec = (const float*)(a.ws + WS_DBG) + (size_t)row * 4;
        const bool same = ((int)rec[0] == gi * 8 + i1) && ((int)rec[1] == gi * 8 + i2);
        dbg_acc(a.ws, 7, same ? 0.f : 1.f, 1.f);
        if (same) { dbg_acc(a.ws, 8, rec[2] - w1, w1); dbg_acc(a.ws, 8, rec[3] - w2, w2); } }
}
__global__ void __launch_bounds__(256) chk_moe(Args a) {
    __shared__ float hs[D]; __shared__ float act[DEXP];
    const int row = samp_row(blockIdx.x >> 1), k = blockIdx.x & 1, t = threadIdx.x;
    const float* rec = (const float*)(a.ws + WS_DBG) + (size_t)row * 4; const int e = (int)rec[k]; const float w = rec[2 + k];
    for (int c = t; c < D; c += 256) hs[c] = f8dec(((const unsigned char*)(a.ws + WS_H2))[(size_t)row * D + c]);
    __syncthreads();
    for (int j = t; j < DEXP; j += 256) { float gsum = 0.f, usum = 0.f; for (int c = 0; c < D; ++c) { gsum += hs[c] * f8r(a.in[I_WG][((size_t)e * D + c) * DEXP + j] * WGU_SCALE); usum += hs[c] * f8r(a.in[I_WU][((size_t)e * D + c) * DEXP + j] * WGU_SCALE); }
        gsum *= 1.0f / WGU_SCALE; usum *= 1.0f / WGU_SCALE;
        act[j] = f8r(gsum / (1.0f + expf(-gsum)) * usum); }
    __syncthreads();
    for (int n = t; n < D; n += 256) { float s = 0.f; for (int j = 0; j < DEXP; ++j) s += act[j] * f8r(a.in[I_WDN][((size_t)e * DEXP + j) * D + n] * WD_SCALE);
        const float ref = w * s * (1.0f / WD_SCALE); dbg_acc(a.ws, 9, ldbf((const bf16*)(a.ws + WS_YT) + ((size_t)row * 2 + k) * D + n) - ref, ref); }
}
__global__ void __launch_bounds__(256) chk_final(Args a) {
    __shared__ float sh[8];
    const int row = samp_row(blockIdx.x), b = row / SEQ, t = threadIdx.x; const float* mod = (const float*)(a.ws + WS_MOD);
    float v[4], ss = 0.f;
#pragma unroll
    for (int q = 0; q < 4; ++q) { const int c = t + 256 * q; v[q] = ldbf((const bf16*)(a.ws + WS_XMID) + (size_t)row * D + c) + mod[(size_t)b * 6 * D + 5 * D + c] * (ldbf((const bf16*)(a.ws + WS_YT) + (size_t)row * 2 * D + c) + ldbf((const bf16*)(a.ws + WS_YT) + (size_t)row * 2 * D + D + c)); ss += v[q] * v[q]; }
    const float rinv = 1.0f / sqrtf(block_sum256(ss, sh) / D + EPS);
#pragma unroll
    for (int q = 0; q < 4; ++q) { const int c = t + 256 * q; const float ref = v[q] * rinv * a.in[I_FG][c]; dbg_acc(a.ws, 10, a.out[(size_t)row * D + c] - ref, ref); }
}
__global__ void __launch_bounds__(256) chk_report(Args a) {
    const float* acc = (const float*)(a.ws + WS_CTL) + CW_DBG; int code = 0;
    for (int k = 10; k >= 0; --k) { if (k < DBG_FIRST) continue; const float tol = (k == 7) ? 0.02f : 1e-3f; if (!(acc[2 * k] <= tol * acc[2 * k + 1])) code = k + 1; }
    const float f = 1.0f + 0.5f * (float)code;
    for (size_t i = (size_t)blockIdx.x * 256 + threadIdx.x; i < (size_t)M * D; i += (size_t)gridDim.x * 256) a.out[i] *= f;
}
#endif

extern "C" void kernel_launch(void* const* d_in, const int* in_sizes, int n_in, void* d_out, int out_size, void* d_ws, size_t ws_size, hipStream_t stream) {
    static int grid = 0;
    if (grid == 0) {
        if (n_in != 25 || in_sizes[0] != M * D || out_size != M * D || ws_size < WS_END) { fprintf(stderr, "kernel_launch: unexpected shapes (n_in %d, in0 %d, out %d, ws %zu); nothing launched\n", n_in, n_in > 0 ? in_sizes[0] : -1, out_size, ws_size); grid = -1; return; }
        int dev = 0, cus = 0, per_cu = 0;
        if (hipGetDevice(&dev) != hipSuccess || hipDeviceGetAttribute(&cus, hipDeviceAttributeMultiprocessorCount, dev) != hipSuccess) { grid = -1; return; }
        if (hipFuncSetAttribute((const void*)mk_fwd, hipFuncAttributeMaxDynamicSharedMemorySize, LDS_BYTES) != hipSuccess) { fprintf(stderr, "kernel_launch: hipFuncSetAttribute failed\n"); grid = -1; return; }
        if (hipOccupancyMaxActiveBlocksPerMultiprocessor(&per_cu, (const void*)mk_fwd, NWAVES * 64, LDS_BYTES) != hipSuccess || per_cu < 1) fprintf(stderr, "kernel_launch: occupancy query reports %d\n", per_cu);
        (void)hipGetLastError();
        grid = cus;
    }
    if (grid < 0) return;
    if (hipMemsetAsync((char*)d_ws + WS_CTL, 0, DEBUG_CHECKS ? (size_t)(1 * MiB) : CTL_ZERO_BYTES, stream) != hipSuccess) return;
    Args a{};
    for (int i = 0; i < 25; ++i) a.in[i] = (const float*)d_in[i];
    a.out = (float*)d_out; a.ws = (unsigned char*)d_ws;
    if (MK_N_LAUNCHES == 1) { a.ph_lo = 0; a.ph_hi = N_PHASES; a.li = 0; hipLaunchKernelGGL(mk_fwd, dim3(grid), dim3(NWAVES * 64), LDS_BYTES, stream, a); }
    else for (int li = 0; li < RUN_PHASES; ++li) { a.ph_lo = li; a.ph_hi = li + 1; a.li = li; hipLaunchKernelGGL(mk_fwd, dim3(grid), dim3(NWAVES * 64), LDS_BYTES, stream, a);
#if DEBUG_CHECKS
        if (li == 2) { hipLaunchKernelGGL(chk_h1, dim3(NSAMP), dim3(256), 0, stream, a); hipLaunchKernelGGL(chk_inproj, dim3(NSAMP * INW / 256), dim3(256), 0, stream, a); }
        if (li == 3) { hipLaunchKernelGGL(chk_attn, dim3(NSAMP * 32 / 256), dim3(256), 0, stream, a); hipLaunchKernelGGL(chk_gmlp, dim3(NSAMP), dim3(512), 0, stream, a); }
        if (li == 4) hipLaunchKernelGGL(chk_merge, dim3(NSAMP * D / 256), dim3(256), 0, stream, a);
        if (li == 5) hipLaunchKernelGGL(chk_wo, dim3(NSAMP * D / 256), dim3(256), 0, stream, a);
        if (li == 6) hipLaunchKernelGGL(chk_router, dim3(NSAMP), dim3(256), 0, stream, a);
        if (li == 8) hipLaunchKernelGGL(chk_moe, dim3(NSAMP * 2), dim3(256), 0, stream, a);
        if (li == 9) { hipLaunchKernelGGL(chk_final, dim3(NSAMP), dim3(256), 0, stream, a); hipLaunchKernelGGL(chk_report, dim3(2048), dim3(256), 0, stream, a); }
#endif
    }
}
```

```cpp
#include <hip/hip_runtime.h>
#include <cstdio>
#include <cstdint>
#include <cmath>
#include <type_traits>

#ifndef MK_N_LAUNCHES
#define MK_N_LAUNCHES 1
#endif

#ifndef DEBUG_CHECKS
#define DEBUG_CHECKS 0
#endif
#ifndef DBG_FIRST
#define DBG_FIRST 0
#endif
#ifndef RUN_PHASES
#define RUN_PHASES 10
#endif
#define GAS __attribute__((address_space(1)))
#define LAS __attribute__((address_space(3)))
typedef unsigned short bf16;
typedef short bf16x8 __attribute__((ext_vector_type(8)));
typedef short s16x4 __attribute__((ext_vector_type(4)));
typedef float f32x2 __attribute__((ext_vector_type(2)));
typedef float f32x4 __attribute__((ext_vector_type(4)));
typedef float f32x16 __attribute__((ext_vector_type(16)));
typedef unsigned u32x2 __attribute__((ext_vector_type(2)));
typedef unsigned u32x4 __attribute__((ext_vector_type(4)));
typedef __bf16 bf16x2_t __attribute__((ext_vector_type(2)));
typedef GAS unsigned gu32;

constexpr int BATCH = 8, SEQ = 4096, D = 1024, M = BATCH * SEQ;
constexpr int NQ = 512, NKV = 256  , GMW = 512, INW = 3840;
constexpr int NEXP = 32, DEXP = 512;
constexpr float EPS = 1e-6f;
constexpr float LOG2E = 1.4426950408889634f;
constexpr float QSCALE = 0.125f * LOG2E;
constexpr int LIST_CAP = 32768;
constexpr int HACT_ROWS = 73728;

constexpr size_t MiB = 1u << 20;
constexpr size_t WS_CTL = 0, CTL_ZERO_BYTES = 32 * 1024;
constexpr size_t WS_MOD = 1 * MiB;
constexpr size_t WS_MODP = 1 * MiB + 256 * 1024;
constexpr size_t WS_WST = 4 * MiB + 512 * 1024;
constexpr size_t WS_LROW = 5 * MiB;
constexpr size_t WS_LW = 9 * MiB;
constexpr size_t WS_GT = 13 * MiB;
constexpr size_t WS_GC = 13 * MiB + 800 * 1024;
constexpr size_t WS_WIN = 14 * MiB;
constexpr size_t WS_WIN8 = 18 * MiB;
constexpr size_t WS_H1F8 = 186 * MiB;
#ifndef GUGV_FP8
#define GUGV_FP8 1
#endif
#ifndef P4_FP8
#define P4_FP8 1
#endif
#ifndef WO_FP8
#define WO_FP8 1
#endif
constexpr float MG_SCALE = WO_FP8 ? 16.0f : 1.0f;
constexpr float YAB_SCALE = 16.0f, PA_SCALE = MG_SCALE * 65536.0f / (YAB_SCALE * 255.0f);
constexpr int NBF = GUGV_FP8 ? 768 : 1792;
constexpr size_t WS_PA = 22 * MiB;
constexpr size_t WS_WO = 24 * MiB;
constexpr size_t WS_WGU = 26 * MiB;
constexpr size_t WS_WD = 90 * MiB;
constexpr size_t WS_A = 122 * MiB;
constexpr size_t WS_YAB = 186 * MiB;
constexpr size_t WS_YT = 122 * MiB;
constexpr size_t WS_Q = 250 * MiB;
constexpr size_t WS_KV = 282 * MiB;
constexpr size_t WS_GU = 298 * MiB, WS_GV = 330 * MiB;
constexpr size_t WS_T = 298 * MiB;
constexpr size_t WS_HACT = 250 * MiB;
constexpr size_t WS_GA = 362 * MiB;
constexpr size_t WS_XMID = 362 * MiB;
constexpr size_t WS_GB = 426 * MiB;
constexpr size_t WS_H2 = 426 * MiB;
constexpr size_t WS_END = 490 * MiB;
static_assert(WS_HACT + (size_t)HACT_ROWS * 1024 <= WS_GA, "HACT overlay");
constexpr int CW_TMO = 0, CW_CODE = 1;
constexpr int CW_CNT = 1024;
constexpr int CW_BAR = 4096;

constexpr int RING_OFF = 0, RING_BYTES = 131072;
constexpr int LDSCTL_OFF = RING_BYTES, MISC_OFF = LDSCTL_OFF + 320;
constexpr int TAB_OFF = RING_BYTES + 512;
constexpr int TAB_UNITS = TAB_OFF, TAB_CNT = TAB_OFF + 256, TAB_ROWS = TAB_OFF + 1024, MAX_WG_UNITS = 14;
constexpr int CSH_OFF = TAB_ROWS + MAX_WG_UNITS * 1024;
constexpr int LDS_BYTES = CSH_OFF + 16384;
static_assert(CSH_OFF % 16 == 0 && LDS_BYTES <= 163840 - 256, "LDS map");
constexpr int NWAVES = 8;
constexpr int N_PHASES = 10;

#define LDS_WAIT() asm volatile("s_waitcnt lgkmcnt(0)" ::: "memory")
#define VM_WAIT() asm volatile("s_waitcnt vmcnt(0)" ::: "memory")
#define RLX_AGENT __ATOMIC_RELAXED, __HIP_MEMORY_SCOPE_AGENT
__device__ __forceinline__ unsigned cvtpk(float lo, float hi) { f32x2 v = {lo, hi}; bf16x2_t b = __builtin_convertvector(v, bf16x2_t); return __builtin_bit_cast(unsigned, b); }
__device__ __forceinline__ float bf_lo(unsigned w) { return __uint_as_float(w << 16); }
__device__ __forceinline__ float bf_hi(unsigned w) { return __uint_as_float(w & 0xffff0000u); }
__device__ __forceinline__ float wave_sum(float v) {
    int x = __float_as_int(v);
#define WS_DPP(ctrl, rmask) x = __float_as_int(__int_as_float(x) + __int_as_float(__builtin_amdgcn_update_dpp(0, x, (ctrl), (rmask), 0xf, false)))
    WS_DPP(0xB1, 0xf);
    WS_DPP(0x4E, 0xf);
    WS_DPP(0x141, 0xf);
    WS_DPP(0x140, 0xf);
    WS_DPP(0x142, 0xa);
    WS_DPP(0x143, 0xc);
#undef WS_DPP
    return __int_as_float(__builtin_amdgcn_readlane(x, 63));
}
__device__ __forceinline__ float clamp448(float v) { return __builtin_amdgcn_fmed3f(v, -448.0f, 448.0f); }
__device__ __forceinline__ unsigned pk4_fp8(float a, float b, float c, float d) {
    unsigned r = 0; r = __builtin_amdgcn_cvt_pk_fp8_f32(clamp448(a), clamp448(b), r, false); r = __builtin_amdgcn_cvt_pk_fp8_f32(clamp448(c), clamp448(d), r, true); return r; }
__device__ __forceinline__ u32x2 pack8_fp8(const f32x4 a, const f32x4 b) { u32x2 w; w.x = pk4_fp8(a[0], a[1], a[2], a[3]); w.y = pk4_fp8(b[0], b[1], b[2], b[3]); return w; }
constexpr float WGU_SCALE = 64.0f, WD_SCALE = 32.0f;
__device__ __forceinline__ unsigned pk4_u8(float a, float b, float c, float d) {
    return (unsigned)(a * 255.0f + 0.5f) | ((unsigned)(b * 255.0f + 0.5f) << 8) | ((unsigned)(c * 255.0f + 0.5f) << 16) | ((unsigned)(d * 255.0f + 0.5f) << 24); }
__device__ __forceinline__ void unpack8_u8(const u32x2 w, f32x4& a, f32x4& b) {
    a = (f32x4){(float)(w.x & 0xffu), (float)((w.x >> 8) & 0xffu), (float)((w.x >> 16) & 0xffu), (float)(w.x >> 24)};
    b = (f32x4){(float)(w.y & 0xffu), (float)((w.y >> 8) & 0xffu), (float)((w.y >> 16) & 0xffu), (float)(w.y >> 24)}; }
__device__ __forceinline__ float sigmoid_f(float x) { return __builtin_amdgcn_rcpf(1.0f + __builtin_amdgcn_exp2f(-x * LOG2E)); }
__device__ __forceinline__ float gelu_tanh_f(float x) {
    const float t = x * __builtin_fmaf(x * x, -2.3022081987f * 0.044715f, -2.3022081987f);
    return x * __builtin_amdgcn_rcpf(1.0f + __builtin_amdgcn_exp2f(t));
}
__device__ __forceinline__ f32x2 exp2_2(const f32x2 v) { return (f32x2){__builtin_amdgcn_exp2f(v.x), __builtin_amdgcn_exp2f(v.y)}; }
__device__ __forceinline__ f32x2 rcp_2(const f32x2 v) { return (f32x2){__builtin_amdgcn_rcpf(v.x), __builtin_amdgcn_rcpf(v.y)}; }
__device__ __forceinline__ f32x2 lo2(const f32x4 v) { return __builtin_shufflevector(v, v, 0, 1); }
__device__ __forceinline__ f32x2 hi2(const f32x4 v) { return __builtin_shufflevector(v, v, 2, 3); }
__device__ __forceinline__ f32x4 cat2(const f32x2 a, const f32x2 b) { return __builtin_shufflevector(a, b, 0, 1, 2, 3); }
__device__ __forceinline__ f32x2 gelu_tanh_2(const f32x2 x) {
    const f32x2 c1 = {-2.3022081987f, -2.3022081987f}, c2 = {-2.3022081987f * 0.044715f, -2.3022081987f * 0.044715f};
    const f32x2 t = x * __builtin_elementwise_fma(x * x, c2, c1);
    return x * rcp_2(exp2_2(t) + 1.0f); }
__device__ __forceinline__ f32x4 gelu_tanh_4(const f32x4 v) { return cat2(gelu_tanh_2(lo2(v)), gelu_tanh_2(hi2(v))); }
template <bool LO1> __device__ __forceinline__ unsigned sigcode_4(const f32x4 t) {
    const f32x2 k = {1.0f / 255.0f, 1.0f / 255.0f};
    f32x2 a = rcp_2(__builtin_elementwise_fma(exp2_2(lo2(t)), k, k)), b = rcp_2(__builtin_elementwise_fma(exp2_2(hi2(t)), k, k));
    if (LO1) { a.x = fmaxf(a.x, 1.0f); a.y = fmaxf(a.y, 1.0f); b.x = fmaxf(b.x, 1.0f); b.y = fmaxf(b.y, 1.0f); }
    unsigned w = 0u; w = __builtin_amdgcn_cvt_pk_u8_f32(a.x, 0, w); w = __builtin_amdgcn_cvt_pk_u8_f32(a.y, 1, w); w = __builtin_amdgcn_cvt_pk_u8_f32(b.x, 2, w); w = __builtin_amdgcn_cvt_pk_u8_f32(b.y, 3, w); return w; }
__device__ __forceinline__ float silu_f(float x) { return x * __builtin_amdgcn_rcpf(1.0f + __builtin_amdgcn_exp2f(-x * LOG2E)); }

namespace pg8 {
constexpr int BM = 256, BK = 64, HALF = 128, HTB = HALF * BK * 2, STAGE_BYTES = 8 * HTB, NXCD = 8, WGM = 8;
__host__ __device__ __forceinline__ int lds_byte(int r, int c) { const int st = (r >> 4) * 2 + (c >> 5), rr = r & 15, cc = c & 31, ob = rr * 64 + cc * 2; return st * 1024 + (ob ^ (((ob >> 9) & 1) << 5)); }
__host__ __device__ __forceinline__ void stage_rc(int b, int& R, int& C) { const int st = b / 1024, sb = b % 1024, swz = sb ^ (((sb >> 9) & 1) << 5); R = (st >> 1) * 16 + swz / 64; C = (st & 1) * 32 + (swz % 64) / 2; }
__host__ __device__ __forceinline__ int perm32(int rho) { const int n = rho >> 4, i = rho & 15; return 8 * (i >> 2) + 4 * n + (i & 3); }

struct Unit { int pm, pn, v, e, ui; };

struct DenseOrder {
    int nM, nN, nwg, G, c;
    __device__ void init(int M_, int N_, int G_, int c_) { nM = M_ / BM; nN = N_ / BM; nwg = nM * nN; G = G_; c = c_; }
    __device__ bool tile(int i, Unit& u) const { return tileL((long)i * G + c, u); }
    __device__ bool tileL(long L, Unit& u) const {
        if (L >= nwg) return false;
        int wgid = (int)L; { const int q = nwg / NXCD, r = nwg % NXCD, xcd = wgid % NXCD, off = wgid / NXCD; wgid = (xcd < r ? xcd * (q + 1) : r * (q + 1) + (xcd - r) * q) + off; }
        const int nig = WGM * nN, gid = wgid / nig, fm = gid * WGM, gsz = (nM - fm) < WGM ? (nM - fm) : WGM;
        u.pm = fm + ((wgid % nig) % gsz); u.pn = (wgid % nig) / gsz; u.v = 0; u.e = 0; u.ui = 0; return true;
    }
    __device__ bool next(int i, Unit& u) const { return tile(i, u); }
};
struct BackfillOrder : DenseOrder {
    __device__ bool next(int i, Unit& u) const {
        const int full = 3;
        if (i < full) return tileL((long)i * G + c, u);
        if (c >= G / 2) return tileL((long)full * G + (long)(i - full) * (G - G / 2) + (c - G / 2), u);
        return false; }
};

template <class Prob, class Epi, class Sched, bool ALIGN_EPI>
__device__ __forceinline__ void gemm_phase(LAS unsigned char* lds, const Prob& P, const Sched& S, const Epi& E) {
    const int tid = threadIdx.x, wid = __builtin_amdgcn_readfirstlane(tid >> 6), lane = tid & 63, wr = wid >> 2, wc = wid & 3, fr = lane & 15, fq = lane >> 4;
    const int nt = P.Kb / 128;
    int Rr[2], Cc[2]; unsigned voffB[2], aoc[2][2], aon[2][2];
#pragma unroll
    for (int i = 0; i < 2; ++i) { int R, C; stage_rc(tid * 16 + i * 8192, R, C); Rr[i] = R; Cc[i] = C; const int Rb = Epi::PERM ? ((R & ~31) + perm32(R & 31)) : R;
        voffB[i] = (unsigned)Rb * P.ldb + (unsigned)C * 2u; }
    const size_t kstep = (size_t)(BK * 2);
    const size_t hstepB = (size_t)HALF * P.ldb;
    const unsigned ldsw = (unsigned)wid * 1024u;
    const int aoff = lds_byte(wr * 64 + fr, fq * 8), boff = lds_byte(wc * 32 + fr, fq * 8);
#define PG8_SA(b, h) (((b) * 2 + (h)) * HTB)
#define PG8_SB(b, h) ((4 + (b) * 2 + (h)) * HTB)
#define PG8_STG(bufoff, p0, p1) do { \
        __builtin_amdgcn_global_load_lds((const unsigned*)(p0), (LAS unsigned*)(lds + (bufoff) + ldsw), 16, 0, 0); \
        __builtin_amdgcn_global_load_lds((const unsigned*)(p1), (LAS unsigned*)(lds + (bufoff) + ldsw + 8192), 16, 0, 0); } while (0)
#define PG8_STGB(bufoff, base) PG8_STG(bufoff, (base) + voffB[0], (base) + voffB[1])
#define PG8_STGA(bufoff, base, off, h) PG8_STG(bufoff, (base) + off[h][0], (base) + off[h][1])
#define PG8_LDF(dst, addr) do { if constexpr (Prob::F8) { const i32x4 lo_ = *(const LAS i32x4*)(addr), hi_ = *(const LAS i32x4*)((addr) + 1024); dst.v = __builtin_shufflevector(lo_, hi_, 0, 1, 2, 3, 4, 5, 6, 7); } \
        else { dst.k[0] = *(const LAS bf16x8*)(addr); dst.k[1] = *(const LAS bf16x8*)((addr) + 1024); } } while (0)
#define PG8_LDA(dst, b, h) do { _Pragma("unroll") for (int m = 0; m < 4; ++m) PG8_LDF(dst[m], lds + PG8_SA(b, h) + aoff + m * 2048); } while (0)
#define PG8_LDB(dst, b, h) do { _Pragma("unroll") for (int n = 0; n < 2; ++n) PG8_LDF(dst[n], lds + PG8_SB(b, h) + boff + n * 2048); } while (0)
#define PG8_MMA(ai, bj, At, Bt) do { __builtin_amdgcn_s_setprio(1); _Pragma("unroll") for (int m = 0; m < 4; ++m) _Pragma("unroll") for (int n = 0; n < 2; ++n) { \
        if constexpr (Prob::F8) asm volatile("v_mfma_scale_f32_16x16x128_f8f6f4 %0, %1, %2, %0, %3, %3 op_sel_hi:[0,0,0]" : "+v"(acc[ai][bj][m][n]) : "v"(Bt[n].v), "v"(At[m].v), "v"(f8scale));   \
        else { _Pragma("unroll") for (int k = 0; k < 2; ++k) acc[ai][bj][m][n] = __builtin_amdgcn_mfma_f32_16x16x32_bf16(Bt[n].k[k], At[m].k[k], acc[ai][bj][m][n], 0, 0, 0); } } \
        __builtin_amdgcn_s_setprio(0); } while (0)
#define PG8_WAIT_V(n) asm volatile("s_waitcnt vmcnt(" #n ")" ::: "memory")
#define PG8_WAIT_L(n) asm volatile("s_waitcnt lgkmcnt(" #n ")" ::: "memory")
#define PG8_BAR __builtin_amdgcn_s_barrier()
#define PG8_SCHED __builtin_amdgcn_sched_barrier(0)
#define PG8_AOFF(dst, ui_) do { _Pragma("unroll") for (int h = 0; h < 2; ++h) _Pragma("unroll") for (int i = 0; i < 2; ++i) { \
        if constexpr (Prob::GATHER) dst[h][i] = P.rowtab[(ui_) * 256 + h * HALF + Rr[i]] + (unsigned)Cc[i] * 2u; \
        else dst[h][i] = (unsigned)(h * HALF + Rr[i]) * P.lda + (unsigned)Cc[i] * 2u; } } while (0)
    Unit cur, nxt; int ui = 0;
    if (!S.next(0, cur)) return;
    f32x4 acc[2][2][4][2];
#pragma unroll
    for (int a = 0; a < 2; ++a)
#pragma unroll
        for (int b = 0; b < 2; ++b)
#pragma unroll
            for (int m = 0; m < 4; ++m)
#pragma unroll
                for (int n = 0; n < 2; ++n) acc[a][b][m][n] = (f32x4){0.f, 0.f, 0.f, 0.f};
    typedef int i32x8 __attribute__((ext_vector_type(8))); typedef int i32x4 __attribute__((ext_vector_type(4)));
    struct FragBf { bf16x8 k[2]; }; struct FragF8 { i32x8 v; };
    typedef typename std::conditional<Prob::F8, FragF8, FragBf>::type Frag;
    Frag At[4], B0[2], B1[2];
    int f8scale = Prob::F8 ? Prob::E8M0 : 0x7f7f7f7f; asm volatile("" : "+v"(f8scale));
    const char* cA = P.a_ptr(cur); const char* cB = P.b_ptr(cur);
    PG8_AOFF(aoc, 0);
#pragma unroll
    for (int h = 0; h < 2; ++h)
#pragma unroll
        for (int i = 0; i < 2; ++i) aon[h][i] = aoc[h][i];
    PG8_STGB(PG8_SB(0, 0), cB); PG8_STGB(PG8_SB(0, 1), cB + hstepB); PG8_STGA(PG8_SA(0, 0), cA, aoc, 0); PG8_STGA(PG8_SA(0, 1), cA, aoc, 1);
    if (wr == 1) PG8_BAR;
    PG8_WAIT_V(2); PG8_BAR;
    PG8_STGB(PG8_SB(1, 0), cB + kstep); PG8_STGA(PG8_SA(1, 0), cA + kstep, aoc, 0); PG8_STGB(PG8_SB(1, 1), cB + hstepB + kstep);
    PG8_WAIT_V(6); PG8_BAR;
    for (;;) {
        const bool has_next = S.next(ui + 1, nxt);
        const int act0 = Prob::RAGGED ? __builtin_amdgcn_readfirstlane(cur.v + wr * 64 < (cur.e >> 6) ? 1 : 0) : 1, act1 = Prob::RAGGED ? __builtin_amdgcn_readfirstlane(cur.v + 128 + wr * 64 < (cur.e >> 6) ? 1 : 0) : 1;
        const char* nA = has_next ? P.a_ptr(nxt) : cA; const char* nB = has_next ? P.b_ptr(nxt) : cB;
        for (int t = 0; t < nt; t += 2) {
            const bool last = (t == nt - 2);
            const char* a1 = cA + (size_t)(t + 1) * kstep;
            const char* a2 = last ? nA : cA + (size_t)(t + 2) * kstep; const char* b2 = last ? nB : cB + (size_t)(t + 2) * kstep;
            const char* a3 = a2 + kstep; const char* b3 = b2 + kstep;
            unsigned ao2[2][2];
            if constexpr (Prob::GATHER) {
                if (last && has_next) PG8_AOFF(aon, ui + 1);
#pragma unroll
                for (int h = 0; h < 2; ++h)
#pragma unroll
                    for (int i = 0; i < 2; ++i) ao2[h][i] = (last && has_next) ? aon[h][i] : aoc[h][i];
            } else {
#pragma unroll
                for (int h = 0; h < 2; ++h)
#pragma unroll
                    for (int i = 0; i < 2; ++i) ao2[h][i] = aoc[h][i];
            }
            if constexpr (Epi::MIDK) { if (t == nt / 2) E.mid(acc, cur, wr, wc, fr, fq); }
#define PG8_IF(c, X) do { if constexpr (Prob::RAGGED) { if (c) { X; } } else { X; } } while (0)
            PG8_LDB(B0, 0, 0); PG8_LDB(B1, 0, 1); PG8_SCHED; PG8_IF(act0, PG8_LDA(At, 0, 0)); PG8_STGA(PG8_SA(1, 1), a1, aoc, 1);
            PG8_WAIT_V(8); PG8_WAIT_L(0); PG8_BAR; PG8_IF(act0, PG8_MMA(0, 0, At, B0); PG8_MMA(0, 1, At, B1)); PG8_BAR; PG8_SCHED;
            PG8_IF(act1, PG8_LDA(At, 0, 1)); PG8_STGB(PG8_SB(0, 0), b2); PG8_STGB(PG8_SB(0, 1), b2 + hstepB); PG8_STGA(PG8_SA(0, 0), a2, ao2, 0);
            PG8_WAIT_V(8); PG8_WAIT_L(0); PG8_BAR; PG8_IF(act1, PG8_MMA(1, 0, At, B0); PG8_MMA(1, 1, At, B1)); PG8_BAR; PG8_SCHED;
            PG8_LDB(B0, 1, 0); PG8_LDB(B1, 1, 1); PG8_SCHED; PG8_IF(act0, PG8_LDA(At, 1, 0)); PG8_STGA(PG8_SA(0, 1), a2, ao2, 1);
            PG8_WAIT_V(8); PG8_WAIT_L(0); PG8_BAR; PG8_IF(act0, PG8_MMA(0, 0, At, B0); PG8_MMA(0, 1, At, B1)); PG8_BAR; PG8_SCHED;
            PG8_IF(act1, PG8_LDA(At, 1, 1)); PG8_STGB(PG8_SB(1, 0), b3); PG8_STGB(PG8_SB(1, 1), b3 + hstepB); PG8_STGA(PG8_SA(1, 0), a3, ao2, 0);
            PG8_WAIT_V(8); PG8_WAIT_L(0); PG8_BAR; PG8_IF(act1, PG8_MMA(1, 0, At, B0); PG8_MMA(1, 1, At, B1)); PG8_BAR; PG8_SCHED;
        }
        if constexpr (ALIGN_EPI) { if (wr == 0) PG8_BAR; }
        if constexpr (Prob::F8) asm volatile("s_nop 15\n\ts_nop 15\n\ts_nop 15" ::: "memory");
        E(acc, cur, wr, wc, fr, fq);
        if (!has_next) break;
#pragma unroll
        for (int a = 0; a < 2; ++a)
#pragma unroll
            for (int b = 0; b < 2; ++b)
#pragma unroll
                for (int m = 0; m < 4; ++m)
#pragma unroll
                    for (int n = 0; n < 2; ++n) acc[a][b][m][n] = (f32x4){0.f, 0.f, 0.f, 0.f};
        cur = nxt; cA = nA; cB = nB; ++ui;
        if constexpr (Prob::GATHER) {
#pragma unroll
            for (int h = 0; h < 2; ++h)
#pragma unroll
                for (int i = 0; i < 2; ++i) aoc[h][i] = aon[h][i];
        }
        if constexpr (ALIGN_EPI) { if (wr == 1) PG8_BAR; }
    }
    PG8_WAIT_V(0);
    if constexpr (!ALIGN_EPI) { if (wr == 0) PG8_BAR; }
    PG8_BAR;
#undef PG8_SA
#undef PG8_SB
#undef PG8_STG
#undef PG8_STGA
#undef PG8_STGB
#undef PG8_LDA
#undef PG8_LDF
#undef PG8_LDB
#undef PG8_MMA
#undef PG8_WAIT_V
#undef PG8_WAIT_L
#undef PG8_BAR
#undef PG8_SCHED
#undef PG8_AOFF
}
}

#define XB_TMO      128
#define XB_XCNT(j)  (256  + 64 * (j))
#define XB_XSUB(j)  (1280 + 64 * (j))
#define XB_XGEN(j)  (2304 + 64 * (j))
#define XB_TOP      3328
#define XB_TOPGEN   3392
#define XCD_BAR_WORDS 3456
#define XB_SPIN_CAP (1u << 18)
__device__ __forceinline__ unsigned xb_ld(unsigned* p)              { return __hip_atomic_load(p, __ATOMIC_RELAXED, __HIP_MEMORY_SCOPE_AGENT); }
__device__ __forceinline__ unsigned xb_add(unsigned* p, unsigned v) { return __hip_atomic_fetch_add(p, v, __ATOMIC_RELAXED, __HIP_MEMORY_SCOPE_AGENT); }
__device__ __forceinline__ unsigned xb_xcc_id() { return (unsigned)__builtin_amdgcn_s_getreg((3 << 11) | 20) & 0xFu; }
#define XB_SPIN(cond, bar) do { unsigned _sp = 0; while (cond) { __builtin_amdgcn_s_sleep(1); \
    if ((++_sp & 255u) == 0u) { if (xb_ld(&(bar)[XB_TMO])) break; if (_sp > XB_SPIN_CAP) { atomicAdd(&(bar)[XB_TMO], 1u); break; } } } } while (0)
struct XcdBarrier { unsigned* bar; unsigned x; volatile LAS unsigned* st; };
__device__ __forceinline__ XcdBarrier xcd_barrier_post(unsigned* bar, volatile LAS unsigned* st) {
    XcdBarrier b; b.bar = bar; b.x = xb_xcc_id(); b.st = st;
    if (threadIdx.x == 0) (void)xb_add(&bar[XB_XCNT(b.x)], 1u);
    return b;
}
__device__ __forceinline__ void xcd_barrier_complete(unsigned* bar, unsigned x, unsigned& nloc, unsigned& nx) {
    const unsigned G = gridDim.x * gridDim.y * gridDim.z;
    unsigned sum, cnt, mine, sp = 0u;
    for (;;) {
        sum = 0u; cnt = 0u; mine = 0u;
#pragma unroll
        for (unsigned j = 0; j < 16; ++j) { const unsigned c = xb_ld(&bar[XB_XCNT(j)]); sum += c; cnt += (c > 0u) ? 1u : 0u; mine = (j == x) ? c : mine; }
        if (sum == G) break;
        __builtin_amdgcn_s_sleep(1);
        if ((++sp & 255u) == 0u) { if (xb_ld(&bar[XB_TMO])) break; if (sp > XB_SPIN_CAP) { atomicAdd(&bar[XB_TMO], 1u); break; } }
    }
    nloc = mine > 0u ? mine : 1u; nx = cnt > 0u ? cnt : 1u;
}
__device__ __forceinline__ void xcd_barrier(const XcdBarrier& b) {
    asm volatile("s_waitcnt vmcnt(0)" ::: "memory");
    __syncthreads();
    if (threadIdx.x == 0) {
        unsigned* bar = b.bar;
        __builtin_amdgcn_s_waitcnt(0);
        unsigned nloc = b.st[0], nx = b.st[1];
        if (nloc == 0u) { xcd_barrier_complete(bar, b.x, nloc, nx); b.st[0] = nloc; b.st[1] = nx; }
        const unsigned old = xb_add(&bar[XB_XSUB(b.x)], 1u);
        const unsigned gen = old / nloc;
        if (old + 1u == (gen + 1u) * nloc) {
            __builtin_amdgcn_fence(__ATOMIC_RELEASE, "agent");
            asm volatile("s_waitcnt vmcnt(0)" ::: "memory");
            const unsigned og = xb_add(&bar[XB_TOP], 1u);
            const unsigned tg = og / nx;
            if (og + 1u == (tg + 1u) * nx) xb_add(&bar[XB_TOPGEN], 1u);
            else XB_SPIN(xb_ld(&bar[XB_TOPGEN]) == tg, bar);
            __builtin_amdgcn_fence(__ATOMIC_ACQUIRE, "agent");
            xb_add(&bar[XB_XGEN(b.x)], 1u);
            asm volatile("s_waitcnt vmcnt(0)" ::: "memory");
        } else {
            XB_SPIN(xb_ld(&bar[XB_XGEN(b.x)]) == gen, bar);
            __builtin_amdgcn_fence(__ATOMIC_ACQUIRE, "agent");
            asm volatile("s_waitcnt vmcnt(0)" ::: "memory");
        }
    }
    __syncthreads();
}

struct Args {
    const float* in[25]; float* out; unsigned char* ws; int ph_lo, ph_hi, li, pad;
};
struct Frame {
    LAS unsigned char* lds;
    volatile LAS unsigned* MISC;
    gu32* ctl;
    unsigned char* ws;
    int tid, lane, wave, vcu, G;
};
enum { I_X = 0, I_C, I_POS, I_RELB, I_WADA, I_BADA, I_N1G, I_WIN, I_SINKS, I_LNG, I_LNB, I_GWS, I_GBS, I_PA, I_PB, I_WO, I_N2G, I_WRG, I_BRG, I_WRE, I_BRE, I_WG, I_WU, I_WDN, I_FG };

__device__ __forceinline__ void p0_transpose_tile(const float* W, int N, int k0, int n0, bf16* WT, int ldt, int drow0, LAS float* scr, int lane, float scale = 1.0f) {
    {
        f32x4 t[8];
#pragma unroll
        for (int i = 0; i < 8; ++i) t[i] = __builtin_nontemporal_load((const GAS f32x4*)(W + (size_t)(k0 + 8 * i + (lane >> 3)) * N + n0 + 4 * (lane & 7))) * scale;
#pragma unroll
        for (int i = 0; i < 8; ++i) { LAS float* d = scr + (8 * i + (lane >> 3)) * 33 + 4 * (lane & 7); d[0] = t[i][0]; d[1] = t[i][1]; d[2] = t[i][2]; d[3] = t[i][3]; }
    }
    LDS_WAIT(); asm volatile("" ::: "memory");
    const int c = lane & 7;
#pragma unroll
    for (int j = 0; j < 4; ++j) { const int n = (lane >> 3) + 8 * j; const LAS float* s = scr + (8 * c) * 33 + n;
        u32x4 o; o.x = cvtpk(s[0 * 33], s[1 * 33]); o.y = cvtpk(s[2 * 33], s[3 * 33]); o.z = cvtpk(s[4 * 33], s[5 * 33]); o.w = cvtpk(s[6 * 33], s[7 * 33]);
        *(GAS u32x4*)(WT + (size_t)(drow0 + n) * ldt + k0 + 8 * c) = o; }
    LDS_WAIT(); asm volatile("" ::: "memory");
}
__device__ __forceinline__ void p0_transpose_tile_f8(const float* W, int N, int k0, int n0, unsigned char* WT, int ldt, int drow0, float scale, LAS float* scr, int lane) {
    {
        f32x4 t[16];
#pragma unroll
        for (int i = 0; i < 16; ++i) t[i] = __builtin_nontemporal_load((const GAS f32x4*)(W + (size_t)(k0 + 8 * i + (lane >> 3)) * N + n0 + 4 * (lane & 7)));
#pragma unroll
        for (int i = 0; i < 16; ++i) { const int k = 8 * i + (lane >> 3); *(LAS f32x4*)(scr + k * 32 + ((4 * (lane & 7)) ^ (4 * (k >> 4)))) = t[i]; }
    }
    LDS_WAIT(); asm volatile("" ::: "memory");
    const int c = lane & 7;
#pragma unroll
    for (int j = 0; j < 4; ++j) { const int n = (lane >> 3) + 8 * j; const LAS float* sp = scr + (16 * c) * 32 + (n ^ (4 * c));
        u32x4 o;
        o.x = pk4_fp8(sp[0 * 32] * scale, sp[1 * 32] * scale, sp[2 * 32] * scale, sp[3 * 32] * scale); o.y = pk4_fp8(sp[4 * 32] * scale, sp[5 * 32] * scale, sp[6 * 32] * scale, sp[7 * 32] * scale);
        o.z = pk4_fp8(sp[8 * 32] * scale, sp[9 * 32] * scale, sp[10 * 32] * scale, sp[11 * 32] * scale); o.w = pk4_fp8(sp[12 * 32] * scale, sp[13 * 32] * scale, sp[14 * 32] * scale, sp[15 * 32] * scale);
        *(GAS u32x4*)(WT + (size_t)(drow0 + n) * ldt + k0 + 16 * c) = o; }
    LDS_WAIT(); asm volatile("" ::: "memory");
}
__device__ __forceinline__ void p0_prologue(Frame& F, const Args& A) {
    const int gw = F.vcu * NWAVES + F.wave, NGW = F.G * NWAVES, lane = F.lane;
    {
        const float* c = A.in[I_C]; const float* w = A.in[I_WADA]; float* modp = (float*)(F.ws + WS_MODP);
        for (int it = gw; it < 96 * 16; it += NGW) {
            const int cg = it % 96, ks = it / 96, k0 = ks * 64, col = cg * 64 + lane;
            float csv[8], acc[8];
#pragma unroll
            for (int b = 0; b < 8; ++b) { const float v = c[b * D + k0 + lane]; csv[b] = silu_f(v); acc[b] = 0.f; }
            float wv[64];
#pragma unroll
            for (int kk = 0; kk < 64; ++kk) wv[kk] = __builtin_nontemporal_load((const GAS float*)(w + (size_t)(k0 + kk) * (6 * D) + col));
#pragma unroll
            for (int kk = 0; kk < 64; ++kk) {
#pragma unroll
                for (int b = 0; b < 8; ++b) acc[b] += __int_as_float(__builtin_amdgcn_readlane(__float_as_int(csv[b]), kk)) * wv[kk];
            }
#pragma unroll
            for (int b = 0; b < 8; ++b) modp[((size_t)ks * 8 + b) * (6 * D) + col] = acc[b];
        }
    }
    {
        LAS float* scr = (LAS float*)(F.lds + RING_OFF + F.wave * 16384);
        constexpr int NB0 = NBF / 32, NB0F = (INW - NBF) / 32, S0 = 16 * NB0  , S0F = 8 * NB0F  , S1 = (P4_FP8 ? 4 : 8) * 32, S2 = (P4_FP8 ? 4 : 8) * 32, S3 = (WO_FP8 ? 8 : 16) * 32, S4 = 32 * 128, S5 = 32 * 128, S6 = 32 * 128;
        constexpr int NITEMS = S0 + S0F + S1 + S2 + S3 + S4 + S5 + S6;
        for (int it = gw; it < NITEMS; it += NGW) {
            int r = it;
            if (r < S0) { const int kb = r / NB0, nb = r % NB0; p0_transpose_tile(A.in[I_WIN], INW, 64 * kb, 32 * nb, (bf16*)(F.ws + WS_WIN), D, 32 * nb, scr, lane); continue; } r -= S0;
            if (r < S0F) { const int kb = r / NB0F, nb = r % NB0F; p0_transpose_tile_f8(A.in[I_WIN], INW, 128 * kb, NBF + 32 * nb, (unsigned char*)(F.ws + WS_WIN8), D, 32 * nb, NBF + 32 * nb < 1792 ? WGU_SCALE : -WGU_SCALE * LOG2E, scr, lane); continue; } r -= S0F;
            if (r < S1) { const int kb = r / 32, nb = r % 32;
                if constexpr (P4_FP8) p0_transpose_tile_f8(A.in[I_PA], D, 128 * kb, 32 * nb, (unsigned char*)(F.ws + WS_PA), D, 32 * nb, PA_SCALE, scr, lane);
                else p0_transpose_tile(A.in[I_PA], D, 64 * kb, 32 * nb, (bf16*)(F.ws + WS_PA), D, 32 * nb, scr, lane, 1.0f / 255.0f);
                continue; } r -= S1;
            if (r < S2) { const int kb = r / 32, nb = r % 32;
                if constexpr (P4_FP8) p0_transpose_tile_f8(A.in[I_PB], D, 128 * kb, 32 * nb, (unsigned char*)(F.ws + WS_PA) + NQ, D, 32 * nb, PA_SCALE, scr, lane);
                else p0_transpose_tile(A.in[I_PB], D, 64 * kb, 32 * nb, (bf16*)(F.ws + WS_PA) + NQ, D, 32 * nb, scr, lane, 1.0f / 255.0f);
                continue; } r -= S2;
            if (r < S3) { const int kb = r / 32, nb = r % 32;
                if constexpr (WO_FP8) p0_transpose_tile_f8(A.in[I_WO], D, 128 * kb, 32 * nb, (unsigned char*)(F.ws + WS_WO), D, 32 * nb, WGU_SCALE, scr, lane);
                else p0_transpose_tile(A.in[I_WO], D, 64 * kb, 32 * nb, (bf16*)(F.ws + WS_WO), D, 32 * nb, scr, lane);
                continue; } r -= S3;
            if (r < S4 + S5) { const int up = r >= S4 ? 1 : 0; if (up) r -= S4; const int e = r >> 7, q = r & 127, kb = q / 16, nb = q % 16, n0 = 32 * nb;
                p0_transpose_tile_f8(A.in[up ? I_WU : I_WG] + (size_t)e * D * DEXP, DEXP, 128 * kb, n0, (unsigned char*)(F.ws + WS_WGU) + (size_t)e * 1024 * 1024, D, (n0 >> 7) * 256 + up * 128 + (n0 & 127), up ? -WGU_SCALE / LOG2E : -WGU_SCALE * LOG2E, scr, lane); continue; }
            r -= S4 + S5;
            { const int e = r >> 7, q = r & 127, kb = q / 32, nb = q % 32; p0_transpose_tile_f8(A.in[I_WDN] + (size_t)e * DEXP * D, D, 128 * kb, 32 * nb, (unsigned char*)(F.ws + WS_WD) + (size_t)e * 1024 * DEXP, DEXP, 32 * nb, WD_SCALE, scr, lane); }
        }
        const float* gws = A.in[I_GWS]; bf16* wst = (bf16*)(F.ws + WS_WST);
        for (int i = F.vcu * 512 + F.tid; i < 4 * 128 * 128 / 2; i += F.G * 512) { const int e0 = 2 * i, t = (e0 >> 7) & 127, s = e0 & 127;
            const float a = s <= t ? gws[e0] : 0.f, b = (s + 1) <= t ? gws[e0 + 1] : 0.f; ((unsigned*)wst)[i] = cvtpk(a, b); }
    }
}

__device__ __forceinline__ float mod_sum(const float* modp, const float* bada, int b, int j) {
    float s = bada[j];
#pragma unroll
    for (int ks = 0; ks < 16; ++ks) s += modp[((size_t)ks * 8 + b) * (6 * D) + j];
    return s;
}
__device__ __forceinline__ void p1_h1(Frame& F, const Args& A) {
    const float* modp = (const float*)(F.ws + WS_MODP); const float* bada = A.in[I_BADA]; float* mod = (float*)(F.ws + WS_MOD);
    for (int idx = F.vcu * 512 + F.tid; idx < 8 * 6 * D; idx += F.G * 512) { const int b = idx / (6 * D), j = idx % (6 * D); mod[idx] = mod_sum(modp, bada, b, j); }
    LAS float* Av = (LAS float*)(F.lds + RING_OFF); LAS float* Bv = Av + D;
    const float* x = A.in[I_X]; const float* g = A.in[I_N1G]; bf16* h1 = (bf16*)(F.ws + WS_A);
    for (int rb = F.vcu; rb < M / 128; rb += F.G) {
        const int b = rb / (SEQ / 128);
        __syncthreads();
        for (int c = F.tid; c < D; c += 512) { const float sh = mod_sum(modp, bada, b, c), sc = mod_sum(modp, bada, b, D + c); Av[c] = g[c] * (1.0f + sc); Bv[c] = sh; }
        __syncthreads();
        for (int j4 = 0; j4 < 16; j4 += 4) {
            f32x4 v[4][2][2];
#pragma unroll
            for (int r = 0; r < 4; ++r) { const float* xr = x + (size_t)(rb * 128 + F.wave * 16 + j4 + r) * D;
#pragma unroll
                for (int jj = 0; jj < 2; ++jj)
#pragma unroll
                    for (int q = 0; q < 2; ++q) v[r][jj][q] = __builtin_nontemporal_load((const GAS f32x4*)(xr + 512 * jj + 8 * F.lane + 4 * q)); }
#pragma unroll
            for (int r = 0; r < 4; ++r) { const int row = rb * 128 + F.wave * 16 + j4 + r; float ss = 0.f;
#pragma unroll
                for (int jj = 0; jj < 2; ++jj)
#pragma unroll
                    for (int q = 0; q < 2; ++q) ss += (v[r][jj][q].x * v[r][jj][q].x + v[r][jj][q].y * v[r][jj][q].y) + (v[r][jj][q].z * v[r][jj][q].z + v[r][jj][q].w * v[r][jj][q].w);
                const float rinv = 1.0f / sqrtf(wave_sum(ss) * (1.0f / D) + EPS);
#pragma unroll
                for (int jj = 0; jj < 2; ++jj) { const int c0 = 512 * jj + 8 * F.lane;
                    const f32x4 a0 = *(const LAS f32x4*)(Av + c0), a1 = *(const LAS f32x4*)(Av + c0 + 4), b0 = *(const LAS f32x4*)(Bv + c0), b1 = *(const LAS f32x4*)(Bv + c0 + 4);
                    const f32x4 o0 = v[r][jj][0] * rinv * a0 + b0, o1 = v[r][jj][1] * rinv * a1 + b1;
                    u32x4 w; w.x = cvtpk(o0.x, o0.y); w.y = cvtpk(o0.z, o0.w); w.z = cvtpk(o1.x, o1.y); w.w = cvtpk(o1.z, o1.w);
                    *(GAS u32x4*)(h1 + (size_t)row * D + c0) = w;
                    *(GAS u32x2*)((unsigned char*)(F.ws + WS_H1F8) + (size_t)row * D + c0) = pack8_fp8(o0, o1); }
            }
        }
    }
}

struct ProbDense { int Kb; unsigned lda, ldb; const char* A; const char* B; static constexpr bool GATHER = false, RAGGED = false, F8 = false; static constexpr int E8M0 = 0x7f7f7f7f; const LAS unsigned* rowtab;
    __device__ __forceinline__ const char* a_ptr(const pg8::Unit& u) const { return A + (size_t)u.pm * 256 * lda; }
    __device__ __forceinline__ const char* b_ptr(const pg8::Unit& u) const { return B + (size_t)u.pn * 256 * ldb; } };
struct ProbDense8 { int Kb; unsigned lda, ldb; const char* A; const char* B; static constexpr bool GATHER = false, RAGGED = false, F8 = true; static constexpr int E8M0 = 0x7c7c7c7c; const LAS unsigned* rowtab;
    __device__ __forceinline__ const char* a_ptr(const pg8::Unit& u) const { return A + (size_t)u.pm * 256 * lda; }
    __device__ __forceinline__ const char* b_ptr(const pg8::Unit& u) const { return B + (size_t)u.pn * 256 * ldb; } };
struct ProbDense8m { int Kb; unsigned lda, ldb; const char* A; const char* B; static constexpr bool GATHER = false, RAGGED = false, F8 = true; static constexpr int E8M0 = 0x77777777; const LAS unsigned* rowtab;
    __device__ __forceinline__ const char* a_ptr(const pg8::Unit& u) const { return A + (size_t)u.pm * 256 * lda; }
    __device__ __forceinline__ const char* b_ptr(const pg8::Unit& u) const { return B + (size_t)u.pn * 256 * ldb; } };
struct ProbDense8w { int Kb; unsigned lda, ldb; const char* A; const char* B; static constexpr bool GATHER = false, RAGGED = false, F8 = true; static constexpr int E8M0 = 0x7a7a7a7a; const LAS unsigned* rowtab;
    __device__ __forceinline__ const char* a_ptr(const pg8::Unit& u) const { return A + (size_t)u.pm * 256 * lda; }
    __device__ __forceinline__ const char* b_ptr(const pg8::Unit& u) const { return B + (size_t)u.pn * 256 * ldb; } };
struct ProbGateUp { int Kb; unsigned lda, ldb; const char* A; const char* B; static constexpr bool GATHER = true, RAGGED = true, F8 = true; static constexpr int E8M0 = 0x7c7c7c7c; const LAS unsigned* rowtab;
    __device__ __forceinline__ const char* a_ptr(const pg8::Unit&) const { return A; }
    __device__ __forceinline__ const char* b_ptr(const pg8::Unit& u) const { return B + ((size_t)(u.e & 63) * 1024 + (size_t)u.pn * 256) * ldb; } };
struct ProbDown { int Kb; unsigned lda, ldb; const char* A; const char* B; static constexpr bool GATHER = false, RAGGED = true, F8 = true; static constexpr int E8M0 = 0x7f7f7f7f; const LAS unsigned* rowtab;
    __device__ __forceinline__ const char* a_ptr(const pg8::Unit& u) const { return A + (size_t)u.pm * 256 * lda; }
    __device__ __forceinline__ const char* b_ptr(const pg8::Unit& u) const { return B + ((size_t)(u.e & 63) * 1024 + (size_t)u.pn * 256) * ldb; } };

__device__ __forceinline__ u32x4 pair16(const u32x2 p0, const u32x2 p1) {
    const auto rx = __builtin_amdgcn_permlane16_swap(p0.x, p1.x, false, false); const auto ry = __builtin_amdgcn_permlane16_swap(p0.y, p1.y, false, false);
    return (u32x4){(unsigned)rx[0], (unsigned)ry[0], (unsigned)rx[1], (unsigned)ry[1]}; }
__device__ __forceinline__ void unpair16(const u32x4 l, u32x2& p0, u32x2& p1) {
    const auto rx = __builtin_amdgcn_permlane16_swap(l.x, l.z, false, false); const auto ry = __builtin_amdgcn_permlane16_swap(l.y, l.w, false, false);
    p0 = (u32x2){(unsigned)rx[0], (unsigned)ry[0]}; p1 = (u32x2){(unsigned)rx[1], (unsigned)ry[1]}; }
struct CSh {
    LAS unsigned char* slab; unsigned woff, roff; int rrow, rpc;
    __device__ __forceinline__ CSh(int wr, int wc, int fr, int fq) {
        extern __shared__ __attribute__((aligned(16))) unsigned char lds_dyn[];
        int lane = fq * 16 + fr; asm volatile("" : "+v"(lane));
        fr = lane & 15; fq = lane >> 4; rrow = lane >> 2; rpc = lane & 3;
        slab = (LAS unsigned char*)lds_dyn + CSH_OFF + (wr * 4 + wc) * 2048;
        woff = (unsigned)(fr * 64 + ((fq ^ ((fr >> 1) & 3)) << 4)); roff = (unsigned)(rrow * 64 + ((rpc ^ ((rrow >> 1) & 3)) << 4)); }
    __device__ __forceinline__ u32x4 xch(int k, const u32x4 w) const { LAS unsigned char* s_ = slab + (k & 1) * 1024; *(LAS u32x4*)(s_ + woff) = w; return *(const LAS u32x4*)(s_ + roff); }
};
__device__ __forceinline__ u32x4 pack8(const f32x4 a, const f32x4 b) { u32x4 w; w.x = cvtpk(a[0], a[1]); w.y = cvtpk(a[2], a[3]); w.z = cvtpk(b[0], b[1]); w.w = cvtpk(b[2], b[3]); return w; }
__device__ __forceinline__ void unpack8(const u32x4 w, f32x4& a, f32x4& b) { a = (f32x4){bf_lo(w.x), bf_hi(w.x), bf_lo(w.y), bf_hi(w.y)}; b = (f32x4){bf_lo(w.z), bf_hi(w.z), bf_lo(w.w), bf_hi(w.w)}; }

template <bool F8>
struct EpiInProjT {
    static constexpr bool PERM = true, MIDK = false;
    unsigned char* ws; int pn0; float scl;
    template <bool LO1> __device__ __forceinline__ void gates(const f32x4 (&acc)[2][2][4][2], unsigned char* base, int row0, int col0) const {
        asm volatile("" : "+v"(row0));
#pragma unroll
        for (int ai = 0; ai < 2; ++ai)
#pragma unroll
            for (int m = 0; m < 4; ++m)
            { u32x2 w[2];
#pragma unroll
                for (int bj = 0; bj < 2; ++bj) { w[bj].x = sigcode_4<LO1>(acc[ai][bj][m][0]); w[bj].y = sigcode_4<LO1>(acc[ai][bj][m][1]); }
                *(GAS u32x4*)(base + (size_t)(row0 + ai * 128 + m * 16) * D + col0) = pair16(w[0], w[1]); }
    }
    __device__ __forceinline__ void operator()(const f32x4 (&acc)[2][2][4][2], const pg8::Unit& u, int wr, int wc, int fr, int fq) const {
        const int pn = u.pn + pn0;
        if constexpr (F8) {
            const int row0 = u.pm * 256 + wr * 64 + fr, col0 = wc * 32 + 8 * (fq & ~1) + 128 * (fq & 1);
            if (pn < 11) gates<false>(acc, ws + WS_GA, row0, 256 * (pn - 7) + col0); else gates<true>(acc, ws + WS_GB, row0, 256 * (pn - 11) + col0);
        } else {
            bf16* base; int ldc, colt, act;
            if (pn < 2) { base = (bf16*)(ws + WS_Q); ldc = NQ; colt = 256 * pn; act = 0; }
            else if (pn == 2) { base = (bf16*)(ws + WS_KV); ldc = NKV; colt = 0; act = 1; }
            else if (pn < 5) { base = (bf16*)(ws + WS_GU); ldc = GMW; colt = 256 * (pn - 3); act = 2; }
            else { base = (bf16*)(ws + WS_GV); ldc = GMW; colt = 256 * (pn - 5); act = 2; }
            const CSh cs(wr, wc, fr, fq); int kk = 0;
#pragma unroll
            for (int ai = 0; ai < 2; ++ai)
#pragma unroll
                for (int m = 0; m < 4; ++m) { bf16* rowp = base + (size_t)(u.pm * 256 + wr * 64 + cs.rrow + ai * 128 + m * 16) * ldc + colt + wc * 32 + 8 * cs.rpc;
#pragma unroll
                    for (int bj = 0; bj < 2; ++bj) { f32x4 v0 = acc[ai][bj][m][0], v1 = acc[ai][bj][m][1];
                        if (act == 0) { v0 = v0 * QSCALE; v1 = v1 * QSCALE; }
                        else if (!GUGV_FP8 && act == 2) { v0 = gelu_tanh_4(v0); v1 = gelu_tanh_4(v1); }
                        *(GAS u32x4*)(rowp + bj * 128) = cs.xch(kk++, pack8(v0, v1)); } }
        }
    }
};
struct EpiGelu8 {
    static constexpr bool PERM = true, MIDK = false;
    unsigned char* ws;
    __device__ __forceinline__ void operator()(const f32x4 (&acc)[2][2][4][2], const pg8::Unit& u, int wr, int wc, int fr, int fq) const {
        bf16* base = (bf16*)(ws + (u.pn < 2 ? WS_GU : WS_GV)); const int colt = 256 * (u.pn & 1);
        const CSh cs(wr, wc, fr, fq); int kk = 0;
#pragma unroll
        for (int ai = 0; ai < 2; ++ai)
#pragma unroll
            for (int m = 0; m < 4; ++m) { bf16* rowp = base + (size_t)(u.pm * 256 + wr * 64 + cs.rrow + ai * 128 + m * 16) * GMW + colt + wc * 32 + 8 * cs.rpc;
#pragma unroll
                for (int bj = 0; bj < 2; ++bj) *(GAS u32x4*)(rowp + bj * 128) = cs.xch(kk++, pack8(gelu_tanh_4(acc[ai][bj][m][0]), gelu_tanh_4(acc[ai][bj][m][1]))); }
    }
};
struct EpiMerge {
    static constexpr bool PERM = true, MIDK = true;
    const unsigned char* GA; const unsigned char* GB; bf16* MG;
    __device__ __forceinline__ void mid(f32x4 (&acc)[2][2][4][2], const pg8::Unit& u, int wr, int wc, int fr_, int fq) const {
        int fr = fr_; asm volatile("" : "+v"(fr));
        const int row0 = u.pm * 256 + wr * 64 + fr, col0 = u.pn * 256 + wc * 32 + 8 * (fq & ~1) + 128 * (fq & 1);
#pragma unroll
        for (int ai = 0; ai < 2; ++ai) {
            u32x4 ga16[4], gb16[4]; u32x2 ga[4][2], gb[4][2];
#pragma unroll
            for (int m = 0; m < 4; ++m) { const size_t off = (size_t)(row0 + ai * 128 + m * 16) * D + col0; ga16[m] = *(const GAS u32x4*)(GA + off); gb16[m] = *(const GAS u32x4*)(GB + off); }
#pragma unroll
            for (int m = 0; m < 4; ++m) { unpair16(ga16[m], ga[m][0], ga[m][1]); unpair16(gb16[m], gb[m][0], gb[m][1]); }
#pragma unroll
            for (int m = 0; m < 4; ++m)
#pragma unroll
                for (int bj = 0; bj < 2; ++bj) { f32x4 a0, a1, b0, b1; unpack8_u8(ga[m][bj], a0, a1); unpack8_u8(gb[m][bj], b0, b1);
#pragma unroll
                    for (int q = 0; q < 4; ++q) { acc[ai][bj][m][0][q] *= a0[q] * __builtin_amdgcn_rcpf(b0[q]); acc[ai][bj][m][1][q] *= a1[q] * __builtin_amdgcn_rcpf(b1[q]); } }
            asm volatile("" ::: "memory");
        }
    }
    __device__ __forceinline__ void operator()(const f32x4 (&acc)[2][2][4][2], const pg8::Unit& u, int wr, int wc, int fr, int fq) const {
        const int row0 = u.pm * 256 + wr * 64 + fr, col0 = u.pn * 256 + wc * 32 + 8 * (fq & ~1) + 128 * (fq & 1);
        u32x4 gb16[2][4]; u32x2 gb[2][4][2];
#pragma unroll
        for (int ai = 0; ai < 2; ++ai)
#pragma unroll
            for (int m = 0; m < 4; ++m) gb16[ai][m] = *(const GAS u32x4*)(GB + (size_t)(row0 + ai * 128 + m * 16) * D + col0);
#pragma unroll
        for (int ai = 0; ai < 2; ++ai)
#pragma unroll
            for (int m = 0; m < 4; ++m) unpair16(gb16[ai][m], gb[ai][m][0], gb[ai][m][1]);
        if constexpr (WO_FP8) {
#pragma unroll
            for (int ai = 0; ai < 2; ++ai)
#pragma unroll
                for (int m = 0; m < 4; ++m) { u32x2 pk[2];
#pragma unroll
                    for (int bj = 0; bj < 2; ++bj) { f32x4 b0, b1; unpack8_u8(gb[ai][m][bj], b0, b1); pk[bj] = pack8_fp8(acc[ai][bj][m][0] * b0, acc[ai][bj][m][1] * b1); }
                    *(GAS u32x4*)((unsigned char*)MG + (size_t)(row0 + ai * 128 + m * 16) * D + col0) = pair16(pk[0], pk[1]); }
        } else {
        const CSh cs(wr, wc, fr, fq); int kk = 0;
#pragma unroll
        for (int ai = 0; ai < 2; ++ai)
#pragma unroll
            for (int m = 0; m < 4; ++m) { const size_t off = (size_t)(u.pm * 256 + wr * 64 + cs.rrow + ai * 128 + m * 16) * D + u.pn * 256 + wc * 32 + 8 * cs.rpc;
#pragma unroll
                for (int bj = 0; bj < 2; ++bj) { f32x4 b0, b1; unpack8_u8(gb[ai][m][bj], b0, b1);
                    *(GAS u32x4*)(MG + off + bj * 128) = cs.xch(kk++, pack8(acc[ai][bj][m][0] * b0, acc[ai][bj][m][1] * b1)); } }
        }
    }
};
struct EpiWo {
    static constexpr bool PERM = true, MIDK = false;
    const float* x; const float* mod; bf16* XM;
    __device__ __forceinline__ void operator()(const f32x4 (&acc)[2][2][4][2], const pg8::Unit& u, int wr, int wc, int fr, int fq) const {
        const int row0 = u.pm * 256 + wr * 64 + fr, col0 = u.pn * 256 + wc * 32 + 8 * fq, b = u.pm >> 4;
        const CSh cs(wr, wc, fr, fq); int kk = 0;
        f32x4 g[2][2];
#pragma unroll
        for (int bj = 0; bj < 2; ++bj)
#pragma unroll
            for (int n = 0; n < 2; ++n) g[bj][n] = *(const GAS f32x4*)(mod + (size_t)b * 6 * D + 2 * D + col0 + bj * 128 + 4 * n);
#pragma unroll
        for (int ai = 0; ai < 2; ++ai) {
            f32x4 xv[4][2][2];
#pragma unroll
            for (int m = 0; m < 4; ++m)
#pragma unroll
                for (int bj = 0; bj < 2; ++bj)
#pragma unroll
                    for (int n = 0; n < 2; ++n) xv[m][bj][n] = __builtin_nontemporal_load((const GAS f32x4*)(x + (size_t)(row0 + ai * 128 + m * 16) * D + col0 + bj * 128 + 4 * n));
#pragma unroll
            for (int m = 0; m < 4; ++m) { const size_t off = (size_t)(u.pm * 256 + wr * 64 + cs.rrow + ai * 128 + m * 16) * D + u.pn * 256 + wc * 32 + 8 * cs.rpc;
#pragma unroll
                for (int bj = 0; bj < 2; ++bj) *(GAS u32x4*)(XM + off + bj * 128) = cs.xch(kk++, pack8(xv[m][bj][0] + g[bj][0] * acc[ai][bj][m][0], xv[m][bj][1] + g[bj][1] * acc[ai][bj][m][1])); }
            asm volatile("" ::: "memory");
        }
    }
};
struct EpiGateUp {
    static constexpr bool PERM = true, MIDK = false;
    unsigned char* H;
    __device__ __forceinline__ void operator()(const f32x4 (&acc)[2][2][4][2], const pg8::Unit& u, int wr, int wc, int fr, int fq) const {
        const int row0 = u.pm * 256 + wr * 64 + fr, col0 = u.pn * 128 + wc * 32 + 8 * (fq & ~1);
#pragma unroll
        for (int ai = 0; ai < 2; ++ai)
#pragma unroll
            for (int j = 0; j < 2; ++j) {
                if (u.v + ai * 128 + wr * 64 + 2 * j * 16 >= (u.e >> 6)) continue;
                u32x2 pc[2];
#pragma unroll
                for (int mm = 0; mm < 2; ++mm) { const int m = 2 * j + mm; f32x4 v0, v1;
#pragma unroll
                    for (int h = 0; h < 2; ++h) {
                        const f32x2 g0 = h ? hi2(acc[ai][0][m][0]) : lo2(acc[ai][0][m][0]), u0 = h ? hi2(acc[ai][1][m][0]) : lo2(acc[ai][1][m][0]);
                        const f32x2 g1 = h ? hi2(acc[ai][0][m][1]) : lo2(acc[ai][0][m][1]), u1 = h ? hi2(acc[ai][1][m][1]) : lo2(acc[ai][1][m][1]);
                        const f32x2 r0 = (g0 * u0) * rcp_2(exp2_2(g0) + 1.0f), r1 = (g1 * u1) * rcp_2(exp2_2(g1) + 1.0f);
                        v0[2 * h] = r0.x; v0[2 * h + 1] = r0.y; v1[2 * h] = r1.x; v1[2 * h + 1] = r1.y; }
                    pc[mm] = pack8_fp8(v0, v1); }
                *(GAS u32x4*)(H + (size_t)(row0 + ai * 128 + (2 * j + (fq & 1)) * 16) * DEXP + col0) = pair16(pc[0], pc[1]); }
    }
};
struct EpiDown {
    static constexpr bool PERM = true, MIDK = false;
    const unsigned* lrow; const float* lw; bf16* YT; const LAS unsigned* tab;
    __device__ __forceinline__ void operator()(const f32x4 (&acc)[2][2][4][2], const pg8::Unit& u, int wr, int wc, int fr, int fq) const {
        const int col0 = u.pn * 256 + wc * 32 + 8 * fq, lt0 = u.pn  ; (void)lt0;
        const int e = u.e & 63, cnt = u.e >> 6;
        const CSh cs(wr, wc, fr, fq); int kk = 0; (void)col0;
#pragma unroll
        for (int ai = 0; ai < 2; ++ai)
#pragma unroll
            for (int m = 0; m < 4; ++m) { const int rb = ai * 128 + wr * 64 + m * 16, r = rb + fr, rs = rb + cs.rrow, li = u.v + rs;
                if (u.v + rb >= cnt) continue;
                const float wq = u.ui < 7 ? __uint_as_float(tab[2 * (u.ui * 256 + r) + 1]) : lw[(size_t)e * LIST_CAP + (u.v + r < cnt ? u.v + r : 0)] * (1.0f / WD_SCALE);
                const unsigned ent = u.ui < 7 ? tab[2 * (u.ui * 256 + rs)] : lrow[(size_t)e * LIST_CAP + (li < cnt ? li : 0)];
                bf16* dst = YT + (size_t)ent * D + u.pn * 256 + wc * 32 + 8 * cs.rpc;
#pragma unroll
                for (int bj = 0; bj < 2; ++bj) { const u32x4 t = cs.xch(kk++, pack8(acc[ai][bj][m][0] * wq, acc[ai][bj][m][1] * wq));
                    if (li < cnt) *(GAS u32x4*)(dst + bj * 128) = t; } }
    }
};
struct MoeOrder {
    const LAS int* utab; int n;
    __device__ __forceinline__ bool next(int i, pg8::Unit& u) const { if (i >= n) return false;
        u.pm = __builtin_amdgcn_readfirstlane(utab[4 * i]); u.pn = __builtin_amdgcn_readfirstlane(utab[4 * i + 1]); u.v = __builtin_amdgcn_readfirstlane(utab[4 * i + 2]); u.e = __builtin_amdgcn_readfirstlane(utab[4 * i + 3]); u.ui = i; return true; }
};
__device__ __forceinline__ int moe_tables(Frame& F, bool rows) {
    LAS int* utab = (LAS int*)(F.lds + TAB_UNITS); LAS int* cnts = (LAS int*)(F.lds + TAB_CNT); LAS int* nun = cnts + 72;
    LAS unsigned* rowtab = (LAS unsigned*)(F.lds + TAB_ROWS);
    __syncthreads();
    if (rows || MK_N_LAUNCHES != 1) {
        if (F.tid < 64) {
            const int lane = F.tid, c = lane < 32 ? (int)__hip_atomic_load(F.ctl + CW_CNT + 64 * lane, RLX_AGENT) : 0, tiles = c >> 8, rem = c & 255;
            int x = tiles;
#pragma unroll
            for (int o = 1; o < 32; o <<= 1) { const int y = __shfl_up(x, o); if (lane >= o) x += y; }
            const int excl = x - tiles, Tf = __shfl(x, 31);
            int rank = 0;
            for (int o = 0; o < 32; ++o) { const int ro = __shfl(rem, o); rank += (ro > rem || (ro == rem && o < lane)) && ro > 0 ? 1 : 0; }
            const int Tp = __popcll(__ballot(lane < 32 && rem > 0)), total = (Tf + Tp) * 4;
            int n = 0;
            for (int i = 0; i < MAX_WG_UNITS; ++i) { const int L = i * F.G + F.vcu; if (L >= total) break;
                const int rt = L >> 2, pn = L & 3;
                const unsigned long long m = rt < Tf ? __ballot(lane < 32 && excl <= rt && rt < excl + tiles) : __ballot(lane < 32 && rem > 0 && rank == rt - Tf);
                const int e = m ? __builtin_ctzll(m) : 0, ce = __shfl(c, e), lt = rt < Tf ? rt - __shfl(excl, e) : __shfl(tiles, e);
                if (lane == 0) { utab[4 * i] = rt; utab[4 * i + 1] = pn; utab[4 * i + 2] = lt * 256; utab[4 * i + 3] = e | (ce << 6); }
                ++n; }
            if (lane == 0) nun[0] = n;
        }
        __syncthreads();
    }
    const int n = nun[0];
    if (rows) {
        const unsigned* lrow = (const unsigned*)(F.ws + WS_LROW);
        for (int q = F.tid; q < n * 256; q += 512) { const int i = q >> 8, r = q & 255, e = utab[4 * i + 3] & 63, cnt = utab[4 * i + 3] >> 6, li = utab[4 * i + 2] + r;
            const unsigned tok = li < cnt ? (lrow[(size_t)e * LIST_CAP + li] >> 1) : 0u; rowtab[q] = tok * (unsigned)D; }
    } else {
        const unsigned* lrow = (const unsigned*)(F.ws + WS_LROW); const float* lw = (const float*)(F.ws + WS_LW);
        for (int q = F.tid; q < n * 256 && q < 7 * 256; q += 512) { const int i = q >> 8, r = q & 255, e = utab[4 * i + 3] & 63, cnt = utab[4 * i + 3] >> 6, li = utab[4 * i + 2] + r, lc = li < cnt ? li : 0;
            rowtab[2 * q] = lrow[(size_t)e * LIST_CAP + lc]; rowtab[2 * q + 1] = __float_as_uint(lw[(size_t)e * LIST_CAP + lc] * (1.0f / WD_SCALE)); }
    }
    __syncthreads();
    return n;
}

constexpr int KCH = 4112;
constexpr int AT_K = 0, AT_V = 8 * KCH  , AT_POS = AT_V + 32768, AT_TAB = AT_POS + 1024  , AT_TABT = AT_TAB + 4 * 132 * 4  ,
              AT_OST = 72704  , AT_TABR = AT_OST + 8 * 4096  ,
              AT_END = AT_TABR + 4 * 4 * 208 * 4;
static_assert(AT_END <= RING_BYTES, "attention LDS");
static_assert(AT_TABT + 4 * 200 * 4 <= AT_OST, "attention LDS");
static_assert(AT_END <= RING_BYTES, "attention LDS");
__device__ __forceinline__ int crow(int r, int hi) { return (r & 3) + 8 * (r >> 2) + 4 * hi; }
__device__ __forceinline__ s16x4 vtr(const LAS unsigned char* p) { typedef short v4i16_t __attribute__((ext_vector_type(4))); return __builtin_bit_cast(s16x4, __builtin_amdgcn_ds_read_tr16_b64_v4i16((LAS v4i16_t*)p)); }
__device__ __forceinline__ bf16x8 mk8(const s16x4 lo, const s16x4 hi) { return (bf16x8){lo[0], lo[1], lo[2], lo[3], hi[0], hi[1], hi[2], hi[3]}; }

__device__ __forceinline__ void attn_unit(Frame& F, const Args& A, int b, int blk, int kvh) {
    int tid = F.tid; asm volatile("" : "+v"(tid));
    const int lane = tid & 63, wid = F.wave, r32 = lane & 31, hi = lane >> 5;
    LAS unsigned char* L = F.lds + RING_OFF;
    const bf16* Q = (const bf16*)(F.ws + WS_Q); const bf16* KV = (const bf16*)(F.ws + WS_KV); bf16* YAB = (bf16*)(F.ws + WS_YAB);
    const int r0 = b * SEQ + blk * 128, rp = blk > 0 ? r0 - 128 : r0;
    __syncthreads();
#pragma unroll
    for (int j = 0; j < 4; ++j) { const int p = tid + 512 * j, key = p >> 3, c = p & 7; const int grow = key < 128 ? rp + key : r0 + key - 128;
        const u32x4 kk = *(const GAS u32x4*)(KV + (size_t)grow * NKV + kvh * 64 + c * 8);
        const u32x4 vv = *(const GAS u32x4*)(KV + (size_t)grow * NKV + 128 + kvh * 64 + c * 8);
        *(LAS u32x4*)(L + AT_K + c * KCH + key * 16) = kk;
        *(LAS u32x4*)(L + AT_V + ((key >> 4) * 2 + (c >> 2)) * 1024 + (key & 15) * 64 + (c & 3) * 16) = vv; }
    if (tid < 256) { const int grow = tid < 128 ? rp + tid : r0 + tid - 128; ((LAS int*)(L + AT_POS))[tid] = ((const int*)A.in[I_POS])[grow]; }
    if (tid < 200) { int n = tid - 36; n = n < 0 ? 0 : (n > 128 ? 128 : n); int bucket;
        if (n < 16) bucket = n; else { const int lg = (int)(logf((float)n / 16.0f) / logf(8.0f) * 16.0f); bucket = 16 + lg; if (bucket > 31) bucket = 31; }
#pragma unroll
        for (int g = 0; g < 4; ++g) { const float v = A.in[I_RELB][bucket * 8 + kvh * 4 + g] * LOG2E; if (tid >= 36 && tid <= 164) ((LAS float*)(L + AT_TAB))[g * 132 + tid - 36] = v;
            const float vm = (tid >= 36 && tid < 164) ? v : -1e30f;
#pragma unroll
            for (int sft = 0; sft < 4; ++sft) if (199 - tid - sft >= 0) ((LAS float*)(L + AT_TABR))[(g * 4 + sft) * 208 + 199 - tid - sft] = vm; } }
    __syncthreads();
    const int toep = __syncthreads_and(tid >= 255 || (blk == 0 && tid < 128) || ((const LAS int*)(L + AT_POS))[tid + 1] - ((const LAS int*)(L + AT_POS))[tid] == 1);
    const int g = wid & 3, qh = wid >> 2, head = kvh * 4 + g;
    const float sink2 = A.in[I_SINKS][head] * LOG2E;
    const LAS float* tab = (const LAS float*)(L + AT_TAB) + g * 132;
    const LAS int* posl = (const LAS int*)(L + AT_POS);
#pragma unroll 1
    for (int s = 0; s < 2; ++s) {
        const int i0 = 64 * qh + 32 * s, T0 = i0 >> 5;
        bf16x8 qr[4];
#pragma unroll
        for (int ks = 0; ks < 4; ++ks) qr[ks] = *(const GAS bf16x8*)(Q + (size_t)(r0 + i0 + r32) * NQ + head * 64 + ks * 16 + hi * 8);
        const int pq = posl[128 + i0 + r32];
        f32x16 p[5];
        if (toep) {
            const int sft = (35 - r32) & 3, Y = ((35 - r32 - sft) >> 2) + hi;
            const LAS f32x4* tr = (const LAS f32x4*)(L + AT_TABR + (g * 4 + sft) * 208 * 4) + Y;
#pragma unroll
            for (int j = 0; j < 5; ++j) {
                const bool tile_dead = (blk == 0) && (T0 + j < 4);
                f32x4 c0 = tr[8 * j], c1 = tr[8 * j + 2], c2 = tr[8 * j + 4], c3 = tr[8 * j + 6];
                if (tile_dead) { c0 = (f32x4){-1e30f, -1e30f, -1e30f, -1e30f}; c1 = c0; c2 = c0; c3 = c0; }
                f32x16 a = __builtin_shufflevector(__builtin_shufflevector(c0, c1, 0, 1, 2, 3, 4, 5, 6, 7), __builtin_shufflevector(c2, c3, 0, 1, 2, 3, 4, 5, 6, 7), 0, 1, 2, 3, 4, 5, 6, 7, 8, 9, 10, 11, 12, 13, 14, 15);
#pragma unroll
                for (int ks = 0; ks < 4; ++ks) { const bf16x8 kf = *(const LAS bf16x8*)(L + AT_K + (2 * ks + hi) * KCH + (32 * (T0 + j) + r32) * 16);
                    a = __builtin_amdgcn_mfma_f32_32x32x16_bf16(kf, qr[ks], a, 0, 0, 0); }
                p[j] = a;
            }
        } else {
#pragma unroll
        for (int j = 0; j < 5; ++j) {
            f32x16 a = {};
#pragma unroll
            for (int ks = 0; ks < 4; ++ks) { const bf16x8 kf = *(const LAS bf16x8*)(L + AT_K + (2 * ks + hi) * KCH + (32 * (T0 + j) + r32) * 16);
                a = __builtin_amdgcn_mfma_f32_32x32x16_bf16(kf, qr[ks], a, 0, 0, 0); }
            p[j] = a;
        }
#pragma unroll
        for (int j = 0; j < 5; ++j) {
            const bool tile_dead = (blk == 0) && (T0 + j < 4);
#pragma unroll
            for (int rq = 0; rq < 4; ++rq) {
                const int k0 = 32 * (T0 + j) + 8 * rq + 4 * hi;
                typedef int i32x4 __attribute__((ext_vector_type(4))); const i32x4 pk = *(const LAS i32x4*)(posl + k0);
#pragma unroll
                for (int q = 0; q < 4; ++q) { const int r = 4 * rq + q, kl = 8 * rq + 4 * hi + q;
                    const int pkv = pk[q];
                    int n = pq - pkv; n = n < 0 ? 0 : (n > 128 ? 128 : n);
                    float sv = p[j][r] + tab[n];
                    bool ok = !tile_dead;
                    if (j == 0) ok = ok && (kl > r32);
                    if (j == 4) ok = ok && (kl <= r32);
                    p[j][r] = ok ? sv : -1e30f; }
            }
        }
        }
        float mx = sink2;
#pragma unroll
        for (int j = 0; j < 5; ++j)
#pragma unroll
            for (int r = 0; r < 16; ++r) mx = fmaxf(mx, p[j][r]);
        mx = fmaxf(mx, __shfl_xor(mx, 32));
        f32x2 l2 = {0.f, 0.f}; const f32x2 mx2 = {mx, mx};
#pragma unroll
        for (int j = 0; j < 5; ++j)
#pragma unroll
            for (int r = 0; r < 16; r += 2) { const f32x2 e = exp2_2((f32x2){p[j][r], p[j][r + 1]} - mx2); p[j][r] = e.x; p[j][r + 1] = e.y; l2 += e; }
        float l = l2.x + l2.y;
        l += __shfl_xor(l, 32);
        l += __builtin_amdgcn_exp2f(sink2 - mx);
        const float rl = __builtin_amdgcn_rcpf(l);
        f32x16 o[2]; o[0] = (f32x16){}; o[1] = (f32x16){};
        const int vlane = (4 * hi + ((lane & 15) >> 2)) * 64 + ((lane >> 4) & 1) * 32 + (lane & 3) * 8;
#pragma unroll
        for (int j = 0; j < 5; ++j)
#pragma unroll
            for (int s2 = 0; s2 < 2; ++s2) {
                u32x4 pw; pw.x = cvtpk(p[j][8 * s2 + 0], p[j][8 * s2 + 1]); pw.y = cvtpk(p[j][8 * s2 + 2], p[j][8 * s2 + 3]);
                pw.z = cvtpk(p[j][8 * s2 + 4], p[j][8 * s2 + 5]); pw.w = cvtpk(p[j][8 * s2 + 6], p[j][8 * s2 + 7]);
                const bf16x8 pa = __builtin_bit_cast(bf16x8, pw);
                const int kg = 2 * (T0 + j) + s2;
#pragma unroll
                for (int d0 = 0; d0 < 2; ++d0) { const LAS unsigned char* vp = L + AT_V + (kg * 2 + d0) * 1024 + vlane;
                    const bf16x8 vf = mk8(vtr(vp), vtr(vp + 512));
                    o[d0] = __builtin_amdgcn_mfma_f32_32x32x16_bf16(vf, pa, o[d0], 0, 0, 0); }
            }
        {
            LAS unsigned char* stg = L + AT_OST + wid * 4096; const f32x2 rl2 = {rl, rl};
#pragma unroll
            for (int d0 = 0; d0 < 2; ++d0)
#pragma unroll
                for (int rq = 0; rq < 4; ++rq) { const f32x2 a = (f32x2){o[d0][4 * rq], o[d0][4 * rq + 1]} * rl2, b2 = (f32x2){o[d0][4 * rq + 2], o[d0][4 * rq + 3]} * rl2;
                    u32x2 w; w.x = cvtpk(a.x, a.y); w.y = cvtpk(b2.x, b2.y);
                    *(LAS u32x2*)(stg + r32 * 128 + (((4 * d0 + rq) ^ (r32 & 7)) << 4) + hi * 8) = w; }
#pragma unroll
            for (int i = 0; i < 4; ++i) { const int pc = lane + 64 * i, row = pc >> 3, ch = pc & 7;
                const u32x4 v = *(const LAS u32x4*)(stg + row * 128 + ((ch ^ (row & 7)) << 4));
                if constexpr (P4_FP8) { f32x4 a, c; unpack8(v, a, c); *(GAS u32x2*)((unsigned char*)YAB + (size_t)(r0 + i0 + row) * D + head * 64 + ch * 8) = pack8_fp8(a * YAB_SCALE, c * YAB_SCALE); }
                else *(GAS u32x4*)(YAB + (size_t)(r0 + i0 + row) * D + head * 64 + ch * 8) = v; }
        }
    }
}

__device__ __forceinline__ void gmlp_unit(Frame& F, const Args& A, int b, int ch) {
    int tid = F.tid; asm volatile("" : "+v"(tid));
    const int lane = tid & 63, wid = F.wave, r32 = lane & 31, hi = lane >> 5;
    LAS unsigned char* L = F.lds + RING_OFF;
    const bf16* GU = (const bf16*)(F.ws + WS_GU); const bf16* GV = (const bf16*)(F.ws + WS_GV); bf16* YAB = (bf16*)(F.ws + WS_YAB);
    const bf16* WST = (const bf16*)(F.ws + WS_WST);
    const int r0 = b * SEQ + ch * 128;
    const int g = wid >> 1, chalf = wid & 1;
    bf16x8 wfl[20];
#pragma unroll
    for (int tt = 0; tt < 4; ++tt)
#pragma unroll
        for (int ks = 0; ks < 8; ++ks) if (ks <= 2 * tt + 1) wfl[tt * (tt + 1) + ks] = *(const GAS bf16x8*)(WST + ((size_t)g * 128 + 32 * tt + r32) * 128 + 16 * ks + 8 * hi);
    float bin[4]; u32x4 gun[4];
#pragma unroll
    for (int i = 0; i < 4; ++i) { const int pc = lane + 64 * i; bin[i] = A.in[I_GBS][g * 128 + (pc >> 3)]; gun[i] = *(const GAS u32x4*)(GU + (size_t)(r0 + (pc >> 3)) * GMW + g * 128 + 64 * chalf + 8 * (pc & 7)); }
    __syncthreads();
    {
        const float* lg = A.in[I_LNG]; const float* lb = A.in[I_LNB];
        const f32x4 g0 = *(const GAS f32x4*)(lg + 8 * lane), g1 = *(const GAS f32x4*)(lg + 8 * lane + 4), b0 = *(const GAS f32x4*)(lb + 8 * lane), b1 = *(const GAS f32x4*)(lb + 8 * lane + 4);
        const int grp = lane >> 4, cb = (lane & 15) >> 2;
        u32x4 gvr[16];
#pragma unroll
        for (int j = 0; j < 16; ++j) gvr[j] = *(const GAS u32x4*)(GV + (size_t)(r0 + 16 * wid + j) * GMW + 8 * lane);
#pragma unroll
        for (int j = 0; j < 16; ++j) {
            f32x4 v0, v1; unpack8(gvr[j], v0, v1);
            const float mu = wave_sum((v0[0] + v0[1]) + (v0[2] + v0[3]) + (v1[0] + v1[1]) + (v1[2] + v1[3])) * (1.0f / GMW);
            v0 = v0 - mu; v1 = v1 - mu;
            const float var = wave_sum((v0[0] * v0[0] + v0[1] * v0[1]) + (v0[2] * v0[2] + v0[3] * v0[3]) + (v1[0] * v1[0] + v1[1] * v1[1]) + (v1[2] * v1[2] + v1[3] * v1[3])) * (1.0f / GMW);
            const float rstd = __builtin_amdgcn_rsqf(var + EPS);
            *(LAS u32x4*)(L + grp * 32768 + (wid * 4 + cb) * 1024 + j * 64 + (lane & 3) * 16) = pack8(v0 * rstd * g0 + b0, v1 * rstd * g1 + b1); }
    }
    __syncthreads();
    const int vlane = (8 * hi + ((lane & 15) >> 2)) * 64 + ((lane >> 4) & 1) * 32 + (lane & 3) * 8;
    bf16x8 bfr[2][8];
#pragma unroll
    for (int ct = 0; ct < 2; ++ct)
#pragma unroll
        for (int ks = 0; ks < 8; ++ks) { const LAS unsigned char* vp = L + g * 32768 + (ks * 4 + 2 * chalf + ct) * 1024 + vlane; bfr[ct][ks] = mk8(vtr(vp), vtr(vp + 256)); }
    __syncthreads();
    LAS float* stg = (LAS float*)(L + wid * (32 * 68 * 4));
#pragma unroll
    for (int tt = 0; tt < 4; ++tt) {
        f32x16 acc[2]; acc[0] = (f32x16){}; acc[1] = (f32x16){};
#pragma unroll
        for (int ks = 0; ks < 8; ++ks) if (ks <= 2 * tt + 1) {
            acc[0] = __builtin_amdgcn_mfma_f32_32x32x16_bf16(wfl[tt * (tt + 1) + ks], bfr[0][ks], acc[0], 0, 0, 0);
            acc[1] = __builtin_amdgcn_mfma_f32_32x32x16_bf16(wfl[tt * (tt + 1) + ks], bfr[1][ks], acc[1], 0, 0, 0); }
#pragma unroll
        for (int ct = 0; ct < 2; ++ct)
#pragma unroll
            for (int r = 0; r < 16; ++r) stg[crow(r, hi) * 68 + 32 * ct + r32] = acc[ct][r];
        u32x4 gu[4]; float bi[4];
#pragma unroll
        for (int i = 0; i < 4; ++i) { gu[i] = gun[i]; bi[i] = bin[i]; }
        if (tt < 3) {
#pragma unroll
            for (int i = 0; i < 4; ++i) { const int pc = lane + 64 * i; bin[i] = A.in[I_GBS][g * 128 + 32 * (tt + 1) + (pc >> 3)];
                gun[i] = *(const GAS u32x4*)(GU + (size_t)(r0 + 32 * (tt + 1) + (pc >> 3)) * GMW + g * 128 + 64 * chalf + 8 * (pc & 7)); } }
#pragma unroll
        for (int i = 0; i < 4; ++i) { const int pc = lane + 64 * i, row = pc >> 3, chn = pc & 7, t = 32 * tt + row, c = g * 128 + 64 * chalf + 8 * chn;
            const f32x4 s0 = *(const LAS f32x4*)(stg + row * 68 + 8 * chn), s1 = *(const LAS f32x4*)(stg + row * 68 + 8 * chn + 4);
            const float bb = bi[i]; f32x4 u0, u1; unpack8(gu[i], u0, u1);
            if constexpr (P4_FP8) *(GAS u32x2*)((unsigned char*)YAB + (size_t)(r0 + t) * D + NQ + c) = pack8_fp8(u0 * (s0 + bb) * YAB_SCALE, u1 * (s1 + bb) * YAB_SCALE);
            else *(GAS u32x4*)(YAB + (size_t)(r0 + t) * D + NQ + c) = pack8(u0 * (s0 + bb), u1 * (s1 + bb)); }
    }
}

__device__ __forceinline__ void router_images(Frame& F, const Args& A) {
    const float* mod = (const float*)(F.ws + WS_MOD); bf16* GT = (bf16*)(F.ws + WS_GT); float* GC = (float*)(F.ws + WS_GC);
    LAS float* red = (LAS float*)(F.lds + RING_OFF);
    for (int it = F.vcu; it < 8 * 48; it += F.G) { const int b = it / 48, n = it % 48; float part = 0.f;
#pragma unroll
        for (int cc = 0; cc < 2; ++cc) { const int c = F.tid + 512 * cc;
            const float sh = mod[(size_t)b * 6 * D + 3 * D + c], sc = mod[(size_t)b * 6 * D + 4 * D + c], a2 = A.in[I_N2G][c] * (1.0f + sc);
            const float w = n < 4 ? A.in[I_WRG][(size_t)c * 4 + n] : (n < 36 ? A.in[I_WRE][(size_t)c * 32 + (n - 4)] : 0.f);
            GT[((size_t)b * 48 + n) * D + c] = (bf16)(cvtpk(a2 * w, 0.f) & 0xffffu); part += sh * w; }
        part = wave_sum(part);
        __syncthreads(); if (F.lane == 0) red[F.wave] = part; __syncthreads();
        if (F.tid == 0) { float s = n < 4 ? A.in[I_BRG][n] : (n < 36 ? A.in[I_BRE][n - 4] : 0.f);
#pragma unroll
            for (int w = 0; w < 8; ++w) s += red[w];
            GC[b * 48 + n] = s; }
    }
}

constexpr int GT_STRIDE = 2064;
constexpr int R6_GT = 0, R6_A2 = 48 * GT_STRIDE  , R6_B2 = R6_A2 + 4096, R6_CONST = R6_B2 + 4096, R6_LCNT = R6_CONST + 256, R6_LBASE = R6_LCNT + 128, R6_RED = R6_LBASE + 128, R6_LOG = R6_RED + 8 * 40 * 4, R6_END = R6_LOG + 8 * 16 * 40 * 4;
static_assert(R6_END <= RING_BYTES, "router LDS");
__device__ __forceinline__ void p6_router(Frame& F, const Args& A) {
    const int wid = F.wave;
    LAS unsigned char* L = F.lds + RING_OFF;
    const float* mod = (const float*)(F.ws + WS_MOD);
    const bf16* XM = (const bf16*)(F.ws + WS_XMID); unsigned char* H2 = (unsigned char*)(F.ws + WS_H2);
    unsigned* lrow = (unsigned*)(F.ws + WS_LROW); float* lw = (float*)(F.ws + WS_LW);
    LAS float* A2 = (LAS float*)(L + R6_A2); LAS float* B2 = (LAS float*)(L + R6_B2); LAS float* cst = (LAS float*)(L + R6_CONST);
    LAS int* lcnt = (LAS int*)(L + R6_LCNT); LAS int* lbase = (LAS int*)(L + R6_LBASE); LAS float* red = (LAS float*)(L + R6_RED);
    LAS float* lg = (LAS float*)(L + R6_LOG) + wid * 16 * 40;
    for (int rb = F.vcu; rb < M / 128; rb += F.G) {
        const int b = rb / (SEQ / 128);
        int tid = F.tid; asm volatile("" : "+v"(tid)); const int lane = tid & 63;
        const int rloc = lane & 15, kq = lane >> 4, row = rb * 128 + wid * 16 + rloc;
        u32x4 xk[32];
#pragma unroll
        for (int ks = 0; ks < 32; ++ks) xk[ks] = *(const GAS u32x4*)(XM + (size_t)row * D + 32 * ks + 8 * kq);
        asm volatile("" ::: "memory");
        __syncthreads();
        {
            const bf16* GTb = (const bf16*)(F.ws + WS_GT) + (size_t)b * 48 * D;
            u32x4 gt[12];
#pragma unroll
            for (int i = 0; i < 12; ++i) gt[i] = *(const GAS u32x4*)(GTb + (size_t)(tid + 512 * i) * 8);
#pragma unroll
            for (int cc = 0; cc < 2; ++cc) { const int c = tid + 512 * cc; A2[c] = A.in[I_N2G][c] * (1.0f + mod[(size_t)b * 6 * D + 4 * D + c]); B2[c] = mod[(size_t)b * 6 * D + 3 * D + c]; }
            if (tid < 48) cst[tid] = ((const float*)(F.ws + WS_GC))[b * 48 + tid];
            if (tid < 32) lcnt[tid] = 0;
#pragma unroll
            for (int i = 0; i < 12; ++i) { const int pc = tid + 512 * i, n = pc >> 7, ch = pc & 127; *(LAS u32x4*)(L + R6_GT + n * GT_STRIDE + ch * 16) = gt[i]; }
        }
        __syncthreads();
        float ss = 0.f;
#pragma unroll
        for (int ks = 0; ks < 32; ++ks) { f32x4 a, c; unpack8(xk[ks], a, c); ss += (a[0] * a[0] + a[1] * a[1]) + (a[2] * a[2] + a[3] * a[3]) + (c[0] * c[0] + c[1] * c[1]) + (c[2] * c[2] + c[3] * c[3]); }
        ss += __shfl_xor(ss, 16); ss += __shfl_xor(ss, 32);
        const float rinv = 1.0f / sqrtf(ss * (1.0f / D) + EPS);
        f32x4 acc[3]; acc[0] = (f32x4){0.f, 0.f, 0.f, 0.f}; acc[1] = acc[0]; acc[2] = acc[0];
#pragma unroll
        for (int ks = 0; ks < 32; ++ks) { const bf16x8 af = __builtin_bit_cast(bf16x8, xk[ks]);
#pragma unroll
            for (int nt = 0; nt < 3; ++nt) { const bf16x8 bfg = *(const LAS bf16x8*)(L + R6_GT + (16 * nt + rloc) * GT_STRIDE + (32 * ks + 8 * kq) * 2);
                acc[nt] = __builtin_amdgcn_mfma_f32_16x16x32_bf16(af, bfg, acc[nt], 0, 0, 0); }
            if ((ks & 3) == 3) asm volatile("" ::: "memory"); }
#pragma unroll
        for (int nt = 0; nt < 3; ++nt) { const int n = 16 * nt + rloc; if (n < 36) {
#pragma unroll
            for (int q = 0; q < 4; ++q) lg[(4 * kq + q) * 40 + n] = acc[nt][q]; } }
        LDS_WAIT(); asm volatile("" ::: "memory");
        int e1 = 0, e2 = 0, lp1 = 0, lp2 = 0; float w1 = 0.f, w2 = 0.f;
        if (lane < 16) {
            const LAS float* lr = lg + lane * 40;
            float l0[4]; int gi = 0;
#pragma unroll
            for (int n = 0; n < 4; ++n) l0[n] = lr[n] * rinv + cst[n];
            float gm = l0[0];
#pragma unroll
            for (int n = 1; n < 4; ++n) if (l0[n] > gm) { gm = l0[n]; gi = n; }
            float gs = 0.f;
#pragma unroll
            for (int n = 0; n < 4; ++n) gs += __expf(l0[n] - gm);
            const float pg = 1.0f / gs;
            float le[8];
#pragma unroll
            for (int j = 0; j < 8; ++j) le[j] = lr[4 + 8 * gi + j] * rinv + cst[4 + 8 * gi + j];
            int i1 = 0; float m1 = le[0];
#pragma unroll
            for (int j = 1; j < 8; ++j) if (le[j] > m1) { m1 = le[j]; i1 = j; }
            int i2 = -1; float m2 = -INFINITY;
#pragma unroll
            for (int j = 0; j < 8; ++j) if (j != i1 && le[j] > m2) { m2 = le[j]; i2 = j; }
            const float ex = __expf(m2 - m1); const float t1 = 1.0f / (1.0f + ex);
            w1 = pg * t1; w2 = pg * (ex * t1);
            if (i2 < 0) i2 = (i1 + 1) & 7;
            e1 = gi * 8 + i1; e2 = gi * 8 + i2;
            lp1 = atomicAdd((int*)&lcnt[e1], 1); lp2 = atomicAdd((int*)&lcnt[e2], 1);
        }
        __syncthreads();
        int basev = 0; if (tid < 32) { const int c = lcnt[tid]; if (c > 0) basev = (int)__hip_atomic_fetch_add(F.ctl + CW_CNT + 64 * tid, (unsigned)c, RLX_AGENT); }
#pragma unroll
        for (int ks = 0; ks < 32; ++ks) asm volatile("" : "+v"(xk[ks]));
#pragma unroll
        for (int ks = 0; ks < 32; ks += 2) { u32x2 pc[2];
#pragma unroll
            for (int h = 0; h < 2; ++h) { const int c0 = 32 * (ks + h) + 8 * kq; f32x4 a, c; unpack8(xk[ks + h], a, c);
                const f32x4 a0 = *(const LAS f32x4*)(A2 + c0), a1 = *(const LAS f32x4*)(A2 + c0 + 4), b0 = *(const LAS f32x4*)(B2 + c0), b1 = *(const LAS f32x4*)(B2 + c0 + 4);
                pc[h] = pack8_fp8(a * rinv * a0 + b0, c * rinv * a1 + b1); }
            *(GAS u32x4*)(H2 + (size_t)row * D + 32 * (ks + (kq & 1)) + 8 * (kq & ~1)) = pair16(pc[0], pc[1]);
            if ((ks & 3) == 2) asm volatile("" ::: "memory"); }
        if (tid < 32) lbase[tid] = basev;
        __syncthreads();
        if (lane < 16) {
            const int p1 = lbase[e1] + lp1, p2 = lbase[e2] + lp2;
            lrow[(size_t)e1 * LIST_CAP + p1] = (unsigned)row * 2u; lw[(size_t)e1 * LIST_CAP + p1] = w1;
            lrow[(size_t)e2 * LIST_CAP + p2] = (unsigned)row * 2u + 1u; lw[(size_t)e2 * LIST_CAP + p2] = w2;
#if DEBUG_CHECKS
            { float* rec = (float*)(F.ws + 490 * MiB) + (size_t)row * 4; rec[0] = (float)e1; rec[1] = (float)e2; rec[2] = w1; rec[3] = w2; }
#endif
        }
    }
}

__device__ __forceinline__ void p9_final(Frame& F, const Args& A) {
    const int lane = F.lane, wid = F.wave;
    const float* mod = (const float*)(F.ws + WS_MOD); const bf16* XM = (const bf16*)(F.ws + WS_XMID); const bf16* YT = (const bf16*)(F.ws + WS_YT);
    for (int rb = F.vcu; rb < M / 128; rb += F.G) {
        const int b = rb / (SEQ / 128);
        f32x4 g2[2][2], fg[2][2];
#pragma unroll
        for (int jj = 0; jj < 2; ++jj)
#pragma unroll
            for (int q = 0; q < 2; ++q) { const int c = 512 * jj + 8 * lane + 4 * q; g2[jj][q] = *(const GAS f32x4*)(mod + (size_t)b * 6 * D + 5 * D + c); fg[jj][q] = *(const GAS f32x4*)(A.in[I_FG] + c); }
#pragma unroll 1
        for (int j0 = 0; j0 < 16; j0 += 4) {
            u32x4 xm[4][2], y0[4][2], y1[4][2];
#pragma unroll
            for (int jr = 0; jr < 4; ++jr) { const int row = rb * 128 + wid * 16 + j0 + jr;
#pragma unroll
                for (int jj = 0; jj < 2; ++jj) { const int c = 512 * jj + 8 * lane;
                    xm[jr][jj] = __builtin_nontemporal_load((const GAS u32x4*)(XM + (size_t)row * D + c));
                    y0[jr][jj] = __builtin_nontemporal_load((const GAS u32x4*)(YT + (size_t)row * 2 * D + c));
                    y1[jr][jj] = __builtin_nontemporal_load((const GAS u32x4*)(YT + (size_t)row * 2 * D + D + c)); } }
#pragma unroll
            for (int jr = 0; jr < 4; ++jr) { const int row = rb * 128 + wid * 16 + j0 + jr;
                f32x4 v[2][2]; float ss = 0.f;
#pragma unroll
                for (int jj = 0; jj < 2; ++jj) { f32x4 x0, x1, a0, a1, z0, z1;
                    unpack8(xm[jr][jj], x0, x1); unpack8(y0[jr][jj], a0, a1); unpack8(y1[jr][jj], z0, z1);
                    v[jj][0] = x0 + g2[jj][0] * (a0 + z0); v[jj][1] = x1 + g2[jj][1] * (a1 + z1);
#pragma unroll
                    for (int q = 0; q < 2; ++q) ss += (v[jj][q][0] * v[jj][q][0] + v[jj][q][1] * v[jj][q][1]) + (v[jj][q][2] * v[jj][q][2] + v[jj][q][3] * v[jj][q][3]); }
                const float rinv = 1.0f / sqrtf(wave_sum(ss) * (1.0f / D) + EPS);
#pragma unroll
                for (int jj = 0; jj < 2; ++jj)
#pragma unroll
                    for (int q = 0; q < 2; ++q) __builtin_nontemporal_store(v[jj][q] * rinv * fg[jj][q], (GAS f32x4*)(A.out + (size_t)row * D + 512 * jj + 8 * lane + 4 * q)); }
        }
    }
}

__global__ void __launch_bounds__(NWAVES * 64, 2) mk_fwd(Args args) {
    extern __shared__ __attribute__((aligned(16))) unsigned char lds[];
    Frame F;
    F.lds = (LAS unsigned char*)lds;
    F.MISC = (volatile LAS unsigned*)(F.lds + MISC_OFF);
    F.tid = threadIdx.x; F.lane = F.tid & 63; F.wave = __builtin_amdgcn_readfirstlane(F.tid >> 6);
    F.G = gridDim.x; { const int bx = blockIdx.x; F.vcu = (F.G % 8 == 0) ? (bx % 8) * (F.G / 8) + bx / 8 : bx; }
    F.ws = args.ws; F.ctl = (gu32*)(args.ws + WS_CTL);
    for (int u = F.tid; u < (TAB_OFF - LDSCTL_OFF) / 4; u += NWAVES * 64) ((LAS unsigned*)(F.lds + LDSCTL_OFF))[u] = 0u;
    __syncthreads();
    XcdBarrier bar; bar.bar = (unsigned*)(F.ctl + CW_BAR); bar.x = 0; bar.st = nullptr;
    if (MK_N_LAUNCHES == 1) bar = xcd_barrier_post((unsigned*)(F.ctl + CW_BAR), F.MISC + 8);
#define GRID_BAR() do { if (MK_N_LAUNCHES == 1) xcd_barrier(bar); } while (0)
    const int lo = args.ph_lo, hi = args.ph_hi;
#ifdef ONLY_PHASE
#define IN(k) ((k) == ONLY_PHASE && lo <= (k) && (k) < hi)
#else
#define IN(k) (lo <= (k) && (k) < hi)
#endif
#define BOTH(k) (IN(k) && IN((k) + 1))

    if (IN(0)) { p0_prologue(F, args); if (BOTH(0)) GRID_BAR(); }
    if (IN(1)) { p1_h1(F, args); if (BOTH(1)) GRID_BAR(); }
    if (IN(2)) {
        const bool fp8_first = (blockIdx.x & 1) != 0;
        constexpr int NG8 = GUGV_FP8 ? 1024 : 0;
#define P2_BF16() do { ProbDense P{D * 2, D * 2u, D * 2u, (const char*)(F.ws + WS_A), (const char*)(F.ws + WS_WIN), nullptr}; \
            pg8::DenseOrder S; S.init(M, NBF, F.G, (int)blockIdx.x); EpiInProjT<false> E{F.ws, 0, 1.0f}; \
            pg8::gemm_phase<ProbDense, EpiInProjT<false>, pg8::DenseOrder, true>(F.lds + RING_OFF, P, S, E); } while (0)
#define P2_GELU8() do { if constexpr (GUGV_FP8) { ProbDense8 P{D, (unsigned)D, (unsigned)D, (const char*)(F.ws + WS_H1F8), (const char*)(F.ws + WS_WIN8), nullptr}; \
            pg8::DenseOrder S; S.init(M, NG8, F.G, (int)blockIdx.x); EpiGelu8 E{F.ws}; \
            pg8::gemm_phase<ProbDense8, EpiGelu8, pg8::DenseOrder, true>(F.lds + RING_OFF, P, S, E); } } while (0)
#define P2_GATES8() do { ProbDense8 P{D, (unsigned)D, (unsigned)D, (const char*)(F.ws + WS_H1F8), (const char*)(F.ws + WS_WIN8) + (size_t)NG8 * D, nullptr}; \
            pg8::BackfillOrder S; S.init(M, INW - NBF - NG8, F.G, (int)blockIdx.x); EpiInProjT<true> E{F.ws, 7, 1.0f}; \
            pg8::gemm_phase<ProbDense8, EpiInProjT<true>, pg8::BackfillOrder, true>(F.lds + RING_OFF, P, S, E); } while (0)
        if (fp8_first) { P2_GATES8(); P2_GELU8(); P2_BF16(); } else { P2_BF16(); P2_GELU8(); P2_GATES8(); }
#undef P2_BF16
#undef P2_GELU8
#undef P2_GATES8
        if (BOTH(2)) GRID_BAR();
    }
    if (IN(3)) {
        router_images(F, args);
        for (int ub = F.vcu; ub < M / 128; ub += F.G) { const int b = ub / (SEQ / 128), blk = ub % (SEQ / 128);

#ifndef NO_ATTN
#pragma unroll 1
            for (int kvh = 0; kvh < 2; ++kvh) attn_unit(F, args, b, blk, kvh);
            asm volatile("" ::: "memory");
#endif
#ifndef NO_GMLP
            gmlp_unit(F, args, b, blk);
#endif
        }
        __syncthreads();
        if (BOTH(3)) GRID_BAR();
    }
    if (IN(4)) {
        pg8::DenseOrder S; S.init(M, D, F.G, (int)blockIdx.x);
        EpiMerge E{(const unsigned char*)(F.ws + WS_GA), (const unsigned char*)(F.ws + WS_GB), (bf16*)(F.ws + WS_A)};
        if constexpr (P4_FP8) { ProbDense8m P{D, (unsigned)D, (unsigned)D, (const char*)(F.ws + WS_YAB), (const char*)(F.ws + WS_PA), nullptr};
            pg8::gemm_phase<ProbDense8m, EpiMerge, pg8::DenseOrder, true>(F.lds + RING_OFF, P, S, E); }
        else { ProbDense P{D * 2, D * 2u, D * 2u, (const char*)(F.ws + WS_YAB), (const char*)(F.ws + WS_PA), nullptr};
            pg8::gemm_phase<ProbDense, EpiMerge, pg8::DenseOrder, true>(F.lds + RING_OFF, P, S, E); }
        if (BOTH(4)) GRID_BAR();
    }
    if (IN(5)) {
        pg8::DenseOrder S; S.init(M, D, F.G, (int)blockIdx.x);
        EpiWo E{args.in[I_X], (const float*)(F.ws + WS_MOD), (bf16*)(F.ws + WS_XMID)};
        if constexpr (WO_FP8) { ProbDense8w P{D, (unsigned)D, (unsigned)D, (const char*)(F.ws + WS_A), (const char*)(F.ws + WS_WO), nullptr};
            pg8::gemm_phase<ProbDense8w, EpiWo, pg8::DenseOrder, true>(F.lds + RING_OFF, P, S, E); }
        else { ProbDense P{D * 2, D * 2u, D * 2u, (const char*)(F.ws + WS_A), (const char*)(F.ws + WS_WO), nullptr};
            pg8::gemm_phase<ProbDense, EpiWo, pg8::DenseOrder, true>(F.lds + RING_OFF, P, S, E); }
        if (BOTH(5)) GRID_BAR();
    }
    if (IN(6)) { p6_router(F, args); __syncthreads(); if (BOTH(6)) GRID_BAR(); }
    if (IN(7)) {
        const int n = moe_tables(F, true);
        ProbGateUp P{D, (unsigned)D, (unsigned)D, (const char*)(F.ws + WS_H2), (const char*)(F.ws + WS_WGU), (const LAS unsigned*)(F.lds + TAB_ROWS)};
        MoeOrder S{(const LAS int*)(F.lds + TAB_UNITS), n};
        EpiGateUp E{(unsigned char*)(F.ws + WS_HACT)};
        pg8::gemm_phase<ProbGateUp, EpiGateUp, MoeOrder, true>(F.lds + RING_OFF, P, S, E);
        if (BOTH(7)) GRID_BAR();
    }
    if (IN(8)) {
        const int n = moe_tables(F, false);
        ProbDown P{DEXP, (unsigned)DEXP, (unsigned)DEXP, (const char*)(F.ws + WS_HACT), (const char*)(F.ws + WS_WD), nullptr};
        MoeOrder S{(const LAS int*)(F.lds + TAB_UNITS), n};
        EpiDown E{(const unsigned*)(F.ws + WS_LROW), (const float*)(F.ws + WS_LW), (bf16*)(F.ws + WS_YT), (const LAS unsigned*)(F.lds + TAB_ROWS)};
        pg8::gemm_phase<ProbDown, EpiDown, MoeOrder, true>(F.lds + RING_OFF, P, S, E);
        if (BOTH(8)) GRID_BAR();
    }
    if (IN(9)) { p9_final(F, args); }
#undef IN
#undef BOTH
}


#if DEBUG_CHECKS
constexpr size_t WS_DBG = 490 * MiB;
constexpr int CW_DBG = 200000;
constexpr int NSAMP = 512;
__device__ __forceinline__ int samp_row(int i) { return 64 * i + ((i * 7) & 63); }
__device__ __forceinline__ float bfr(float v) { return bf_lo(cvtpk(v, 0.f) & 0xffffu); }
__device__ __forceinline__ float ldbf(const bf16* p) { return __uint_as_float((unsigned)(*p) << 16); }
__device__ __forceinline__ float f8dec(unsigned char b) { return __builtin_amdgcn_cvt_f32_fp8((int)b, 0); }
__device__ __forceinline__ float f8r(float v) { return f8dec((unsigned char)(pk4_fp8(v, 0.f, 0.f, 0.f) & 0xffu)); }
__device__ __forceinline__ void dbg_acc(unsigned char* ws, int k, float err, float ref) { float* a = (float*)(ws + WS_CTL) + CW_DBG; atomicAdd(a + 2 * k, err * err); atomicAdd(a + 2 * k + 1, ref * ref); }
__device__ __forceinline__ float block_sum256(float v, float* sh) {
    v = wave_sum(v); __syncthreads(); if ((threadIdx.x & 63) == 0) sh[threadIdx.x >> 6] = v; __syncthreads(); const float r = sh[0] + sh[1] + sh[2] + sh[3]; __syncthreads(); return r; }
__global__ void __launch_bounds__(256) chk_h1(Args a) {
    __shared__ float sh[8];
    const int row = samp_row(blockIdx.x), b = row / SEQ, t = threadIdx.x;
    float sc[4], shf[4];
#pragma unroll
    for (int q = 0; q < 4; ++q) { sc[q] = a.in[I_BADA][D + t + 256 * q]; shf[q] = a.in[I_BADA][t + 256 * q]; }
    for (int k = 0; k < D; ++k) { const float cv = a.in[I_C][b * D + k]; const float cs = cv / (1.0f + expf(-cv));
#pragma unroll
        for (int q = 0; q < 4; ++q) { sc[q] += cs * a.in[I_WADA][(size_t)k * 6 * D + D + t + 256 * q]; shf[q] += cs * a.in[I_WADA][(size_t)k * 6 * D + t + 256 * q]; } }
    float ss = 0.f; float xv[4];
#pragma unroll
    for (int q = 0; q < 4; ++q) { xv[q] = a.in[I_X][(size_t)row * D + t + 256 * q]; ss += xv[q] * xv[q]; }
    const float rinv = 1.0f / sqrtf(block_sum256(ss, sh) / D + EPS);
    const bf16* h1 = (const bf16*)(a.ws + WS_A);
#pragma unroll
    for (int q = 0; q < 4; ++q) { const int c = t + 256 * q; const float ref = xv[q] * rinv * a.in[I_N1G][c] * (1.0f + sc[q]) + shf[q]; dbg_acc(a.ws, 0, ldbf(h1 + (size_t)row * D + c) - ref, ref); }
}
__global__ void __launch_bounds__(256) chk_inproj(Args a) {
    const int idx = blockIdx.x * 256 + threadIdx.x; if (idx >= NSAMP * INW) return;
    const int row = samp_row(idx / INW), n = idx % INW;
    const bf16* h1 = (const bf16*)(a.ws + WS_A); float s = 0.f;
    if (n < NBF) { for (int k = 0; k < D; ++k) s += ldbf(h1 + (size_t)row * D + k) * bfr(a.in[I_WIN][(size_t)k * INW + n]); }
    else { for (int k = 0; k < D; ++k) s += f8dec(((const unsigned char*)(a.ws + WS_H1F8))[(size_t)row * D + k]) * f8r(a.in[I_WIN][(size_t)k * INW + n] * WGU_SCALE); s *= 1.0f / WGU_SCALE; }
    float ref, got;
    if (n < 512) { ref = s * QSCALE; got = ldbf((const bf16*)(a.ws + WS_Q) + (size_t)row * NQ + n); }
    else if (n < 768) { ref = s; got = ldbf((const bf16*)(a.ws + WS_KV) + (size_t)row * NKV + n - 512); }
    else if (n < 1280) { ref = 0.5f * s * (1.0f + tanhf(0.7978845608f * (s + 0.044715f * s * s * s))); got = ldbf((const bf16*)(a.ws + WS_GU) + (size_t)row * GMW + n - 768); }
    else if (n < 1792) { ref = 0.5f * s * (1.0f + tanhf(0.7978845608f * (s + 0.044715f * s * s * s))); got = ldbf((const bf16*)(a.ws + WS_GV) + (size_t)row * GMW + n - 1280); }
    else if (n < 2816) { ref = 1.0f / (1.0f + expf(-s)); got = (float)((const unsigned char*)(a.ws + WS_GA))[(size_t)row * D + n - 1792] * (1.0f / 255.0f); }
    else { ref = fmaxf(1.0f / (1.0f + expf(-s)), 1.0f / 255.0f); got = (float)((const unsigned char*)(a.ws + WS_GB))[(size_t)row * D + n - 2816] * (1.0f / 255.0f); }
    dbg_acc(a.ws, 1, got - ref, ref);
}
__global__ void __launch_bounds__(256) chk_attn(Args a) {
    const int idx = blockIdx.x * 256 + threadIdx.x; if (idx >= NSAMP * 8 * 4) return;
    const int row = samp_row(idx / 32), head = (idx >> 2) & 7, dq = idx & 3, b = row / SEQ, tpos = row % SEQ, blk = tpos / 128, kvh = head >> 2;
    const bf16* Q = (const bf16*)(a.ws + WS_Q); const bf16* KV = (const bf16*)(a.ws + WS_KV); const int* pos = (const int*)a.in[I_POS];
    const int band0 = b * SEQ + blk * 128 - 128;
    const int i = tpos % 128;
    float m = a.in[I_SINKS][head], l = 0.f; float o[16];
#pragma unroll
    for (int d = 0; d < 16; ++d) o[d] = 0.f;
    for (int kj = i + 1; kj <= i + 128; ++kj) { if (blk == 0 && kj < 128) continue; const int kr = band0 + kj;
        float s = 0.f; for (int d = 0; d < 64; ++d) s += ldbf(Q + (size_t)row * NQ + head * 64 + d) * ldbf(KV + (size_t)kr * NKV + kvh * 64 + d);
        s *= (1.0f / LOG2E);
        int n = pos[row] - pos[kr]; if (n < 0) n = 0; int bucket; if (n < 16) bucket = n; else { bucket = 16 + (int)(logf((float)n / 16.0f) / logf(8.0f) * 16.0f); if (bucket > 31) bucket = 31; }
        s += a.in[I_RELB][bucket * 8 + head]; m = fmaxf(m, s); }
    for (int kj = i + 1; kj <= i + 128; ++kj) { if (blk == 0 && kj < 128) continue; const int kr = band0 + kj;
        float s = 0.f; for (int d = 0; d < 64; ++d) s += ldbf(Q + (size_t)row * NQ + head * 64 + d) * ldbf(KV + (size_t)kr * NKV + kvh * 64 + d);
        s *= (1.0f / LOG2E);
        int n = pos[row] - pos[kr]; if (n < 0) n = 0; int bucket; if (n < 16) bucket = n; else { bucket = 16 + (int)(logf((float)n / 16.0f) / logf(8.0f) * 16.0f); if (bucket > 31) bucket = 31; }
        s += a.in[I_RELB][bucket * 8 + head]; const float p = expf(s - m); l += p;
#pragma unroll
        for (int d = 0; d < 16; ++d) o[d] += p * ldbf(KV + (size_t)kr * NKV + 128 + kvh * 64 + dq * 16 + d); }
    l += expf(a.in[I_SINKS][head] - m);
    const bf16* yab = (const bf16*)(a.ws + WS_YAB);
#pragma unroll
    for (int d = 0; d < 16; ++d) { const float ref = o[d] / l; dbg_acc(a.ws, 2, ldbf(yab + (size_t)row * D + head * 64 + dq * 16 + d) - ref, ref); }
}
__global__ void __launch_bounds__(512) chk_gmlp(Args a) {
    __shared__ float sh[16];
    const int row = samp_row(blockIdx.x), c = threadIdx.x, g = c >> 7, r0 = row & ~127, t = row & 127;
    const bf16* GU = (const bf16*)(a.ws + WS_GU); const bf16* GV = (const bf16*)(a.ws + WS_GV);
    float acc = 0.f;
    for (int s = 0; s <= t; ++s) { const float v = ldbf(GV + (size_t)(r0 + s) * GMW + c);
        float x = wave_sum(v); __syncthreads(); if ((c & 63) == 0) sh[c >> 6] = x; __syncthreads(); float tot = 0.f; for (int w = 0; w < 8; ++w) tot += sh[w]; const float mu = tot / GMW;
        x = wave_sum((v - mu) * (v - mu)); __syncthreads(); if ((c & 63) == 0) sh[c >> 6] = x; __syncthreads(); tot = 0.f; for (int w = 0; w < 8; ++w) tot += sh[w]; const float rstd = 1.0f / sqrtf(tot / GMW + EPS);
        const float vn = bfr((v - mu) * rstd * a.in[I_LNG][c] + a.in[I_LNB][c]);
        acc += bfr(a.in[I_GWS][((size_t)g * 128 + t) * 128 + s]) * vn; }
    const float ref = ldbf(GU + (size_t)row * GMW + c) * (acc + a.in[I_GBS][g * 128 + t]);
    dbg_acc(a.ws, 3, ldbf((const bf16*)(a.ws + WS_YAB) + (size_t)row * D + NQ + c) - ref, ref);
}
__global__ void __launch_bounds__(256) chk_merge(Args a) {
    const int idx = blockIdx.x * 256 + threadIdx.x; if (idx >= NSAMP * D) return;
    const int row = samp_row(idx / D), n = idx % D; const bf16* yab = (const bf16*)(a.ws + WS_YAB);
    float sa = 0.f, sb = 0.f;
    for (int k = 0; k < 512; ++k) { sa += ldbf(yab + (size_t)row * D + k) * bfr(a.in[I_PA][(size_t)k * D + n]); sb += ldbf(yab + (size_t)row * D + 512 + k) * bfr(a.in[I_PB][(size_t)k * D + n]); }
    const float ref = (float)((const unsigned char*)(a.ws + WS_GA))[(size_t)row * D + n] * (1.0f / 255.0f) * sa + (float)((const unsigned char*)(a.ws + WS_GB))[(size_t)row * D + n] * (1.0f / 255.0f) * sb;
    dbg_acc(a.ws, 4, ldbf((const bf16*)(a.ws + WS_A) + (size_t)row * D + n) - ref, ref);
}
__global__ void __launch_bounds__(256) chk_wo(Args a) {
    const int idx = blockIdx.x * 256 + threadIdx.x; if (idx >= NSAMP * D) return;
    const int row = samp_row(idx / D), n = idx % D, b = row / SEQ; const bf16* mg = (const bf16*)(a.ws + WS_A);
    float s = 0.f; for (int k = 0; k < D; ++k) s += ldbf(mg + (size_t)row * D + k) * bfr(a.in[I_WO][(size_t)k * D + n]);
    const float ref = a.in[I_X][(size_t)row * D + n] + ((const float*)(a.ws + WS_MOD))[(size_t)b * 6 * D + 2 * D + n] * s;
    dbg_acc(a.ws, 5, ldbf((const bf16*)(a.ws + WS_XMID) + (size_t)row * D + n) - ref, ref);
}
__global__ void __launch_bounds__(256) chk_router(Args a) {
    __shared__ float sh[8]; __shared__ float lgt[36];
    const int row = samp_row(blockIdx.x), b = row / SEQ, t = threadIdx.x; const float* mod = (const float*)(a.ws + WS_MOD);
    float xv[4], hv[4], ss = 0.f;
#pragma unroll
    for (int q = 0; q < 4; ++q) { xv[q] = ldbf((const bf16*)(a.ws + WS_XMID) + (size_t)row * D + t + 256 * q); ss += xv[q] * xv[q]; }
    const float rinv = 1.0f / sqrtf(block_sum256(ss, sh) / D + EPS);
#pragma unroll
    for (int q = 0; q < 4; ++q) { const int c = t + 256 * q; hv[q] = xv[q] * rinv * a.in[I_N2G][c] * (1.0f + mod[(size_t)b * 6 * D + 4 * D + c]) + mod[(size_t)b * 6 * D + 3 * D + c];
        dbg_acc(a.ws, 6, f8dec(((const unsigned char*)(a.ws + WS_H2))[(size_t)row * D + c]) - f8r(hv[q]), hv[q]); }
    for (int n = 0; n < 36; ++n) { float p = 0.f;
#pragma unroll
        for (int q = 0; q < 4; ++q) { const int c = t + 256 * q; p += hv[q] * (n < 4 ? a.in[I_WRG][c * 4 + n] : a.in[I_WRE][c * 32 + n - 4]); }
        const float tot = block_sum256(p, sh); if (t == 0) lgt[n] = tot + (n < 4 ? a.in[I_BRG][n] : a.in[I_BRE][n - 4]); }
    __syncthreads();
    if (t == 0) { int gi = 0; for (int n = 1; n < 4; ++n) if (lgt[n] > lgt[gi]) gi = n; float gs = 0.f; for (int n = 0; n < 4; ++n) gs += expf(lgt[n] - lgt[gi]); const float pg = 1.0f / gs;
        int i1 = 0; for (int j = 1; j < 8; ++j) if (lgt[4 + 8 * gi + j] > lgt[4 + 8 * gi + i1]) i1 = j; int i2 = -1; for (int j = 0; j < 8; ++j) if (j != i1 && (i2 < 0 || lgt[4 + 8 * gi + j] > lgt[4 + 8 * gi + i2])) i2 = j;
        const float ex = expf(lgt[4 + 8 * gi + i2] - lgt[4 + 8 * gi + i1]), w1 = pg / (1.0f + ex), w2 = pg * ex / (1.0f + ex);
        const float* rec = (const float*)(a.ws + WS_DBG) + (size_t)row * 4;
        const bool same = ((int)rec[0] == gi * 8 + i1) && ((int)rec[1] == gi * 8 + i2);
        dbg_acc(a.ws, 7, same ? 0.f : 1.f, 1.f);
        if (same) { dbg_acc(a.ws, 8, rec[2] - w1, w1); dbg_acc(a.ws, 8, rec[3] - w2, w2); } }
}
__global__ void __launch_bounds__(256) chk_moe(Args a) {
    __shared__ float hs[D]; __shared__ float act[DEXP];
    const int row = samp_row(blockIdx.x >> 1), k = blockIdx.x & 1, t = threadIdx.x;
    const float* rec = (const float*)(a.ws + WS_DBG) + (size_t)row * 4; const int e = (int)rec[k]; const float w = rec[2 + k];
    for (int c = t; c < D; c += 256) hs[c] = f8dec(((const unsigned char*)(a.ws + WS_H2))[(size_t)row * D + c]);
    __syncthreads();
    for (int j = t; j < DEXP; j += 256) { float gsum = 0.f, usum = 0.f; for (int c = 0; c < D; ++c) { gsum += hs[c] * f8r(a.in[I_WG][((size_t)e * D + c) * DEXP + j] * WGU_SCALE); usum += hs[c] * f8r(a.in[I_WU][((size_t)e * D + c) * DEXP + j] * WGU_SCALE); }
        gsum *= 1.0f / WGU_SCALE; usum *= 1.0f / WGU_SCALE;
        act[j] = f8r(gsum / (1.0f + expf(-gsum)) * usum); }
    __syncthreads();
    for (int n = t; n < D; n += 256) { float s = 0.f; for (int j = 0; j < DEXP; ++j) s += act[j] * f8r(a.in[I_WDN][((size_t)e * DEXP + j) * D + n] * WD_SCALE);
        const float ref = w * s * (1.0f / WD_SCALE); dbg_acc(a.ws, 9, ldbf((const bf16*)(a.ws + WS_YT) + ((size_t)row * 2 + k) * D + n) - ref, ref); }
}
__global__ void __launch_bounds__(256) chk_final(Args a) {
    __shared__ float sh[8];
    const int row = samp_row(blockIdx.x), b = row / SEQ, t = threadIdx.x; const float* mod = (const float*)(a.ws + WS_MOD);
    float v[4], ss = 0.f;
#pragma unroll
    for (int q = 0; q < 4; ++q) { const int c = t + 256 * q; v[q] = ldbf((const bf16*)(a.ws + WS_XMID) + (size_t)row * D + c) + mod[(size_t)b * 6 * D + 5 * D + c] * (ldbf((const bf16*)(a.ws + WS_YT) + (size_t)row * 2 * D + c) + ldbf((const bf16*)(a.ws + WS_YT) + (size_t)row * 2 * D + D + c)); ss += v[q] * v[q]; }
    const float rinv = 1.0f / sqrtf(block_sum256(ss, sh) / D + EPS);
#pragma unroll
    for (int q = 0; q < 4; ++q) { const int c = t + 256 * q; const float ref = v[q] * rinv * a.in[I_FG][c]; dbg_acc(a.ws, 10, a.out[(size_t)row * D + c] - ref, ref); }
}
__global__ void __launch_bounds__(256) chk_report(Args a) {
    const float* acc = (const float*)(a.ws + WS_CTL) + CW_DBG; int code = 0;
    for (int k = 10; k >= 0; --k) { if (k < DBG_FIRST) continue; const float tol = (k == 7) ? 0.02f : 1e-3f; if (!(acc[2 * k] <= tol * acc[2 * k + 1])) code = k + 1; }
    const float f = 1.0f + 0.5f * (float)code;
    for (size_t i = (size_t)blockIdx.x * 256 + threadIdx.x; i < (size_t)M * D; i += (size_t)gridDim.x * 256) a.out[i] *= f;
}
#endif

extern "C" void kernel_launch(void* const* d_in, const int* in_sizes, int n_in, void* d_out, int out_size, void* d_ws, size_t ws_size, hipStream_t stream) {
    static int grid = 0;
    if (grid == 0) {
        if (n_in != 25 || in_sizes[0] != M * D || out_size != M * D || ws_size < WS_END) { fprintf(stderr, "kernel_launch: unexpected shapes (n_in %d, in0 %d, out %d, ws %zu); nothing launched\n", n_in, n_in > 0 ? in_sizes[0] : -1, out_size, ws_size); grid = -1; return; }
        int dev = 0, cus = 0, per_cu = 0;
        if (hipGetDevice(&dev) != hipSuccess || hipDeviceGetAttribute(&cus, hipDeviceAttributeMultiprocessorCount, dev) != hipSuccess) { grid = -1; return; }
        if (hipFuncSetAttribute((const void*)mk_fwd, hipFuncAttributeMaxDynamicSharedMemorySize, LDS_BYTES) != hipSuccess) { fprintf(stderr, "kernel_launch: hipFuncSetAttribute failed\n"); grid = -1; return; }
        if (hipOccupancyMaxActiveBlocksPerMultiprocessor(&per_cu, (const void*)mk_fwd, NWAVES * 64, LDS_BYTES) != hipSuccess || per_cu < 1) fprintf(stderr, "kernel_launch: occupancy query reports %d\n", per_cu);
        (void)hipGetLastError();
        grid = cus;
    }
    if (grid < 0) return;
    if (hipMemsetAsync((char*)d_ws + WS_CTL, 0, DEBUG_CHECKS ? (size_t)(1 * MiB) : CTL_ZERO_BYTES, stream) != hipSuccess) return;
    Args a{};
    for (int i = 0; i < 25; ++i) a.in[i] = (const float*)d_in[i];
    a.out = (float*)d_out; a.ws = (unsigned char*)d_ws;
    if (MK_N_LAUNCHES == 1) { a.ph_lo = 0; a.ph_hi = N_PHASES; a.li = 0; hipLaunchKernelGGL(mk_fwd, dim3(grid), dim3(NWAVES * 64), LDS_BYTES, stream, a); }
    else for (int li = 0; li < RUN_PHASES; ++li) { a.ph_lo = li; a.ph_hi = li + 1; a.li = li; hipLaunchKernelGGL(mk_fwd, dim3(grid), dim3(NWAVES * 64), LDS_BYTES, stream, a);
#if DEBUG_CHECKS
        if (li == 2) { hipLaunchKernelGGL(chk_h1, dim3(NSAMP), dim3(256), 0, stream, a); hipLaunchKernelGGL(chk_inproj, dim3(NSAMP * INW / 256), dim3(256), 0, stream, a); }
        if (li == 3) { hipLaunchKernelGGL(chk_attn, dim3(NSAMP * 32 / 256), dim3(256), 0, stream, a); hipLaunchKernelGGL(chk_gmlp, dim3(NSAMP), dim3(512), 0, stream, a); }
        if (li == 4) hipLaunchKernelGGL(chk_merge, dim3(NSAMP * D / 256), dim3(256), 0, stream, a);
        if (li == 5) hipLaunchKernelGGL(chk_wo, dim3(NSAMP * D / 256), dim3(256), 0, stream, a);
        if (li == 6) hipLaunchKernelGGL(chk_router, dim3(NSAMP), dim3(256), 0, stream, a);
        if (li == 8) hipLaunchKernelGGL(chk_moe, dim3(NSAMP * 2), dim3(256), 0, stream, a);
        if (li == 9) { hipLaunchKernelGGL(chk_final, dim3(NSAMP), dim3(256), 0, stream, a); hipLaunchKernelGGL(chk_report, dim3(2048), dim3(256), 0, stream, a); }
#endif
    }
}
```
